# Optimizing an MI355X kernel written in HIP

```python
import math
import jax, jax.numpy as jnp
from jax import lax
import numpy as np

D_MODEL = 1024
BATCH = 2
SEQ = 16384
DEPTH = 2

GRID_W = 64
CTX_LEN = 256
HEAD_DIM = 64
ATTN_WIDTH = D_MODEL // 2
N_HEADS = ATTN_WIDTH // HEAD_DIM
N_KV_HEADS = N_HEADS // 4
KV_WIDTH = N_KV_HEADS * HEAD_DIM
WINDOW = 128
ATTN_BLOCK = 128
ROPE_BASE = 10000.0
S5_WIDTH = D_MODEL // 4
S5_GROUP = 16
S5_GROUPS = S5_WIDTH // S5_GROUP
S5_STATE = 64
S5_DIRS = 2
SGU_WIDTH = D_MODEL // 4
SGU_GROUPS = 4
SGU_CHUNK = 128
MIX_WIDTH = ATTN_WIDTH + S5_WIDTH + SGU_WIDTH
IN_WIDTH = ATTN_WIDTH + 2 * KV_WIDTH + S5_WIDTH + 2 * SGU_WIDTH
IN_SPLITS = (ATTN_WIDTH, ATTN_WIDTH + KV_WIDTH, ATTN_WIDTH + 2 * KV_WIDTH, ATTN_WIDTH + 2 * KV_WIDTH + S5_WIDTH)
OUT_SPLITS = (ATTN_WIDTH, ATTN_WIDTH + S5_WIDTH)
N_EXPERTS = 16
EXPERT_FF = D_MODEL
EC_CAPACITY_FACTOR = 2
N_MOD = 6
EPS = 1e-6

kernel_name = 'hybrid_s5_sgu_swa_ecmoe_diffusion'

F32 = jnp.float32


def rmsnorm(x, g):
    x32 = x.astype(F32)
    y = x32 * lax.rsqrt(jnp.mean(x32 * x32, axis=-1, keepdims=True) + EPS)
    return (y * g.astype(F32)).astype(x.dtype)


def modulate(x, g, shift, scale):
    return rmsnorm(x, g) * (1 + scale) + shift


def axial_rope_tables(n):
    rows = n // GRID_W
    row = jnp.repeat(jnp.arange(rows), GRID_W).astype(F32)
    col = jnp.tile(jnp.arange(GRID_W), rows).astype(F32)
    axis_dim = HEAD_DIM // 2
    inv = ROPE_BASE ** (-jnp.arange(0, axis_dim, 2, dtype=F32) / axis_dim)
    ang_r = row[:, None] * inv
    ang_c = col[:, None] * inv
    return (jnp.cos(ang_r), jnp.sin(ang_r), jnp.cos(ang_c), jnp.sin(ang_c))


def _rotate(x, cos, sin):
    x1, x2 = jnp.split(x, 2, axis=-1)
    cos = cos[:, None, :]
    sin = sin[:, None, :]
    return jnp.concatenate([x1 * cos - x2 * sin, x2 * cos + x1 * sin], axis=-1)


def apply_axial_rope(x, tabs):
    cr, sr, cc, sc = tabs
    xr, xc = jnp.split(x, 2, axis=-1)
    return jnp.concatenate([_rotate(xr, cr, sr), _rotate(xc, cc, sc)], axis=-1).astype(x.dtype)


def window_attention(q, k, v, k_ctx, v_ctx, sink):
    b, n = q.shape[0], q.shape[1]
    nb = n // ATTN_BLOCK
    grp = N_HEADS // N_KV_HEADS
    scale = HEAD_DIM ** -0.5
    qb = q.reshape(b, nb, ATTN_BLOCK, N_KV_HEADS, grp, HEAD_DIM)

    def band(t):
        tp = jnp.pad(t, ((0, 0), (ATTN_BLOCK, ATTN_BLOCK), (0, 0), (0, 0)))
        tp = tp.reshape(b, nb + 2, ATTN_BLOCK, N_KV_HEADS, HEAD_DIM)
        return jnp.concatenate([tp[:, :-2], tp[:, 1:-1], tp[:, 2:]], axis=2)

    kb, vb = band(k), band(v)
    qi = jnp.arange(nb)[:, None, None] * ATTN_BLOCK + jnp.arange(ATTN_BLOCK)[None, :, None]
    kj = (jnp.arange(nb)[:, None, None] - 1) * ATTN_BLOCK + jnp.arange(3 * ATTN_BLOCK)[None, None, :]
    valid = (jnp.abs(kj - qi) <= WINDOW) & (kj >= 0) & (kj < n)

    s_win = jnp.einsum('bnqkgd,bnskd->bnkgqs', qb, kb).astype(F32) * scale
    s_win = jnp.where(valid[None, :, None, None], s_win, -jnp.inf)
    s_ctx = jnp.einsum('bnqkgd,bckd->bnkgqc', qb, k_ctx).astype(F32) * scale
    s_sink = sink.astype(F32).reshape(1, 1, N_KV_HEADS, grp, 1, 1)
    m = jnp.maximum(jnp.maximum(s_win.max(-1, keepdims=True), s_ctx.max(-1, keepdims=True)), s_sink)
    e_win = jnp.exp(s_win - m)
    e_ctx = jnp.exp(s_ctx - m)
    denom = e_win.sum(-1, keepdims=True) + e_ctx.sum(-1, keepdims=True) + jnp.exp(s_sink - m)
    p_win = (e_win / denom).astype(v.dtype)
    p_ctx = (e_ctx / denom).astype(v.dtype)
    o = jnp.einsum('bnkgqs,bnskd->bnqkgd', p_win, vb) + jnp.einsum('bnkgqc,bckd->bnqkgd', p_ctx, v_ctx)
    return o.reshape(b, n, N_HEADS * HEAD_DIM)


def context_attention(q, k, v, sink):
    b, lc = q.shape[0], q.shape[1]
    grp = N_HEADS // N_KV_HEADS
    qg = q.reshape(b, lc, N_KV_HEADS, grp, HEAD_DIM)
    s = jnp.einsum('bqkgd,bskd->bkgqs', qg, k).astype(F32) * HEAD_DIM ** -0.5
    s_sink = jnp.broadcast_to(sink.astype(F32).reshape(1, N_KV_HEADS, grp, 1, 1), s.shape[:-1] + (1,))
    p = jax.nn.softmax(jnp.concatenate([s, s_sink], axis=-1), axis=-1)[..., :-1].astype(v.dtype)
    o = jnp.einsum('bkgqs,bskd->bqkgd', p, v)
    return o.reshape(b, lc, N_HEADS * HEAD_DIM)


def s5_discretize(lam_re, lam_im, log_dt, b_re, b_im):
    dt = jnp.exp(log_dt.astype(F32))[:, None]
    lr, li = lam_re.astype(F32), lam_im.astype(F32)
    mag = jnp.exp(lr * dt)
    ang = li * dt
    ab_re, ab_im = mag * jnp.cos(ang), mag * jnp.sin(ang)
    nr, ni = ab_re - 1.0, ab_im
    den = lr * lr + li * li
    coef_re = (nr * lr + ni * li) / den
    coef_im = (ni * lr - nr * li) / den
    br, bi = b_re.astype(F32), b_im.astype(F32)
    bb_re = coef_re[..., None] * br - coef_im[..., None] * bi
    bb_im = coef_re[..., None] * bi + coef_im[..., None] * br
    return ab_re, ab_im, bb_re, bb_im


def _linear_recurrence_combine(e1, e2):
    a1r, a1i, b1r, b1i = e1
    a2r, a2i, b2r, b2i = e2
    return (a2r * a1r - a2i * a1i,
            a2r * a1i + a2i * a1r,
            a2r * b1r - a2i * b1i + b2r,
            a2r * b1i + a2i * b1r + b2i)


def s5_scan(u, disc, h0, reverse):
    ab_re, ab_im, bb_re, bb_im = disc
    bu_re = jnp.einsum('gpc,bngc->bngp', bb_re, u)
    bu_im = jnp.einsum('gpc,bngc->bngp', bb_im, u)
    if h0 is not None:
        h0_re, h0_im = h0
        pos = -1 if reverse else 0
        bu_re = bu_re.at[:, pos].add(ab_re * h0_re - ab_im * h0_im)
        bu_im = bu_im.at[:, pos].add(ab_re * h0_im + ab_im * h0_re)
    a_re = jnp.broadcast_to(ab_re, bu_re.shape)
    a_im = jnp.broadcast_to(ab_im, bu_im.shape)
    _, _, h_re, h_im = lax.associative_scan(_linear_recurrence_combine, (a_re, a_im, bu_re, bu_im),
                                            reverse=reverse, axis=1)
    return h_re, h_im


def s5_readout(c_re, c_im, h_re, h_im):
    y = jnp.einsum('gcp,bngp->bngc', c_re.astype(F32), h_re) - jnp.einsum('gcp,bngp->bngc', c_im.astype(F32), h_im)
    return y.reshape(y.shape[0], y.shape[1], S5_WIDTH)


def s5_mixer(u_lat, u_ctx, lam_re, lam_im, log_dt, b_re, b_im, c_re, c_im, d_skip, glu_w, glu_b, ctx_out):
    def groups(u):
        return u.astype(F32).reshape(u.shape[0], u.shape[1], S5_GROUPS, S5_GROUP)

    ul, uc = groups(u_lat), groups(u_ctx)
    d32 = d_skip.astype(F32)
    y_lat = d32 * u_lat.astype(F32)
    y_ctx = d32 * u_ctx.astype(F32)
    for direction in range(S5_DIRS):
        reverse = direction == 1
        disc = s5_discretize(lam_re[direction], lam_im[direction], log_dt[direction],
                             b_re[direction], b_im[direction])
        hc_re, hc_im = s5_scan(uc, disc, None, reverse)
        end = 0 if reverse else -1
        hl_re, hl_im = s5_scan(ul, disc, (hc_re[:, end], hc_im[:, end]), reverse)
        y_lat = y_lat + s5_readout(c_re[direction], c_im[direction], hl_re, hl_im)
        if ctx_out:
            y_ctx = y_ctx + s5_readout(c_re[direction], c_im[direction], hc_re, hc_im)

    def glu(y, dtype):
        g = jax.nn.gelu(y)
        return (g * jax.nn.sigmoid(g @ glu_w.astype(F32) + glu_b.astype(F32))).astype(dtype)

    return glu(y_lat, u_lat.dtype), (glu(y_ctx, u_ctx.dtype) if ctx_out else None)


def sgu_mixer(z, norm_g, w_s, b_s):
    u, v = jnp.split(jax.nn.gelu(z), 2, axis=-1)
    v = rmsnorm(v, norm_g)
    b, n = v.shape[0], v.shape[1]
    vc = v.reshape(b, n // SGU_CHUNK, SGU_CHUNK, SGU_GROUPS, SGU_WIDTH // SGU_GROUPS)
    s = jnp.einsum('gts,bnsgc->bntgc', w_s, vc) + b_s.T[None, None, :, :, None]
    return u * s.reshape(b, n, SGU_WIDTH)


def mixer_out_norm(y, g):
    parts = jnp.split(y, OUT_SPLITS, axis=-1)
    gains = jnp.split(g, OUT_SPLITS)
    return jnp.concatenate([rmsnorm(p, gg) for p, gg in zip(parts, gains)], axis=-1)


def expert_choice_moe(h, router_w, w_gate, w_up, w_down):
    b, n = h.shape[0], h.shape[1]
    cap = EC_CAPACITY_FACTOR * n // N_EXPERTS
    probs = jax.nn.softmax(jnp.einsum('bnd,de->ben', h, router_w).astype(F32), axis=1)
    gate, idx = lax.top_k(probs, cap)
    bidx = jnp.arange(b)[:, None, None]
    xin = h[bidx, idx]
    hid = jax.nn.silu(jnp.einsum('becd,edf->becf', xin, w_gate)) * jnp.einsum('becd,edf->becf', xin, w_up)
    y = jnp.einsum('becf,efd->becd', hid, w_down) * gate[..., None].astype(h.dtype)
    return jnp.zeros_like(h).at[bidx, idx].add(y)


def setup_inputs(seed: int = 0) -> dict:
    key = jax.random.key(seed)
    ks = iter(jax.random.split(key, 40))

    def nrm(shape, scale):
        return jax.random.normal(next(ks), shape, F32) * scale

    def gain(shape):
        return 1.0 + nrm(shape, 0.02)

    lam_im_base = jnp.pi * jnp.arange(S5_STATE, dtype=F32)
    return {
        'x': nrm((BATCH, SEQ, D_MODEL), 1.0),
        'c': nrm((BATCH, D_MODEL), 1.0),
        'ctx': nrm((BATCH, CTX_LEN, D_MODEL), 1.0),
        'c_ctx': nrm((D_MODEL,), 1.0),
        'ada_w': nrm((DEPTH, D_MODEL, N_MOD * D_MODEL), 0.5 * D_MODEL ** -0.5),
        'ada_b': nrm((DEPTH, N_MOD * D_MODEL), 0.02),
        'norm_mix_g': gain((DEPTH, D_MODEL)),
        'norm_ffn_g': gain((DEPTH, D_MODEL)),
        'w_in': nrm((DEPTH, D_MODEL, IN_WIDTH), D_MODEL ** -0.5),
        'q_norm_g': gain((DEPTH, HEAD_DIM)),
        'k_norm_g': gain((DEPTH, HEAD_DIM)),
        'attn_sink': nrm((DEPTH, N_HEADS), 0.5),
        's5_lambda_re': -0.5 + nrm((DEPTH, S5_DIRS, S5_GROUPS, S5_STATE), 0.01),
        's5_lambda_im': lam_im_base + nrm((DEPTH, S5_DIRS, S5_GROUPS, S5_STATE), 0.01),
        's5_log_dt': jax.random.uniform(next(ks), (DEPTH, S5_DIRS, S5_GROUPS), F32,
                                        minval=math.log(1e-3), maxval=math.log(1e-1)),
        's5_b_re': nrm((DEPTH, S5_DIRS, S5_GROUPS, S5_STATE, S5_GROUP), (2 * S5_GROUP) ** -0.5),
        's5_b_im': nrm((DEPTH, S5_DIRS, S5_GROUPS, S5_STATE, S5_GROUP), (2 * S5_GROUP) ** -0.5),
        's5_c_re': nrm((DEPTH, S5_DIRS, S5_GROUPS, S5_GROUP, S5_STATE), (2 * S5_STATE) ** -0.5),
        's5_c_im': nrm((DEPTH, S5_DIRS, S5_GROUPS, S5_GROUP, S5_STATE), (2 * S5_STATE) ** -0.5),
        's5_d': nrm((DEPTH, S5_WIDTH), 1.0),
        's5_glu_w': nrm((DEPTH, S5_WIDTH, S5_WIDTH), S5_WIDTH ** -0.5),
        's5_glu_b': nrm((DEPTH, S5_WIDTH), 0.02),
        'sgu_norm_g': gain((DEPTH, SGU_WIDTH)),
        'sgu_w': nrm((DEPTH, SGU_GROUPS, SGU_CHUNK, SGU_CHUNK), SGU_CHUNK ** -0.5),
        'sgu_b': 1.0 + nrm((DEPTH, SGU_GROUPS, SGU_CHUNK), 0.1),
        'out_norm_g': gain((DEPTH, MIX_WIDTH)),
        'w_out': nrm((DEPTH, MIX_WIDTH, D_MODEL), MIX_WIDTH ** -0.5),
        'router_w': nrm((DEPTH, D_MODEL, N_EXPERTS), D_MODEL ** -0.5),
        'exp_w_gate': nrm((DEPTH, N_EXPERTS, D_MODEL, EXPERT_FF), D_MODEL ** -0.5),
        'exp_w_up': nrm((DEPTH, N_EXPERTS, D_MODEL, EXPERT_FF), D_MODEL ** -0.5),
        'exp_w_down': nrm((DEPTH, N_EXPERTS, EXPERT_FF, D_MODEL), EXPERT_FF ** -0.5),
    }


def reference(x, c, ctx, c_ctx, ada_w, ada_b, norm_mix_g, norm_ffn_g, w_in, q_norm_g, k_norm_g, attn_sink,
              s5_lambda_re, s5_lambda_im, s5_log_dt, s5_b_re, s5_b_im, s5_c_re, s5_c_im, s5_d, s5_glu_w,
              s5_glu_b, sgu_norm_g, sgu_w, sgu_b, out_norm_g, w_out, router_w, exp_w_gate, exp_w_up,
              exp_w_down):
    b, n = x.shape[0], x.shape[1]
    rope = axial_rope_tables(n)
    h_lat, h_ctx = x, ctx
    silu_c = jax.nn.silu(c)
    silu_cc = jax.nn.silu(c_ctx)

    def heads(t, nh):
        return t.reshape(t.shape[0], t.shape[1], nh, HEAD_DIM)

    for l in range(DEPTH):
        ctx_out = l < DEPTH - 1
        mod_lat = (silu_c @ ada_w[l] + ada_b[l]).reshape(b, N_MOD, D_MODEL)[:, :, None, :]
        mod_ctx = (silu_cc @ ada_w[l] + ada_b[l]).reshape(N_MOD, D_MODEL)[None, :, None, :]

        a_lat = modulate(h_lat, norm_mix_g[l], mod_lat[:, 0], mod_lat[:, 1])
        a_ctx = modulate(h_ctx, norm_mix_g[l], mod_ctx[:, 0], mod_ctx[:, 1])
        q_l, k_l, v_l, s_l, g_l = jnp.split(a_lat @ w_in[l], IN_SPLITS, axis=-1)
        q_c, k_c, v_c, s_c, g_c = jnp.split(a_ctx @ w_in[l], IN_SPLITS, axis=-1)

        q_l = apply_axial_rope(rmsnorm(heads(q_l, N_HEADS), q_norm_g[l]), rope)
        k_l = apply_axial_rope(rmsnorm(heads(k_l, N_KV_HEADS), k_norm_g[l]), rope)
        v_l = heads(v_l, N_KV_HEADS)
        k_c = rmsnorm(heads(k_c, N_KV_HEADS), k_norm_g[l])
        v_c = heads(v_c, N_KV_HEADS)
        att_lat = window_attention(q_l, k_l, v_l, k_c, v_c, attn_sink[l])

        s5_lat, s5_ctx = s5_mixer(s_l, s_c, s5_lambda_re[l], s5_lambda_im[l], s5_log_dt[l], s5_b_re[l],
                                  s5_b_im[l], s5_c_re[l], s5_c_im[l], s5_d[l], s5_glu_w[l], s5_glu_b[l],
                                  ctx_out)

        sgu_lat = sgu_mixer(g_l, sgu_norm_g[l], sgu_w[l], sgu_b[l])

        mix_lat = mixer_out_norm(jnp.concatenate([att_lat, s5_lat, sgu_lat], axis=-1), out_norm_g[l])
        h_lat = h_lat + mod_lat[:, 2] * (mix_lat @ w_out[l])
        if ctx_out:
            q_c = rmsnorm(heads(q_c, N_HEADS), q_norm_g[l])
            att_ctx = context_attention(q_c, k_c, v_c, attn_sink[l])
            sgu_ctx = sgu_mixer(g_c, sgu_norm_g[l], sgu_w[l], sgu_b[l])
            mix_ctx = mixer_out_norm(jnp.concatenate([att_ctx, s5_ctx, sgu_ctx], axis=-1), out_norm_g[l])
            h_ctx = h_ctx + mod_ctx[:, 2] * (mix_ctx @ w_out[l])

        f_lat = modulate(h_lat, norm_ffn_g[l], mod_lat[:, 3], mod_lat[:, 4])
        h_lat = h_lat + mod_lat[:, 5] * expert_choice_moe(f_lat, router_w[l], exp_w_gate[l], exp_w_up[l],
                                                          exp_w_down[l])
        if ctx_out:
            f_ctx = modulate(h_ctx, norm_ffn_g[l], mod_ctx[:, 3], mod_ctx[:, 4])
            h_ctx = h_ctx + mod_ctx[:, 5] * expert_choice_moe(f_ctx, router_w[l], exp_w_gate[l],
                                                              exp_w_up[l], exp_w_down[l])
    return h_lat
```

```cpp
#include <hip/hip_runtime.h>
#include <cstdio>
#include <cstdint>
#include <cmath>

constexpr int D = 1024, NBATCH = 2, SEQ = 16384, LC = 256;
constexpr int MLAT = NBATCH * SEQ, MCTX = NBATCH * LC, MT = MLAT + MCTX;
constexpr int INW = 1536;
constexpr int NE = 16, CAPL = 2048, CAPC = 32;
constexpr int XLAT = NBATCH * NE * CAPL;
constexpr int XROWS = XLAT + NE * 256;
constexpr float EPS = 1e-6f;
constexpr float LOG2E = 1.4426950408889634f;
constexpr int NTILE = MT / 256;
constexpr int NSC = MT / 16;

namespace pg8 {
#define PG8_LAS __attribute__((address_space(3)))
typedef unsigned short bf16_t;
typedef short bf16x8 __attribute__((ext_vector_type(8)));
typedef float f32x4 __attribute__((ext_vector_type(4)));
typedef unsigned u32x4 __attribute__((ext_vector_type(4)));
constexpr int BM = 256, BK = 64, HALF = 128, HTB = HALF * BK * 2  , STAGE_BYTES = 8 * HTB, NXCD = 8, WGM = 8;

__host__ __device__ __forceinline__ int lds_byte(int r, int c) { const int st = (r >> 4) * 2 + (c >> 5), rr = r & 15, cc = c & 31, ob = rr * 64 + cc * 2; return st * 1024 + (ob ^ (((ob >> 9) & 1) << 5)); }
__host__ __device__ __forceinline__ void stage_rc(int b, int& R, int& C) { const int st = b / 1024, sb = b % 1024, swz = sb ^ (((sb >> 9) & 1) << 5); R = (st >> 1) * 16 + swz / 64; C = (st & 1) * 32 + (swz % 64) / 2; }
__host__ __device__ __forceinline__ int perm32(int rho) { const int n = rho >> 4, i = rho & 15; return 8 * (i >> 2) + 4 * n + (i & 3); }

struct Unit { int pm, pn, pb; };
struct Gemm { const bf16_t* A; const bf16_t* Bt; int M, N, K; };

struct StaticOrder {
    int nM, nN, nwg, G, c, moe;
    __host__ __device__ void init(int M, int N, int G_, int c_, int moe_ = 0) { nM = M / BM; nN = N / BM; nwg = nM * nN; G = G_; c = c_; moe = moe_; }
    __host__ __device__ bool next(int i, Unit& u) const {
        const long L = (long)i * G + c; if (L >= nwg) return false;
        int wgid = (int)L; { const int q = nwg / NXCD, r = nwg % NXCD, xcd = wgid % NXCD, off = wgid / NXCD; wgid = (xcd < r ? xcd * (q + 1) : r * (q + 1) + (xcd - r) * q) + off; }
        const int nig = WGM * nN, gid = wgid / nig, fm = gid * WGM, gsz = (nM - fm) < WGM ? (nM - fm) : WGM;
        u.pm = fm + ((wgid % nig) % gsz); u.pn = (wgid % nig) / gsz;
        u.pb = moe ? ((u.pm < 256 ? ((u.pm >> 3) & 15) : (u.pm - 256)) * nN + u.pn) : u.pn; return true;
    }
    __device__ __forceinline__ void a_ready(const Unit&) const {}
    __device__ __forceinline__ void done(const Unit&) const {}
};

__device__ __forceinline__ unsigned cvt_pk_bf16(float lo, float hi) { unsigned r; asm volatile("v_cvt_pk_bf16_f32 %0, %1, %2" : "=v"(r) : "v"(lo), "v"(hi)); return r; }

struct EpiStoreBf16 {
    static constexpr bool PERM = true, AFTER_DRAIN = false;
    bf16_t* O; int ldc;
    __device__ __forceinline__ void operator()(const f32x4 (&acc)[2][2][4][2], const Unit& u, int wr, int wc, int fr, int fq) const {
        const int row0 = u.pm * BM + wr * 64 + fr, col0 = u.pn * BM + wc * 32 + 8 * fq;
#pragma unroll
        for (int ai = 0; ai < 2; ++ai)
#pragma unroll
            for (int m = 0; m < 4; ++m) { bf16_t* rowp = O + (size_t)(row0 + ai * HALF + m * 16) * ldc + col0;
#pragma unroll
                for (int bj = 0; bj < 2; ++bj) { const f32x4 v0 = acc[ai][bj][m][0], v1 = acc[ai][bj][m][1];
                    u32x4 w; w.x = cvt_pk_bf16(v0[0], v0[1]); w.y = cvt_pk_bf16(v0[2], v0[3]); w.z = cvt_pk_bf16(v1[0], v1[1]); w.w = cvt_pk_bf16(v1[2], v1[3]);
                    *(u32x4*)(rowp + bj * HALF) = w; } }
    }
};
struct EpiResid {
    static constexpr bool PERM = false, AFTER_DRAIN = false;
    const float* src_lat; float* dst_lat; const float* src_ctx; float* dst_ctx; const float* gate3;
    int mlat, gate_off;
    __device__ __forceinline__ void operator()(const f32x4 (&acc)[2][2][4][2], const Unit& u, int wr, int wc, int fr, int fq) const {
        const int r0 = u.pm * BM; const bool isctx = r0 >= mlat; const int mb = isctx ? 2 : (r0 >> 14);
        const float* src = isctx ? src_ctx : src_lat; float* dst = isctx ? dst_ctx : dst_lat;
        const int rb = (isctx ? r0 - mlat : r0) + wr * 64 + fr, col0 = u.pn * BM + wc * 32 + 4 * fq;
        const float* gate = gate3 + mb * 6144 + gate_off;
        f32x4 gv[2][2];
#pragma unroll
        for (int bj = 0; bj < 2; ++bj)
#pragma unroll
            for (int n = 0; n < 2; ++n) gv[bj][n] = *(const f32x4*)(gate + col0 + bj * HALF + n * 16);
#pragma unroll
        for (int ai = 0; ai < 2; ++ai)
#pragma unroll
            for (int m = 0; m < 4; ++m) { const size_t off = (size_t)(rb + ai * HALF + m * 16) * 1024 + col0;
#pragma unroll
                for (int bj = 0; bj < 2; ++bj)
#pragma unroll
                    for (int n = 0; n < 2; ++n) { const f32x4 h = *(const f32x4*)(src + off + bj * HALF + n * 16); *(f32x4*)(dst + off + bj * HALF + n * 16) = h + gv[bj][n] * acc[ai][bj][m][n]; }
                if (m & 1) asm volatile("" ::: "memory"); }
    }
};
struct EpiSwiGLU {
    static constexpr bool PERM = true, AFTER_DRAIN = false;
    bf16_t* O;
    __device__ __forceinline__ void operator()(const f32x4 (&acc)[2][2][4][2], const Unit& u, int wr, int wc, int fr, int fq) const {
        const int row0 = u.pm * BM + wr * 64 + fr, col0 = u.pn * HALF + wc * 32 + 8 * fq;
#pragma unroll
        for (int ai = 0; ai < 2; ++ai)
#pragma unroll
            for (int m = 0; m < 4; ++m) { bf16_t* rowp = O + (size_t)(row0 + ai * HALF + m * 16) * 1024 + col0;
                float hv[8];
#pragma unroll
                for (int n = 0; n < 2; ++n)
#pragma unroll
                    for (int i = 0; i < 4; ++i) { const float g = acc[ai][0][m][n][i], up = acc[ai][1][m][n][i];
                        const float sg = g * __builtin_amdgcn_rcpf(1.0f + __builtin_amdgcn_exp2f(-g * 1.4426950408889634f)); hv[n * 4 + i] = sg * up; }
                u32x4 w; w.x = cvt_pk_bf16(hv[0], hv[1]); w.y = cvt_pk_bf16(hv[2], hv[3]); w.z = cvt_pk_bf16(hv[4], hv[5]); w.w = cvt_pk_bf16(hv[6], hv[7]);
                *(u32x4*)rowp = w; }
    }
};
struct EpiGateY {
    static constexpr bool PERM = true, AFTER_DRAIN = false;
    bf16_t* O; const float* gate;
    __device__ __forceinline__ void operator()(const f32x4 (&acc)[2][2][4][2], const Unit& u, int wr, int wc, int fr, int fq) const {
        const int row0 = u.pm * BM + wr * 64 + fr, col0 = u.pn * BM + wc * 32 + 8 * fq;
#pragma unroll
        for (int ai = 0; ai < 2; ++ai)
#pragma unroll
            for (int m = 0; m < 4; ++m) { const int row = row0 + ai * HALF + m * 16; const float gt = gate[row]; bf16_t* rowp = O + (size_t)row * 1024 + col0;
#pragma unroll
                for (int bj = 0; bj < 2; ++bj) { const f32x4 v0 = acc[ai][bj][m][0] * gt, v1 = acc[ai][bj][m][1] * gt;
                    u32x4 w; w.x = cvt_pk_bf16(v0[0], v0[1]); w.y = cvt_pk_bf16(v0[2], v0[3]); w.z = cvt_pk_bf16(v1[0], v1[1]); w.w = cvt_pk_bf16(v1[2], v1[3]);
                    *(u32x4*)(rowp + bj * HALF) = w; } }
    }
};

template <class Epi, class Sched, bool ALIGN_EPI = false, bool SP2 = false>
__device__ __forceinline__ void gemm_phase(PG8_LAS unsigned char* lds, const Gemm g, const Sched& S, const Epi& E) {
    int tid_ = threadIdx.x; asm volatile("" : "+v"(tid_));
    const int tid = tid_, wid = __builtin_amdgcn_readfirstlane(tid >> 6), lane = tid & 63, wr = wid >> 2, wc = wid & 3, fr = lane & 15, fq = lane >> 4;
    const int K = g.K, nt = K / BK;
    unsigned voffA[2], voffB[2];
#pragma unroll
    for (int i = 0; i < 2; ++i) { int R, C; stage_rc(tid * 16 + i * 8192, R, C); const int Rb = Epi::PERM ? ((R & ~31) + perm32(R & 31)) : R;
        voffA[i] = (unsigned)(R * K + C) * 2u; voffB[i] = (unsigned)(Rb * K + C) * 2u; }
    const size_t kstep = (size_t)(BK * 2);
    const size_t hstep = (size_t)HALF * K * 2;
    const size_t tstep = 2 * hstep;
    const unsigned ldsw = (unsigned)wid * 1024u;
    const int aoff = lds_byte(wr * 64 + fr, fq * 8), boff = lds_byte(wc * 32 + fr, fq * 8);
#define PG8_SA(b, h) (((b) * 2 + (h)) * HTB)
#define PG8_SB(b, h) ((4 + (b) * 2 + (h)) * HTB)
#define PG8_STAGE(bufoff, gbase, voff) do { _Pragma("unroll") for (int _i = 0; _i < 2; ++_i) \
        __builtin_amdgcn_global_load_lds((const unsigned*)((const char*)(gbase) + (voff)[_i]), (PG8_LAS unsigned*)(lds + (bufoff) + ldsw + _i * 8192), 16, 0, 0); } while (0)
#define PG8_LDA(dst, b, h) do { _Pragma("unroll") for (int m = 0; m < 4; ++m) _Pragma("unroll") for (int k = 0; k < 2; ++k) dst[m][k] = *(const PG8_LAS bf16x8*)(lds + PG8_SA(b, h) + aoff + m * 2048 + k * 1024); } while (0)
#define PG8_LDB(dst, b, h) do { _Pragma("unroll") for (int n = 0; n < 2; ++n) _Pragma("unroll") for (int k = 0; k < 2; ++k) dst[n][k] = *(const PG8_LAS bf16x8*)(lds + PG8_SB(b, h) + boff + n * 2048 + k * 1024); } while (0)
#define PG8_MMA(ai, bj, At, Bt) do { __builtin_amdgcn_s_setprio(1); _Pragma("unroll") for (int m = 0; m < 4; ++m) _Pragma("unroll") for (int n = 0; n < 2; ++n) _Pragma("unroll") for (int k = 0; k < 2; ++k) \
        acc[ai][bj][m][n] = __builtin_amdgcn_mfma_f32_16x16x32_bf16(Bt[n][k], At[m][k], acc[ai][bj][m][n], 0, 0, 0); __builtin_amdgcn_s_setprio(0); } while (0)
#define PG8_WAIT_V(n) asm volatile("s_waitcnt vmcnt(" #n ")" ::: "memory")
#define PG8_WAIT_L(n) asm volatile("s_waitcnt lgkmcnt(" #n ")" ::: "memory")
#define PG8_BAR __builtin_amdgcn_s_barrier()
#define PG8_SCHED __builtin_amdgcn_sched_barrier(0)
    Unit cur, nxt; int ui = 0;
    if (!S.next(0, cur)) return;
    f32x4 acc[2][2][4][2];
#pragma unroll
    for (int a = 0; a < 2; ++a)
#pragma unroll
        for (int b = 0; b < 2; ++b)
#pragma unroll
            for (int m = 0; m < 4; ++m)
#pragma unroll
                for (int n = 0; n < 2; ++n) acc[a][b][m][n] = (f32x4){0.f, 0.f, 0.f, 0.f};
    bf16x8 At[4][2], B0[2][2], B1[2][2];
    const char* cA = (const char*)g.A + (size_t)cur.pm * tstep; const char* cB = (const char*)g.Bt + (size_t)cur.pb * tstep;
    S.a_ready(cur);
    if constexpr (SP2) {
        PG8_STAGE(PG8_SB(0, 0), cB, voffB); PG8_STAGE(PG8_SB(0, 1), cB + hstep, voffB); PG8_STAGE(PG8_SA(0, 0), cA, voffA); PG8_STAGE(PG8_SA(0, 1), cA + hstep, voffA);
        if (wr == 1) PG8_BAR;
        PG8_WAIT_V(2); PG8_BAR;
        PG8_STAGE(PG8_SB(1, 0), cB + kstep, voffB); PG8_STAGE(PG8_SA(1, 0), cA + kstep, voffA); PG8_STAGE(PG8_SB(1, 1), cB + hstep + kstep, voffB);
        PG8_WAIT_V(6); PG8_BAR;
    } else {
        PG8_STAGE(PG8_SB(0, 0), cB, voffB); PG8_STAGE(PG8_SA(0, 0), cA, voffA); PG8_STAGE(PG8_SB(0, 1), cB + hstep, voffB); PG8_STAGE(PG8_SA(0, 1), cA + hstep, voffA);
        if (wr == 1) PG8_BAR;
        PG8_WAIT_V(4); PG8_BAR;
        PG8_STAGE(PG8_SB(1, 0), cB + kstep, voffB); PG8_STAGE(PG8_SA(1, 0), cA + kstep, voffA); PG8_STAGE(PG8_SB(1, 1), cB + hstep + kstep, voffB);
        PG8_WAIT_V(6); PG8_BAR;
    }
    for (;;) {
        const bool has_next = S.next(ui + 1, nxt);
        const char* nA = has_next ? (const char*)g.A + (size_t)nxt.pm * tstep : cA; const char* nB = has_next ? (const char*)g.Bt + (size_t)nxt.pb * tstep : cB;
        for (int t = 0; t < nt; t += 2) {
            const bool last = (t == nt - 2);
            const char* a1 = cA + (size_t)(t + 1) * kstep;
            const char* a2 = last ? nA : cA + (size_t)(t + 2) * kstep; const char* b2 = last ? nB : cB + (size_t)(t + 2) * kstep;
            const char* a3 = a2 + kstep; const char* b3 = b2 + kstep;
            if (last && has_next) S.a_ready(nxt);
            if constexpr (SP2) {
            PG8_LDB(B0, 0, 0); PG8_LDB(B1, 0, 1); PG8_SCHED; PG8_LDA(At, 0, 0); PG8_STAGE(PG8_SA(1, 1), a1 + hstep, voffA);
            PG8_WAIT_V(8); PG8_WAIT_L(0); PG8_BAR; PG8_MMA(0, 0, At, B0); PG8_MMA(0, 1, At, B1); PG8_BAR; PG8_SCHED;
            PG8_LDA(At, 0, 1); PG8_STAGE(PG8_SB(0, 0), b2, voffB); PG8_STAGE(PG8_SB(0, 1), b2 + hstep, voffB); PG8_STAGE(PG8_SA(0, 0), a2, voffA);
            PG8_WAIT_V(8); PG8_WAIT_L(0); PG8_BAR; PG8_MMA(1, 0, At, B0); PG8_MMA(1, 1, At, B1); PG8_BAR; PG8_SCHED;
            PG8_LDB(B0, 1, 0); PG8_LDB(B1, 1, 1); PG8_SCHED; PG8_LDA(At, 1, 0); PG8_STAGE(PG8_SA(0, 1), a2 + hstep, voffA);
            PG8_WAIT_V(8); PG8_WAIT_L(0); PG8_BAR; PG8_MMA(0, 0, At, B0); PG8_MMA(0, 1, At, B1); PG8_BAR; PG8_SCHED;
            PG8_LDA(At, 1, 1); PG8_STAGE(PG8_SB(1, 0), b3, voffB); PG8_STAGE(PG8_SB(1, 1), b3 + hstep, voffB); PG8_STAGE(PG8_SA(1, 0), a3, voffA);
            PG8_WAIT_V(8); PG8_WAIT_L(0); PG8_BAR; PG8_MMA(1, 0, At, B0); PG8_MMA(1, 1, At, B1); PG8_BAR; PG8_SCHED;
            } else {
            PG8_LDB(B0, 0, 0); PG8_SCHED; PG8_LDA(At, 0, 0); PG8_STAGE(PG8_SA(1, 1), a1 + hstep, voffA);
            PG8_WAIT_L(8); PG8_BAR; PG8_WAIT_L(0); PG8_MMA(0, 0, At, B0); PG8_BAR; PG8_SCHED;
            PG8_LDB(B1, 0, 1); PG8_STAGE(PG8_SB(0, 0), b2, voffB);
            PG8_BAR; PG8_WAIT_L(0); PG8_MMA(0, 1, At, B1); PG8_BAR;
            PG8_LDA(At, 0, 1); PG8_STAGE(PG8_SA(0, 0), a2, voffA);
            PG8_BAR; PG8_WAIT_L(0); PG8_MMA(1, 0, At, B0); PG8_BAR; PG8_SCHED;
            PG8_STAGE(PG8_SB(0, 1), b2 + hstep, voffB);
            PG8_WAIT_V(6); PG8_BAR; PG8_MMA(1, 1, At, B1); PG8_BAR;
            PG8_LDB(B0, 1, 0); PG8_SCHED; PG8_LDA(At, 1, 0); PG8_STAGE(PG8_SA(0, 1), a2 + hstep, voffA);
            PG8_WAIT_L(8); PG8_BAR; PG8_WAIT_L(0); PG8_MMA(0, 0, At, B0); PG8_BAR; PG8_SCHED;
            PG8_LDB(B1, 1, 1); PG8_STAGE(PG8_SB(1, 0), b3, voffB);
            PG8_BAR; PG8_WAIT_L(0); PG8_MMA(0, 1, At, B1); PG8_BAR;
            PG8_LDA(At, 1, 1); PG8_STAGE(PG8_SA(1, 0), a3, voffA);
            PG8_BAR; PG8_WAIT_L(0); PG8_MMA(1, 0, At, B0); PG8_BAR; PG8_SCHED;
            PG8_STAGE(PG8_SB(1, 1), b3 + hstep, voffB);
            PG8_WAIT_V(6); PG8_BAR; PG8_MMA(1, 1, At, B1); PG8_BAR;
            }
        }
        if constexpr (ALIGN_EPI) { if (wr == 0) PG8_BAR; }
        if constexpr (!Epi::AFTER_DRAIN) { E(acc, cur, wr, wc, fr, fq); S.done(cur); }
        if (!has_next) break;
#pragma unroll
        for (int a = 0; a < 2; ++a)
#pragma unroll
            for (int b = 0; b < 2; ++b)
#pragma unroll
                for (int m = 0; m < 4; ++m)
#pragma unroll
                    for (int n = 0; n < 2; ++n) acc[a][b][m][n] = (f32x4){0.f, 0.f, 0.f, 0.f};
        cur = nxt; cA = nA; cB = nB; ++ui;
        if constexpr (ALIGN_EPI) { if (wr == 1) PG8_BAR; }
    }
    PG8_WAIT_V(0);
    if constexpr (!ALIGN_EPI) { if (wr == 0) PG8_BAR; }
    PG8_BAR;
    if constexpr (Epi::AFTER_DRAIN) { E.fused(acc, cur, wr, wc, fr, fq, lds, wid, lane); S.done(cur); }
#undef PG8_SA
#undef PG8_SB
#undef PG8_STAGE
#undef PG8_LDA
#undef PG8_LDB
#undef PG8_MMA
#undef PG8_WAIT_V
#undef PG8_WAIT_L
#undef PG8_BAR
#undef PG8_SCHED
}
}
#define GAS __attribute__((address_space(1)))
#define LAS __attribute__((address_space(3)))
typedef unsigned short bf16;
typedef unsigned v4u __attribute__((ext_vector_type(4)));
typedef float f32x4 __attribute__((ext_vector_type(4)));
typedef short bf16x8 __attribute__((ext_vector_type(8)));
typedef GAS unsigned gu32;
typedef GAS unsigned long long gu64;
#define RLX_AGENT __ATOMIC_RELAXED, __HIP_MEMORY_SCOPE_AGENT
#define LDS_WAIT() asm volatile("s_waitcnt lgkmcnt(0)" ::: "memory")
#define VM_WAIT() asm volatile("s_waitcnt vmcnt(0)" ::: "memory")
__device__ __forceinline__ unsigned long long rt() { return __builtin_amdgcn_s_memrealtime(); }
__device__ __forceinline__ unsigned f2bf(float f) { unsigned u = __builtin_bit_cast(unsigned, f); return (u + 0x7fffu + ((u >> 16) & 1u)) >> 16; }
__device__ __forceinline__ unsigned pk2(float lo, float hi) { return f2bf(lo) | (f2bf(hi) << 16); }

#define XB_TMO      128
#define XB_XCNT(j)  (256  + 64 * (j))
#define XB_XSUB(j)  (1280 + 64 * (j))
#define XB_XGEN(j)  (2304 + 64 * (j))
#define XB_TOP      3328
#define XB_TOPGEN   3392
#define XCD_BAR_WORDS 3456
#define XB_SPIN_CAP (1u << 18)

__device__ __forceinline__ unsigned xb_ld(unsigned* p)              { return __hip_atomic_load(p, __ATOMIC_RELAXED, __HIP_MEMORY_SCOPE_AGENT); }
__device__ __forceinline__ unsigned xb_add(unsigned* p, unsigned v) { return __hip_atomic_fetch_add(p, v, __ATOMIC_RELAXED, __HIP_MEMORY_SCOPE_AGENT); }
__device__ __forceinline__ unsigned xb_xcc_id() { return (unsigned)__builtin_amdgcn_s_getreg((3 << 11) | 20) & 0xFu; }
#define XB_SPIN(cond, bar) do { unsigned _sp = 0; while (cond) { __builtin_amdgcn_s_sleep(1); \
    if ((++_sp & 255u) == 0u) { if (xb_ld(&(bar)[XB_TMO])) break; if (_sp > XB_SPIN_CAP) { atomicAdd(&(bar)[XB_TMO], 1u); break; } } } } while (0)

struct XcdBarrier {
    unsigned* bar; unsigned x;
    volatile LAS unsigned* st;
};

__device__ __forceinline__ XcdBarrier xcd_barrier_post(unsigned* bar, volatile LAS unsigned* st) {
    XcdBarrier b; b.bar = bar; b.x = xb_xcc_id(); b.st = st;
    if (threadIdx.x == 0) (void)xb_add(&bar[XB_XCNT(b.x)], 1u);
    return b;
}
__device__ __forceinline__ void xcd_barrier_complete(unsigned* bar, unsigned x, unsigned& nloc, unsigned& nx) {
    const unsigned G = gridDim.x * gridDim.y * gridDim.z;
    unsigned sum, cnt, mine, sp = 0u;
    for (;;) {
        sum = 0u; cnt = 0u; mine = 0u;
#pragma unroll
        for (unsigned j = 0; j < 16; ++j) { const unsigned c = xb_ld(&bar[XB_XCNT(j)]); sum += c; cnt += (c > 0u) ? 1u : 0u; mine = (j == x) ? c : mine; }
        if (sum == G) break;
        __builtin_amdgcn_s_sleep(1);
        if ((++sp & 255u) == 0u) { if (xb_ld(&bar[XB_TMO])) break; if (sp > XB_SPIN_CAP) { atomicAdd(&bar[XB_TMO], 1u); break; } }
    }
    nloc = mine > 0u ? mine : 1u; nx = cnt > 0u ? cnt : 1u;
}

__device__ __forceinline__ void xcd_barrier(const XcdBarrier& b) {
    asm volatile("s_waitcnt vmcnt(0)" ::: "memory");
    __syncthreads();
    if (threadIdx.x == 0) {
        unsigned* bar = b.bar;
        __builtin_amdgcn_s_waitcnt(0);
        unsigned nloc = b.st[0], nx = b.st[1];
        if (nloc == 0u) { xcd_barrier_complete(bar, b.x, nloc, nx); b.st[0] = nloc; b.st[1] = nx; }
        const unsigned old = xb_add(&bar[XB_XSUB(b.x)], 1u);
        const unsigned gen = old / nloc;
        if (old + 1u == (gen + 1u) * nloc) {
            __builtin_amdgcn_fence(__ATOMIC_RELEASE, "agent");
            asm volatile("s_waitcnt vmcnt(0)" ::: "memory");
            const unsigned og = xb_add(&bar[XB_TOP], 1u);
            const unsigned tg = og / nx;
            if (og + 1u == (tg + 1u) * nx) xb_add(&bar[XB_TOPGEN], 1u);
            else XB_SPIN(xb_ld(&bar[XB_TOPGEN]) == tg, bar);
            __builtin_amdgcn_fence(__ATOMIC_ACQUIRE, "agent");
            xb_add(&bar[XB_XGEN(b.x)], 1u);
            asm volatile("s_waitcnt vmcnt(0)" ::: "memory");
        } else {
            XB_SPIN(xb_ld(&bar[XB_XGEN(b.x)]) == gen, bar);
            __builtin_amdgcn_fence(__ATOMIC_ACQUIRE, "agent");
            asm volatile("s_waitcnt vmcnt(0)" ::: "memory");
        }
    }
    __syncthreads();
}

typedef float f32x2 __attribute__((ext_vector_type(2)));
typedef float f32x16 __attribute__((ext_vector_type(16)));
typedef unsigned u32x2 __attribute__((ext_vector_type(2)));
typedef short v4i16_t __attribute__((ext_vector_type(4)));

constexpr size_t MiB = 1u << 20;
constexpr size_t WS_CTL = 0, CTL_ZERO_BYTES = 1 * MiB;
constexpr size_t WS_MODV = 1 * MiB;
constexpr size_t WS_POW  = 1 * MiB + 256 * 1024;
constexpr size_t WS_BBAR = 2 * MiB;
constexpr size_t WS_WGLU = 2 * MiB + 512 * 1024;
constexpr size_t WS_WSGU = 2 * MiB + 768 * 1024;
constexpr size_t WS_HCTX = 3 * MiB;
constexpr size_t WS_EB   = 5 * MiB;
constexpr size_t WS_TG   = 9 * MiB;
constexpr size_t WS_E2   = 17 * MiB;
constexpr size_t WS_HIN2 = 19 * MiB + 512 * 1024;
constexpr size_t WS_PROBS = 22 * MiB;
constexpr size_t WS_SMAP = 24 * MiB + 256 * 1024;
constexpr size_t WS_IDX  = 26 * MiB + 512 * 1024;
constexpr size_t WS_GATE = 27 * MiB;
constexpr size_t WS_WIN  = 28 * MiB;
constexpr size_t WS_WOUT = 34 * MiB;
constexpr size_t WS_WGU  = 38 * MiB;
constexpr size_t WS_WD   = 102 * MiB;
constexpr size_t WS_R1   = 134 * MiB;
constexpr size_t WS_R2   = 270 * MiB;
constexpr size_t WS_R3   = 406 * MiB;
constexpr size_t WS_END  = 542 * MiB;
static_assert((size_t)XROWS * 2048 == 136 * MiB, "MoE row buffers are 136 MiB");
constexpr int CW_TMO = 0, CW_CODE = 1;
constexpr int CW_BAR = 4096;
constexpr int CW_Q = 16384;
constexpr int RING_OFF = 0, RING_BYTES = 131072;
constexpr int LDSCTL_OFF = RING_BYTES, MISC_OFF = LDSCTL_OFF + 320;
constexpr int LDS_BYTES = 147456;
constexpr int NWAVES = 8;


struct Args { const float* in[31]; float* out; unsigned char* ws; int ph_lo, ph_hi; };
typedef const float* fptr_t;
typedef const __attribute__((address_space(4))) fptr_t kfptr;
struct Ctx {
    LAS unsigned char* lds; volatile LAS unsigned* MISC; gu32* ctl;
    int tid, lane, wave, vcu, G;
    kfptr* inp; float* out; unsigned char* ws;
};
enum InIdx { I_X = 0, I_C, I_CTX, I_CCTX, I_ADAW, I_ADAB, I_NMIXG, I_NFFNG, I_WIN, I_QNG, I_KNG, I_SINK, I_LRE, I_LIM, I_LOGDT, I_BRE, I_BIM, I_CRE, I_CIM,
             I_S5D, I_GLUW, I_GLUB, I_SGUNG, I_SGUW, I_SGUB, I_ONG, I_WOUT, I_ROUTW, I_WG, I_WU, I_WDN };

__device__ __forceinline__ float bf2f(unsigned h) { return __uint_as_float(h << 16); }
__device__ __forceinline__ float wave_sum(float v) {
#pragma unroll
    for (int o = 1; o < 64; o <<= 1) v += __shfl_xor(v, o);
    return v;
}
__device__ __forceinline__ float gelu_tanh(float x) {
    const float z2 = 1.5957691216057308f * (x + 0.044715f * x * x * x);
    return x * __builtin_amdgcn_rcpf(1.0f + __builtin_amdgcn_exp2f(-z2 * LOG2E));
}
__device__ __forceinline__ float silu_f(float x) { return x / (1.0f + __expf(-x)); }
#define WG_SYNC() do { asm volatile("s_waitcnt vmcnt(0) lgkmcnt(0)" ::: "memory"); __syncthreads(); } while (0)

__device__ __forceinline__ int q_next(const Ctx& c, int qi) {
    WG_SYNC();
    if (c.tid == 0) c.MISC[16] = __hip_atomic_fetch_add(c.ctl + CW_Q + 64 * qi, 1u, RLX_AGENT);
    __syncthreads();
    const int u = (int)c.MISC[16];
    return __builtin_amdgcn_readfirstlane(u);
}

__device__ __forceinline__ void transpose_item(const float* W, int K, int N, bf16* WT, int ilv, LAS float* scr, int item, int lane) {
    const int nblk = N / 32, kb = item / nblk, nb = item % nblk, k0 = 64 * kb, n0 = 32 * nb;
    const int row_off = ilv ? ((n0 >> 7) * 128 + (ilv == 2 ? 128 : 0)) : 0;
#pragma unroll 8
    for (int i = 0; i < 32; ++i) { const int kk = 2 * i + (lane >> 5); scr[kk * 33 + (lane & 31)] = W[(size_t)(k0 + kk) * N + n0 + (lane & 31)]; }
    LDS_WAIT(); asm volatile("" ::: "memory");
    const int cc = lane & 7;
#pragma unroll
    for (int j = 0; j < 4; ++j) { const int n = (lane >> 3) + 8 * j; const LAS float* s = scr + (8 * cc) * 33 + n;
        v4u o; o.x = pk2(s[0 * 33], s[1 * 33]); o.y = pk2(s[2 * 33], s[3 * 33]); o.z = pk2(s[4 * 33], s[5 * 33]); o.w = pk2(s[6 * 33], s[7 * 33]);
        *(v4u*)(WT + (size_t)(row_off + n0 + n) * K + k0 + 8 * cc) = o; }
    LDS_WAIT(); asm volatile("" ::: "memory");
}
__device__ __forceinline__ void convert_experts(const Ctx& c_, int l) { Ctx c = c_; asm volatile("" : "+s"(c.ws), "+s"(c.inp), "+s"(c.out), "+v"(c.tid)); c.lane = c.tid & 63; asm volatile("" : "+s"(l));
    LAS float* scr = (LAS float*)(c.lds + RING_OFF + c.wave * 16384);
    const int gw = c.vcu * NWAVES + c.wave, NGW = c.G * NWAVES;
    bf16* WGU = (bf16*)(c.ws + WS_WGU); bf16* WD = (bf16*)(c.ws + WS_WD);
    for (int it = gw; it < 3 * 16 * 512; it += NGW) {
        const int which = it / (16 * 512), r = it % (16 * 512), e = r / 512, item = r % 512;
        const size_t wofs = ((size_t)l * 16 + e) * 1024 * 1024;
        if (which == 0) transpose_item(c.inp[I_WG] + wofs, 1024, 1024, WGU + (size_t)e * 2048 * 1024, 1, scr, item, c.lane);
        else if (which == 1) transpose_item(c.inp[I_WU] + wofs, 1024, 1024, WGU + (size_t)e * 2048 * 1024, 2, scr, item, c.lane);
        else transpose_item(c.inp[I_WDN] + wofs, 1024, 1024, WD + (size_t)e * 1024 * 1024, 0, scr, item, c.lane);
    }
}

__device__ __forceinline__ void p0a(const Ctx& c_) { Ctx c = c_; asm volatile("" : "+s"(c.ws), "+s"(c.inp), "+s"(c.out), "+v"(c.tid)); c.lane = c.tid & 63;
    {
        float* modv = (float*)(c.ws + WS_MODV); LAS float* red = (LAS float*)(c.lds + RING_OFF);
        for (int it = c.vcu; it < 192; it += c.G) {
            const int l = it / 96, col = (it % 96) * 64 + c.lane;
            const float* W = c.inp[I_ADAW] + (size_t)l * 1024 * 6144 + col;
            float a0 = 0.f, a1 = 0.f, a2 = 0.f;
            const int kb = c.wave * 128;
#pragma unroll 8
            for (int k = 0; k < 128; ++k) { const float w = W[(size_t)(kb + k) * 6144];
                a0 += silu_f(c.inp[I_C][kb + k]) * w; a1 += silu_f(c.inp[I_C][1024 + kb + k]) * w; a2 += silu_f(c.inp[I_CCTX][kb + k]) * w; }
            red[(c.wave * 3 + 0) * 64 + c.lane] = a0; red[(c.wave * 3 + 1) * 64 + c.lane] = a1; red[(c.wave * 3 + 2) * 64 + c.lane] = a2;
            WG_SYNC();
            if (c.wave < 3) { float s = 0.f;
#pragma unroll
                for (int w = 0; w < 8; ++w) s += red[(w * 3 + c.wave) * 64 + c.lane];
                modv[(size_t)(l * 3 + c.wave) * 6144 + col] = s + c.inp[I_ADAB][l * 6144 + col]; }
            WG_SYNC();
        }
    }
    {
        LAS float* scr = (LAS float*)(c.lds + RING_OFF + c.wave * 16384);
        const int gw = c.vcu * NWAVES + c.wave, NGW = c.G * NWAVES;
        constexpr int I_IN = 16 * 48, I_OUT = 16 * 32, I_GLU = 4 * 8;
        constexpr int NIT = 2 * (I_IN + I_OUT + I_GLU);
        for (int it = gw; it < NIT; it += NGW) {
            int r = it; const int l = r / (I_IN + I_OUT + I_GLU); r %= (I_IN + I_OUT + I_GLU);
            if (r < I_IN) { transpose_item(c.inp[I_WIN] + (size_t)l * 1024 * INW, 1024, INW, (bf16*)(c.ws + WS_WIN) + (size_t)l * INW * 1024, 0, scr, r, c.lane); continue; } r -= I_IN;
            if (r < I_OUT) { transpose_item(c.inp[I_WOUT] + (size_t)l * 1024 * 1024, 1024, 1024, (bf16*)(c.ws + WS_WOUT) + (size_t)l * 1024 * 1024, 0, scr, r, c.lane); continue; } r -= I_OUT;
            transpose_item(c.inp[I_GLUW] + (size_t)l * 256 * 256, 256, 256, (bf16*)(c.ws + WS_WGLU) + (size_t)l * 256 * 256, 0, scr, r, c.lane);
        }
        bf16* wsgu = (bf16*)(c.ws + WS_WSGU);
        for (int i = c.vcu * 512 + c.tid; i < 131072 / 8; i += c.G * 512) { const float* s = c.inp[I_SGUW] + (size_t)i * 8;
            v4u o; o.x = pk2(s[0], s[1]); o.y = pk2(s[2], s[3]); o.z = pk2(s[4], s[5]); o.w = pk2(s[6], s[7]); *(v4u*)(wsgu + (size_t)i * 8) = o; }
    }
    {
        f32x2* POW = (f32x2*)(c.ws + WS_POW); f32x2* BBAR = (f32x2*)(c.ws + WS_BBAR);
        for (int idx = c.vcu * 512 + c.tid; idx < 2 * 2 * 16 * 64; idx += c.G * 512) {
            const double lr = (double)c.inp[I_LRE][idx], li = (double)c.inp[I_LIM][idx], dt = exp((double)c.inp[I_LOGDT][idx >> 6]);
            for (int k = 0; k < 18; ++k) { const double kk = (k == 17) ? 256.0 : (double)k; const double mag = exp(lr * dt * kk), ang = li * dt * kk;
                POW[(size_t)idx * 18 + k] = (f32x2){(float)(mag * cos(ang)), (float)(mag * sin(ang))}; }
            const double mag = exp(lr * dt), ang = li * dt; const double abr = mag * cos(ang), abi = mag * sin(ang);
            const double nr = abr - 1.0, ni = abi, den = lr * lr + li * li;
            const double cr = (nr * lr + ni * li) / den, ci = (ni * lr - nr * li) / den;
            for (int ch = 0; ch < 16; ++ch) { const double br = (double)c.inp[I_BRE][(size_t)idx * 16 + ch], bi = (double)c.inp[I_BIM][(size_t)idx * 16 + ch];
                BBAR[(size_t)idx * 16 + ch] = (f32x2){(float)(cr * br - ci * bi), (float)(cr * bi + ci * br)}; }
        }
    }
    convert_experts(c, 0);
}

__device__ __forceinline__ void p0b_tables(const Ctx& c_) { Ctx c = c_; asm volatile("" : "+s"(c.ws), "+s"(c.inp), "+s"(c.out), "+v"(c.tid)); c.lane = c.tid & 63;
    const f32x2* POW = (const f32x2*)(c.ws + WS_POW); const f32x2* BBAR = (const f32x2*)(c.ws + WS_BBAR);
    bf16* EB = (bf16*)(c.ws + WS_EB); bf16* TG = (bf16*)(c.ws + WS_TG);
    const int gt = c.vcu * 512 + c.tid, NT = c.G * 512;
    for (int it = gt; it < 262144; it += NT) {
        const int k0 = (it & 31) * 8, n = (it >> 5) & 255, g = (it >> 13) & 15, l = it >> 17;
        const int d = n >> 7, p = (n & 127) >> 1, ri = n & 1, s = k0 >> 4, c0 = k0 & 15;
        const int cidx = ((l * 2 + d) * 16 + g) * 64 + p;
        const f32x2 pw = POW[(size_t)cidx * 18 + (d == 0 ? 15 - s : s)];
        float v[8];
#pragma unroll
        for (int j = 0; j < 8; ++j) { const f32x2 bb = BBAR[(size_t)cidx * 16 + c0 + j]; v[j] = ri ? (pw.x * bb.y + pw.y * bb.x) : (pw.x * bb.x - pw.y * bb.y); }
        v4u o; o.x = pk2(v[0], v[1]); o.y = pk2(v[2], v[3]); o.z = pk2(v[4], v[5]); o.w = pk2(v[6], v[7]);
        *(v4u*)(EB + ((size_t)((l * 16 + g) * 256 + n)) * 256 + k0) = o;
    }
    for (int it = gt; it < 524288; it += NT) {
        const int k0 = (it & 63) * 8, n = (it >> 6) & 255, g = (it >> 14) & 15, l = it >> 18;
        const int tau = n >> 4, ch = n & 15;
        float v[8];
        if (k0 < 256) {
            const int s = k0 >> 4, c0 = k0 & 15;
#pragma unroll
            for (int j = 0; j < 8; ++j) v[j] = (s == tau && (c0 + j) == ch) ? c.inp[I_S5D][l * 256 + g * 16 + ch] : 0.f;
#pragma unroll
            for (int d = 0; d < 2; ++d) {
                const int dl = d == 0 ? tau - s : s - tau;
                if (dl >= 0) {
                    const int cb = ((l * 2 + d) * 16 + g) * 64;
                    for (int p = 0; p < 64; ++p) {
                        const float cre = c.inp[I_CRE][((size_t)((l * 2 + d) * 16 + g) * 16 + ch) * 64 + p], cim = c.inp[I_CIM][((size_t)((l * 2 + d) * 16 + g) * 16 + ch) * 64 + p];
                        const f32x2 pw = POW[(size_t)(cb + p) * 18 + dl];
                        const float wr = cre * pw.x - cim * pw.y, wi = cre * pw.y + cim * pw.x;
#pragma unroll
                        for (int j = 0; j < 8; ++j) { const f32x2 bb = BBAR[(size_t)(cb + p) * 16 + c0 + j]; v[j] += wr * bb.x - wi * bb.y; }
                    }
                }
            }
        } else {
#pragma unroll
            for (int j = 0; j < 8; ++j) { const int kk = k0 - 256 + j, d = kk >> 7, p = (kk & 127) >> 1, ri = kk & 1;
                const int cidx = ((l * 2 + d) * 16 + g) * 64 + p;
                const float cre = c.inp[I_CRE][((size_t)((l * 2 + d) * 16 + g) * 16 + ch) * 64 + p], cim = c.inp[I_CIM][((size_t)((l * 2 + d) * 16 + g) * 16 + ch) * 64 + p];
                const f32x2 pw = POW[(size_t)cidx * 18 + (d == 0 ? tau + 1 : 16 - tau)];
                const float wr = cre * pw.x - cim * pw.y, wi = cre * pw.y + cim * pw.x;
                v[j] = ri ? -wi : wr; }
        }
        v4u o; o.x = pk2(v[0], v[1]); o.y = pk2(v[2], v[3]); o.z = pk2(v[4], v[5]); o.w = pk2(v[6], v[7]);
        *(v4u*)(TG + ((size_t)((l * 16 + g) * 256 + n)) * 512 + k0) = o;
    }
}

__device__ __forceinline__ void row_prep(const Ctx& c_, int mode, int l) { Ctx c = c_; asm volatile("" : "+s"(c.ws), "+s"(c.inp), "+s"(c.out), "+v"(c.tid)); c.lane = c.tid & 63; asm volatile("" : "+s"(l));
    const int gw = c.vcu * NWAVES + c.wave, NGW = c.G * NWAVES;
    const float* modv = (const float*)(c.ws + WS_MODV);
    const bf16* Y = (const bf16*)(c.ws + WS_R3); bf16* A1 = (bf16*)(c.ws + WS_R1);
    const int* smapL = (const int*)(c.ws + WS_SMAP); const int* smapC = smapL + 2 * 16 * 16384;
    float* hctx = (float*)(c.ws + WS_HCTX);
    const int nrows = (mode == 2) ? MLAT : MT;
    for (int m = gw; m < nrows; m += NGW) {
        const bool isctx = m >= MLAT; const int b = isctx ? ((m - MLAT) >> 8) : (m >> 14), t = isctx ? ((m - MLAT) & 255) : (m & 16383), mb = isctx ? 2 : b;
        const float* src = (mode == 0) ? (isctx ? c.inp[I_CTX] + (size_t)(m - MLAT) * D : c.inp[I_X] + (size_t)m * D) : (isctx ? hctx + (size_t)(m - MLAT) * D : c.out + (size_t)m * D);
        f32x4 v[4];
#pragma unroll
        for (int j = 0; j < 4; ++j) v[j] = *(const f32x4*)(src + 4 * c.lane + 256 * j);
        if (mode != 0) {
            const float* gff = modv + (size_t)((l - 1 + (mode == 2 ? 1 : 0)) * 3 + mb) * 6144 + 5 * 1024;
            f32x4 acc[4];
#pragma unroll
            for (int j = 0; j < 4; ++j) acc[j] = (f32x4){0.f, 0.f, 0.f, 0.f};
            for (int e = 0; e < NE; ++e) {
                const int slot = isctx ? smapC[(b * 16 + e) * 256 + t] : smapL[(b * 16 + e) * 16384 + t];
                if (slot >= 0) {
                    const size_t yrow = isctx ? (size_t)(XLAT + e * 256 + b * 32 + slot) : (size_t)((b * 16 + e) * CAPL + slot);
#pragma unroll
                    for (int j = 0; j < 4; ++j) { const u32x2 w = *(const u32x2*)(Y + yrow * D + 4 * c.lane + 256 * j);
                        acc[j] += (f32x4){bf2f(w.x & 0xffffu), bf2f(w.x >> 16), bf2f(w.y & 0xffffu), bf2f(w.y >> 16)}; }
                }
            }
            float* dst = isctx ? hctx + (size_t)(m - MLAT) * D : c.out + (size_t)m * D;
#pragma unroll
            for (int j = 0; j < 4; ++j) { v[j] += *(const f32x4*)(gff + 4 * c.lane + 256 * j) * acc[j]; *(f32x4*)(dst + 4 * c.lane + 256 * j) = v[j]; }
        }
        if (mode == 2) continue;
        float ss = 0.f;
#pragma unroll
        for (int j = 0; j < 4; ++j) ss += (v[j].x * v[j].x + v[j].y * v[j].y) + (v[j].z * v[j].z + v[j].w * v[j].w);
        const float rstd = 1.0f / sqrtf(wave_sum(ss) * (1.0f / D) + EPS);
        const float* mo = modv + (size_t)(l * 3 + mb) * 6144; const float* gn = c.inp[I_NMIXG] + l * D;
#pragma unroll
        for (int j = 0; j < 4; ++j) { const int col = 4 * c.lane + 256 * j;
            const f32x4 g = *(const f32x4*)(gn + col), sh = *(const f32x4*)(mo + col), sc = *(const f32x4*)(mo + 1024 + col);
            const f32x4 a = v[j] * rstd * g * (sc + 1.0f) + sh;
            u32x2 w; w.x = pk2(a.x, a.y); w.y = pk2(a.z, a.w); *(u32x2*)(A1 + (size_t)m * D + col) = w; }
    }
}

__device__ __forceinline__ f32x4 mfma16(bf16x8 a, bf16x8 b, f32x4 c) { return __builtin_amdgcn_mfma_f32_16x16x32_bf16(a, b, c, 0, 0, 0); }
__device__ __forceinline__ f32x16 mfma32(bf16x8 a, bf16x8 b, f32x16 c) { return __builtin_amdgcn_mfma_f32_32x32x16_bf16(a, b, c, 0, 0, 0); }

__device__ __forceinline__ void qk_prep_rows(const Ctx& c_, int l, int chunk) { Ctx c = c_; asm volatile("" : "+s"(c.ws), "+s"(c.inp), "+s"(c.out), "+v"(c.tid)); c.lane = c.tid & 63; asm volatile("" : "+s"(l));
    bf16* P = (bf16*)(c.ws + WS_R2);
    const float qg = c.inp[I_QNG][l * 64 + c.lane], kg = c.inp[I_KNG][l * 64 + c.lane];
    const int i16 = c.lane & 15;
    const float inv = exp2f(-(float)(2 * i16) * (13.287712379549449f / 32.0f));
    for (int rr = 0; rr < 16; ++rr) {
        const int m = chunk * 128 + c.wave * 16 + rr;
        const bool isctx = m >= MLAT;
        float cs = 1.f, sn = 0.f;
        if (!isctx) { const int n = m & 16383; const float pos = (float)((c.lane < 32) ? (n >> 6) : (n & 63)); sincosf(pos * inv, &sn, &cs); }
        bf16* row = P + (size_t)m * INW;
#pragma unroll
        for (int h = 0; h < 10; ++h) {
            const float x = bf2f(row[h * 64 + c.lane]);
            const float rstd = 1.0f / sqrtf(wave_sum(x * x) * (1.0f / 64.0f) + EPS);
            float xn = x * rstd * (h < 8 ? qg : kg);
            const float pr = __shfl_xor(xn, 16);
            float o = (c.lane & 16) ? (xn * cs + pr * sn) : (xn * cs - pr * sn);
            if (h < 8) o *= 0.125f * LOG2E;
            row[h * 64 + c.lane] = (bf16)f2bf(o);
        }
    }
}
__device__ __forceinline__ void s5_e_unit(const Ctx& c_, int l, int tile) { Ctx c = c_; asm volatile("" : "+s"(c.ws), "+s"(c.inp), "+s"(c.out), "+v"(c.tid)); c.lane = c.tid & 63; asm volatile("" : "+s"(l));
    const bf16* P = (const bf16*)(c.ws + WS_R2); float* E = (float*)(c.ws + WS_R2 + 98 * MiB); float* E2 = (float*)(c.ws + WS_E2);
    const bf16* EB = (const bf16*)(c.ws + WS_EB) + (size_t)l * 16 * 256 * 256; const f32x2* POW = (const f32x2*)(c.ws + WS_POW);
    const int fr = c.lane & 15, fq = c.lane >> 4;
    LAS float* Ew = (LAS float*)(c.lds + RING_OFF + c.wave * 16384);
    for (int gi = 0; gi < 2; ++gi) {
        const int g = 2 * c.wave + gi;
        bf16x8 a[8];
#pragma unroll
        for (int ks = 0; ks < 8; ++ks) a[ks] = *(const bf16x8*)(P + (size_t)(tile * 256 + 16 * fr + 2 * ks + (fq >> 1)) * INW + 768 + 16 * g + 8 * (fq & 1));
        const bf16* EBg = EB + (size_t)g * 256 * 256;
#pragma unroll 2
        for (int nt = 0; nt < 16; ++nt) {
            f32x4 acc = (f32x4){0.f, 0.f, 0.f, 0.f};
#pragma unroll
            for (int ks = 0; ks < 8; ++ks) { const bf16x8 b = *(const bf16x8*)(EBg + (size_t)(16 * nt + fr) * 256 + 32 * ks + 8 * fq); acc = mfma16(b, a[ks], acc); }
            *(f32x4*)(E + ((size_t)(tile * 16 + fr) * 16 + g) * 256 + 16 * nt + 4 * fq) = acc;
            *(LAS f32x4*)(Ew + fr * 256 + 16 * nt + 4 * fq) = acc;
        }
        LDS_WAIT(); asm volatile("" ::: "memory");
#pragma unroll
        for (int d = 0; d < 2; ++d) {
            const f32x2 a16 = POW[(size_t)(((l * 2 + d) * 16 + g) * 64 + c.lane) * 18 + 16];
            float hr = 0.f, hi = 0.f;
#pragma unroll
            for (int j = 0; j < 16; ++j) { const int sc = d == 0 ? j : 15 - j; const f32x2 e = *(const LAS f32x2*)(Ew + sc * 256 + d * 128 + 2 * c.lane);
                const float nr = a16.x * hr - a16.y * hi + e.x, ni = a16.x * hi + a16.y * hr + e.y; hr = nr; hi = ni; }
            *(f32x2*)(E2 + ((size_t)tile * 16 + g) * 256 + d * 128 + 2 * c.lane) = (f32x2){hr, hi};
        }
        LDS_WAIT(); asm volatile("" ::: "memory");
    }
}

__device__ __forceinline__ void s5_carry_unit(const Ctx& c_, int l, int unit) { Ctx c = c_; asm volatile("" : "+s"(c.ws), "+s"(c.inp), "+s"(c.out), "+v"(c.tid)); c.lane = c.tid & 63; asm volatile("" : "+s"(l));
    const float* E2 = (const float*)(c.ws + WS_E2); float* Hin2 = (float*)(c.ws + WS_HIN2); const f32x2* POW = (const f32x2*)(c.ws + WS_POW);
    const int ch = unit * 512 + c.tid;
    const int p = ch & 63, g = (ch >> 6) & 15, d = (ch >> 10) & 1, b = ch >> 11;
    const f32x2 a = POW[(size_t)(((l * 2 + d) * 16 + g) * 64 + p) * 18 + 17];
    const size_t cofs = (size_t)g * 256 + d * 128 + 2 * p;
    float hr = 0.f, hi = 0.f;
    for (int s0 = 0; s0 < 65; s0 += 13) {
        f32x2 e[13]; int tl[13];
#pragma unroll
        for (int j = 0; j < 13; ++j) { const int s = s0 + j; tl[j] = (s == 0) ? (128 + b) : (d == 0 ? b * 64 + (s - 1) : b * 64 + (64 - s)); e[j] = *(const f32x2*)(E2 + (size_t)tl[j] * 4096 + cofs); }
#pragma unroll
        for (int j = 0; j < 13; ++j) { *(f32x2*)(Hin2 + (size_t)tl[j] * 4096 + cofs) = (f32x2){hr, hi};
            const float nr = a.x * hr - a.y * hi + e[j].x, ni = a.x * hi + a.y * hr + e[j].y; hr = nr; hi = ni; }
    }
}

constexpr int ATT_ROWB = 144;
constexpr int ATT_K_OFF = 0, ATT_V_OFF = 64 * ATT_ROWB;
__device__ __forceinline__ void attn_unit(const Ctx& c_, int l, int unit) { Ctx c = c_; asm volatile("" : "+s"(c.ws), "+s"(c.inp), "+s"(c.out), "+v"(c.tid)); c.lane = c.tid & 63; asm volatile("" : "+s"(l));
    const bf16* P = (const bf16*)(c.ws + WS_R2); bf16* mix = (bf16*)(c.ws + WS_R1);
    int b, kvh, qb; bool isctx;
    if (unit < 512) { b = unit >> 8; kvh = (unit >> 7) & 1; qb = unit & 127; isctx = false; }
    else { const int u2 = unit - 512; b = u2 >> 2; kvh = (u2 >> 1) & 1; qb = u2 & 1; isctx = true; }
    const int r32 = c.lane & 31, hi = c.lane >> 5, wsub = c.wave & 1;
    const int hq = kvh * 4 + (c.wave >> 1);
    const float sink2 = c.inp[I_SINK][l * 8 + hq] * LOG2E;
    const int q4 = (c.lane & 15) >> 2, p4 = c.lane & 3, d0 = 16 * ((c.lane >> 4) & 1);
    const int vlane_off = (4 * hi + q4) * ATT_ROWB + (d0 + 4 * p4) * 2;
#pragma unroll 1
    for (int qg = 0; qg < 2; ++qg) {
        const int qrow = (isctx ? (MLAT + b * LC + qb * 128) : (b * SEQ + qb * 128)) + 64 * wsub + 32 * qg + r32;
        bf16x8 qf[4];
#pragma unroll
        for (int ks = 0; ks < 4; ++ks) qf[ks] = *(const bf16x8*)(P + (size_t)qrow * INW + 64 * hq + 16 * ks + 8 * hi);
        float m_run = sink2, l_run = hi == 0 ? 1.0f : 0.0f; f32x16 o[2];
#pragma unroll
        for (int dt = 0; dt < 2; ++dt)
#pragma unroll
            for (int r = 0; r < 16; ++r) o[dt][r] = 0.f;
#pragma unroll 1
        for (int t = isctx ? 6 : 0; t < 10; ++t) {
            int krow0; const bool win = t < 6;
            if (win) { const int kp0 = 128 * (qb - 1) + 64 * t; if (kp0 < 0 || kp0 >= SEQ) continue; krow0 = b * SEQ + kp0; }
            else krow0 = MLAT + b * LC + 64 * (t - 6);
            __syncthreads();
            { const int key = c.tid >> 3, chk = c.tid & 7; const bf16* src = P + (size_t)(krow0 + key) * INW + 64 * kvh + 8 * chk;
              const v4u kv = *(const v4u*)(src + 512), vv = *(const v4u*)(src + 640);
              *(LAS v4u*)(c.lds + ATT_K_OFF + key * ATT_ROWB + chk * 16) = kv; *(LAS v4u*)(c.lds + ATT_V_OFF + key * ATT_ROWB + chk * 16) = vv; }
            LDS_WAIT(); __syncthreads();
            f32x16 s0, s1;
#pragma unroll
            for (int r = 0; r < 16; ++r) { s0[r] = 0.f; s1[r] = 0.f; }
#pragma unroll
            for (int ks = 0; ks < 4; ++ks) {
                const bf16x8 k0 = *(const LAS bf16x8*)(c.lds + ATT_K_OFF + r32 * ATT_ROWB + (16 * ks + 8 * hi) * 2);
                const bf16x8 k1 = *(const LAS bf16x8*)(c.lds + ATT_K_OFF + (32 + r32) * ATT_ROWB + (16 * ks + 8 * hi) * 2);
                s0 = mfma32(k0, qf[ks], s0); s1 = mfma32(k1, qf[ks], s1);
            }
            if (win) {
                const int qp = 128 * qb + 64 * wsub + 32 * qg + r32, kb = 128 * (qb - 1) + 64 * t + 4 * hi;
#pragma unroll
                for (int r = 0; r < 16; ++r) { const int dk = kb + (r & 3) + 8 * (r >> 2) - qp;
                    if (dk > 128 || dk < -128) s0[r] = -INFINITY;
                    if (dk + 32 > 128 || dk + 32 < -128) s1[r] = -INFINITY; }
            }
            float mx = s0[0];
#pragma unroll
            for (int r = 1; r < 16; ++r) mx = fmaxf(mx, s0[r]);
#pragma unroll
            for (int r = 0; r < 16; ++r) mx = fmaxf(mx, s1[r]);
            mx = fmaxf(mx, __shfl_xor(mx, 32));
            const float mn = fmaxf(m_run, mx), alpha = __builtin_amdgcn_exp2f(m_run - mn);
            m_run = mn;
            float sum = 0.f;
#pragma unroll
            for (int r = 0; r < 16; ++r) { s0[r] = __builtin_amdgcn_exp2f(s0[r] - mn); s1[r] = __builtin_amdgcn_exp2f(s1[r] - mn); sum += s0[r] + s1[r]; }
            l_run = l_run * alpha + sum;
#pragma unroll
            for (int dt = 0; dt < 2; ++dt)
#pragma unroll
                for (int r = 0; r < 16; ++r) o[dt][r] *= alpha;
#pragma unroll
            for (int kh = 0; kh < 2; ++kh)
#pragma unroll
                for (int s2 = 0; s2 < 2; ++s2) {
                    v4u pw;
                    if (kh == 0) { pw.x = pk2(s0[8 * s2 + 0], s0[8 * s2 + 1]); pw.y = pk2(s0[8 * s2 + 2], s0[8 * s2 + 3]); pw.z = pk2(s0[8 * s2 + 4], s0[8 * s2 + 5]); pw.w = pk2(s0[8 * s2 + 6], s0[8 * s2 + 7]); }
                    else         { pw.x = pk2(s1[8 * s2 + 0], s1[8 * s2 + 1]); pw.y = pk2(s1[8 * s2 + 2], s1[8 * s2 + 3]); pw.z = pk2(s1[8 * s2 + 4], s1[8 * s2 + 5]); pw.w = pk2(s1[8 * s2 + 6], s1[8 * s2 + 7]); }
                    const bf16x8 pf = __builtin_bit_cast(bf16x8, pw);
#pragma unroll
                    for (int dt = 0; dt < 2; ++dt) {
                        LAS unsigned char* vp = c.lds + ATT_V_OFF + (32 * kh + 16 * s2) * ATT_ROWB + 64 * dt + vlane_off;
                        const v4i16_t lo = __builtin_amdgcn_ds_read_tr16_b64_v4i16((LAS v4i16_t*)vp);
                        const v4i16_t h8 = __builtin_amdgcn_ds_read_tr16_b64_v4i16((LAS v4i16_t*)(vp + 8 * ATT_ROWB));
                        const bf16x8 vf = (bf16x8){lo[0], lo[1], lo[2], lo[3], h8[0], h8[1], h8[2], h8[3]};
                        o[dt] = mfma32(vf, pf, o[dt]);
                    }
                }
        }
        const float lt = l_run + __shfl_xor(l_run, 32), il = 1.0f / lt;
        bf16* orow = mix + (size_t)qrow * D + 64 * hq + 4 * hi;
#pragma unroll
        for (int dt = 0; dt < 2; ++dt)
#pragma unroll
            for (int rr = 0; rr < 4; ++rr) { u32x2 w; w.x = pk2(o[dt][4 * rr] * il, o[dt][4 * rr + 1] * il); w.y = pk2(o[dt][4 * rr + 2] * il, o[dt][4 * rr + 3] * il);
                *(u32x2*)(orow + 32 * dt + 8 * rr) = w; }
    }
}

constexpr int SGU_ROWB = 272;
__device__ __forceinline__ void sgu_unit(const Ctx& c_, int l, int chunk) { Ctx c = c_; asm volatile("" : "+s"(c.ws), "+s"(c.inp), "+s"(c.out), "+v"(c.tid)); c.lane = c.tid & 63; asm volatile("" : "+s"(l));
    const bf16* P = (const bf16*)(c.ws + WS_R2); bf16* mix = (bf16*)(c.ws + WS_R1);
    const bf16* Ws = (const bf16*)(c.ws + WS_WSGU) + (size_t)l * 4 * 128 * 128;
    const int r0 = chunk * 128, fr = c.lane & 15, fq = c.lane >> 4;
    __syncthreads();
    { const f32x4 gn = *(const f32x4*)(c.inp[I_SGUNG] + l * 256 + 4 * c.lane);
      for (int rr = 0; rr < 16; ++rr) { const int s = c.wave * 16 + rr;
        const u32x2 w = *(const u32x2*)(P + (size_t)(r0 + s) * INW + 1280 + 4 * c.lane);
        const float v0 = gelu_tanh(bf2f(w.x & 0xffffu)), v1 = gelu_tanh(bf2f(w.x >> 16)), v2 = gelu_tanh(bf2f(w.y & 0xffffu)), v3 = gelu_tanh(bf2f(w.y >> 16));
        const float rstd = 1.0f / sqrtf(wave_sum((v0 * v0 + v1 * v1) + (v2 * v2 + v3 * v3)) * (1.0f / 256.0f) + EPS);
        LAS bf16* vt = (LAS bf16*)(c.lds + (4 * c.lane) * SGU_ROWB + s * 2);
        vt[0] = (bf16)f2bf(v0 * rstd * gn.x); vt[SGU_ROWB / 2] = (bf16)f2bf(v1 * rstd * gn.y); vt[SGU_ROWB] = (bf16)f2bf(v2 * rstd * gn.z); vt[3 * SGU_ROWB / 2] = (bf16)f2bf(v3 * rstd * gn.w); } }
    LDS_WAIT(); __syncthreads();
    const int gg = c.wave >> 1, th = c.wave & 1;
    bf16x8 a[4][4];
#pragma unroll
    for (int mt = 0; mt < 4; ++mt)
#pragma unroll
        for (int ks = 0; ks < 4; ++ks) a[mt][ks] = *(const bf16x8*)(Ws + ((size_t)gg * 128 + 64 * th + 16 * mt + fr) * 128 + 32 * ks + 8 * fq);
#pragma unroll
    for (int nt = 0; nt < 4; ++nt) {
        f32x4 acc[4];
#pragma unroll
        for (int mt = 0; mt < 4; ++mt) acc[mt] = (f32x4){0.f, 0.f, 0.f, 0.f};
#pragma unroll
        for (int ks = 0; ks < 4; ++ks) { const bf16x8 bfr = *(const LAS bf16x8*)(c.lds + (64 * gg + 16 * nt + fr) * SGU_ROWB + (32 * ks + 8 * fq) * 2);
#pragma unroll
            for (int mt = 0; mt < 4; ++mt) acc[mt] = mfma16(bfr, a[mt][ks], acc[mt]); }
#pragma unroll
        for (int mt = 0; mt < 4; ++mt) { const int t = 64 * th + 16 * mt + fr, ch = 64 * gg + 16 * nt + 4 * fq;
            const float bs = c.inp[I_SGUB][(l * 4 + gg) * 128 + t];
            const u32x2 w = *(const u32x2*)(P + (size_t)(r0 + t) * INW + 1024 + ch);
            const float u0 = gelu_tanh(bf2f(w.x & 0xffffu)), u1 = gelu_tanh(bf2f(w.x >> 16)), u2 = gelu_tanh(bf2f(w.y & 0xffffu)), u3 = gelu_tanh(bf2f(w.y >> 16));
            u32x2 ow; ow.x = pk2(u0 * (acc[mt][0] + bs), u1 * (acc[mt][1] + bs)); ow.y = pk2(u2 * (acc[mt][2] + bs), u3 * (acc[mt][3] + bs));
            *(u32x2*)(mix + (size_t)(r0 + t) * D + 768 + ch) = ow; }
    }
}

constexpr int HS_ROWB = 528;
__device__ __forceinline__ void s5_out_unit(const Ctx& c_, int l, int tile) { Ctx c = c_; asm volatile("" : "+s"(c.ws), "+s"(c.inp), "+s"(c.out), "+v"(c.tid)); c.lane = c.tid & 63; asm volatile("" : "+s"(l));
    const bf16* P = (const bf16*)(c.ws + WS_R2); const float* E = (const float*)(c.ws + WS_R2 + 98 * MiB); const float* Hin2 = (const float*)(c.ws + WS_HIN2);
    const bf16* TG = (const bf16*)(c.ws + WS_TG) + (size_t)l * 16 * 256 * 512; const f32x2* POW = (const f32x2*)(c.ws + WS_POW);
    bf16* mix = (bf16*)(c.ws + WS_R1); bf16* Gs = (bf16*)(c.ws + WS_R1 + 66 * MiB); bf16* mixn = (bf16*)(c.ws + WS_R3);
    const bf16* Wglu = (const bf16*)(c.ws + WS_WGLU) + (size_t)l * 256 * 256;
    const int fr = c.lane & 15, fq = c.lane >> 4;
    LAS unsigned char* Hs = c.lds + RING_OFF + c.wave * (16 * HS_ROWB);
    for (int gi = 0; gi < 2; ++gi) {
        const int g = 2 * c.wave + gi;
#pragma unroll
        for (int d = 0; d < 2; ++d) {
            const f32x2 a16 = POW[(size_t)(((l * 2 + d) * 16 + g) * 64 + c.lane) * 18 + 16];
            const f32x2 h0 = *(const f32x2*)(Hin2 + ((size_t)tile * 16 + g) * 256 + d * 128 + 2 * c.lane);
            float hr = h0.x, hi = h0.y;
            f32x2 e[16];
#pragma unroll
            for (int j = 0; j < 16; ++j) { const int sc = d == 0 ? j : 15 - j; e[j] = *(const f32x2*)(E + ((size_t)(tile * 16 + sc) * 16 + g) * 256 + d * 128 + 2 * c.lane); }
#pragma unroll
            for (int j = 0; j < 16; ++j) { const int sc = d == 0 ? j : 15 - j;
                *(LAS unsigned*)(Hs + sc * HS_ROWB + (d * 128 + 2 * c.lane) * 2) = pk2(hr, hi);
                const float nr = a16.x * hr - a16.y * hi + e[j].x, ni = a16.x * hi + a16.y * hr + e[j].y; hr = nr; hi = ni; }
        }
        LDS_WAIT(); asm volatile("" ::: "memory");
        bf16x8 a[16];
#pragma unroll
        for (int ks = 0; ks < 8; ++ks) a[ks] = *(const bf16x8*)(P + (size_t)(tile * 256 + 16 * fr + 2 * ks + (fq >> 1)) * INW + 768 + 16 * g + 8 * (fq & 1));
#pragma unroll
        for (int ks = 0; ks < 8; ++ks) a[8 + ks] = *(const LAS bf16x8*)(Hs + fr * HS_ROWB + (32 * ks + 8 * fq) * 2);
        const bf16* TGg = TG + (size_t)g * 256 * 512;
#pragma unroll 2
        for (int nt = 0; nt < 16; ++nt) {
            f32x4 acc = (f32x4){0.f, 0.f, 0.f, 0.f};
#pragma unroll
            for (int ks = 0; ks < 16; ++ks) { const bf16x8 b = *(const bf16x8*)(TGg + (size_t)(16 * nt + fr) * 512 + 32 * ks + 8 * fq); acc = mfma16(b, a[ks], acc); }
            u32x2 w; w.x = pk2(gelu_tanh(acc[0]), gelu_tanh(acc[1])); w.y = pk2(gelu_tanh(acc[2]), gelu_tanh(acc[3]));
            *(u32x2*)(Gs + (size_t)(tile * 256 + 16 * fr + nt) * 256 + 16 * g + 4 * fq) = w;
        }
        LDS_WAIT(); asm volatile("" ::: "memory");
    }
    WG_SYNC();
#pragma unroll 1
    for (int mt = 0; mt < 2; ++mt) {
        const int row = tile * 256 + 32 * c.wave + 16 * mt + fr;
        bf16x8 a[8];
#pragma unroll
        for (int ks = 0; ks < 8; ++ks) a[ks] = *(const bf16x8*)(Gs + (size_t)row * 256 + 32 * ks + 8 * fq);
#pragma unroll 2
        for (int nt = 0; nt < 16; ++nt) {
            f32x4 acc = (f32x4){0.f, 0.f, 0.f, 0.f};
#pragma unroll
            for (int ks = 0; ks < 8; ++ks) { const bf16x8 b = *(const bf16x8*)(Wglu + (size_t)(16 * nt + fr) * 256 + 32 * ks + 8 * fq); acc = mfma16(b, a[ks], acc); }
            const int ch = 16 * nt + 4 * fq;
            const f32x4 gb = *(const f32x4*)(c.inp[I_GLUB] + l * 256 + ch);
            const u32x2 gw = *(const u32x2*)(Gs + (size_t)row * 256 + ch);
            const float g0 = bf2f(gw.x & 0xffffu), g1 = bf2f(gw.x >> 16), g2 = bf2f(gw.y & 0xffffu), g3 = bf2f(gw.y >> 16);
            const float o0 = g0 / (1.0f + __expf(-(acc[0] + gb.x))), o1 = g1 / (1.0f + __expf(-(acc[1] + gb.y))), o2 = g2 / (1.0f + __expf(-(acc[2] + gb.z))), o3 = g3 / (1.0f + __expf(-(acc[3] + gb.w)));
            u32x2 w; w.x = pk2(o0, o1); w.y = pk2(o2, o3);
            *(u32x2*)(mix + (size_t)row * D + 512 + ch) = w;
        }
    }
    WG_SYNC();
    const float* og = c.inp[I_ONG] + l * D;
    for (int rr = 0; rr < 32; ++rr) {
        const int row = tile * 256 + 32 * c.wave + rr;
        float x[2][8]; float ss[2];
#pragma unroll
        for (int j = 0; j < 2; ++j) { const v4u w = *(const v4u*)(mix + (size_t)row * D + 8 * c.lane + 512 * j);
            x[j][0] = bf2f(w.x & 0xffffu); x[j][1] = bf2f(w.x >> 16); x[j][2] = bf2f(w.y & 0xffffu); x[j][3] = bf2f(w.y >> 16);
            x[j][4] = bf2f(w.z & 0xffffu); x[j][5] = bf2f(w.z >> 16); x[j][6] = bf2f(w.w & 0xffffu); x[j][7] = bf2f(w.w >> 16);
            float s = 0.f;
#pragma unroll
            for (int i = 0; i < 8; ++i) s += x[j][i] * x[j][i];
            ss[j] = s; }
        const float s_att = wave_sum(ss[0]), s_s5 = wave_sum(c.lane < 32 ? ss[1] : 0.f), s_sgu = wave_sum(c.lane < 32 ? 0.f : ss[1]);
        const float r_att = 1.0f / sqrtf(s_att * (1.0f / 512.0f) + EPS), r_b = 1.0f / sqrtf((c.lane < 32 ? s_s5 : s_sgu) * (1.0f / 256.0f) + EPS);
#pragma unroll
        for (int j = 0; j < 2; ++j) { const int col = 8 * c.lane + 512 * j; const float r = j == 0 ? r_att : r_b;
            const f32x4 ga = *(const f32x4*)(og + col), gb = *(const f32x4*)(og + col + 4);
            v4u w; w.x = pk2(x[j][0] * r * ga.x, x[j][1] * r * ga.y); w.y = pk2(x[j][2] * r * ga.z, x[j][3] * r * ga.w);
            w.z = pk2(x[j][4] * r * gb.x, x[j][5] * r * gb.y); w.w = pk2(x[j][6] * r * gb.z, x[j][7] * r * gb.w);
            *(v4u*)(mixn + (size_t)row * D + col) = w; }
    }
}

__device__ __forceinline__ void ffn_prep(const Ctx& c_, int l, int nrows) { Ctx c = c_; asm volatile("" : "+s"(c.ws), "+s"(c.inp), "+s"(c.out), "+v"(c.tid)); c.lane = c.tid & 63; asm volatile("" : "+s"(l));
    const int gw = c.vcu * NWAVES + c.wave, NGW = c.G * NWAVES;
    const float* modv = (const float*)(c.ws + WS_MODV); bf16* F = (bf16*)(c.ws + WS_R3 + 66 * MiB);
    float* probsL = (float*)(c.ws + WS_PROBS); float* probsC = probsL + 2 * 16 * 16384;
    const float* hctx = (const float*)(c.ws + WS_HCTX); const float* rw = c.inp[I_ROUTW] + (size_t)l * D * NE;
    for (int m = gw; m < nrows; m += NGW) {
        const bool isctx = m >= MLAT; const int b = isctx ? ((m - MLAT) >> 8) : (m >> 14), t = isctx ? ((m - MLAT) & 255) : (m & 16383), mb = isctx ? 2 : b;
        const float* src = isctx ? hctx + (size_t)(m - MLAT) * D : c.out + (size_t)m * D;
        f32x4 v[4]; float ss = 0.f;
#pragma unroll
        for (int j = 0; j < 4; ++j) { v[j] = *(const f32x4*)(src + 4 * c.lane + 256 * j); ss += (v[j].x * v[j].x + v[j].y * v[j].y) + (v[j].z * v[j].z + v[j].w * v[j].w); }
        const float rstd = 1.0f / sqrtf(wave_sum(ss) * (1.0f / D) + EPS);
        const float* mo = modv + (size_t)(l * 3 + mb) * 6144; const float* gn = c.inp[I_NFFNG] + l * D;
        float lg[16];
#pragma unroll
        for (int e = 0; e < 16; ++e) lg[e] = 0.f;
#pragma unroll
        for (int j = 0; j < 4; ++j) { const int col = 4 * c.lane + 256 * j;
            const f32x4 g = *(const f32x4*)(gn + col), sh = *(const f32x4*)(mo + 3 * 1024 + col), sc = *(const f32x4*)(mo + 4 * 1024 + col);
            const f32x4 a = v[j] * rstd * g * (sc + 1.0f) + sh;
            u32x2 w; w.x = pk2(a.x, a.y); w.y = pk2(a.z, a.w); *(u32x2*)(F + (size_t)m * D + col) = w;
#pragma unroll
            for (int i = 0; i < 4; ++i) { const float ai = a[i]; const float* rr = rw + (size_t)(col + i) * NE;
#pragma unroll
                for (int q = 0; q < 4; ++q) { const f32x4 r4 = *(const f32x4*)(rr + 4 * q); lg[4 * q] += ai * r4.x; lg[4 * q + 1] += ai * r4.y; lg[4 * q + 2] += ai * r4.z; lg[4 * q + 3] += ai * r4.w; } } }
        float mx = -INFINITY;
#pragma unroll
        for (int e = 0; e < 16; ++e) { lg[e] = wave_sum(lg[e]); mx = fmaxf(mx, lg[e]); }
        float den = 0.f;
#pragma unroll
        for (int e = 0; e < 16; ++e) { lg[e] = expf(lg[e] - mx); den += lg[e]; }
        float mine = 0.f;
#pragma unroll
        for (int e = 0; e < 16; ++e) mine = (c.lane == e) ? lg[e] : mine;
        mine = mine / den;
        if (c.lane < 16) { if (isctx) probsC[(b * 16 + c.lane) * 256 + t] = mine; else probsL[(b * 16 + c.lane) * 16384 + t] = mine; }
    }
}

__device__ __forceinline__ int block_excl_scan(const Ctx& c, int v, volatile LAS int* tmp, int& total) {
    int inc = v;
#pragma unroll
    for (int o = 1; o < 64; o <<= 1) { const int y = __shfl_up(inc, o); if (c.lane >= o) inc += y; }
    __syncthreads();
    if (c.lane == 63) tmp[c.wave] = inc;
    __syncthreads();
    int base = 0, tot = 0;
#pragma unroll
    for (int w = 0; w < 8; ++w) { const int x = tmp[w]; if (w < c.wave) base += x; tot += x; }
    total = tot;
    return base + inc - v;
}
__device__ __forceinline__ void select_unit(const Ctx& c_, int unit) { Ctx c = c_; asm volatile("" : "+s"(c.ws), "+s"(c.inp), "+s"(c.out), "+v"(c.tid)); c.lane = c.tid & 63;
    const bool isctx = unit >= 32; const int be = isctx ? unit - 32 : unit, b = be >> 4, e = be & 15;
    const int N = isctx ? 256 : 16384, cap = isctx ? CAPC : CAPL;
    const float* probs = (const float*)(c.ws + WS_PROBS) + (isctx ? 2 * 16 * 16384 + be * 256 : be * 16384);
    int* smap = (int*)(c.ws + WS_SMAP) + (isctx ? 2 * 16 * 16384 + be * 256 : be * 16384);
    int* idx = (int*)(c.ws + WS_IDX); float* gate = (float*)(c.ws + WS_GATE);
    const int rowbase = isctx ? (XLAT + e * 256 + b * 32) : be * CAPL;
    const int tokbase = isctx ? (MLAT + b * LC) : b * SEQ;
    LAS unsigned* keys = (LAS unsigned*)(c.lds + RING_OFF);
    volatile LAS unsigned* hist = (volatile LAS unsigned*)(c.lds + RING_OFF + 65536);
    volatile LAS int* tmp = (volatile LAS int*)(c.lds + RING_OFF + 65536 + 1024);
    __syncthreads();
    for (int i = c.tid; i < N; i += 512) keys[i] = __float_as_uint(probs[i]);
    unsigned prefix = 0; int remaining = cap;
    for (int pass = 0; pass < 4; ++pass) {
        const int shift = 24 - 8 * pass;
        if (c.tid < 256) hist[c.tid] = 0u;
        __syncthreads();
        for (int i = c.tid; i < N; i += 512) { const unsigned k = keys[i];
            if (pass == 0 || (k >> (shift + 8)) == (prefix >> (shift + 8))) __hip_atomic_fetch_add((LAS unsigned*)&hist[(k >> shift) & 255u], 1u, __ATOMIC_RELAXED, __HIP_MEMORY_SCOPE_WORKGROUP); }
        __syncthreads();
        if (c.tid == 0) { int cum = 0, dsel = 0, rem = remaining;
            for (int d = 255; d >= 0; --d) { const int h = (int)hist[d]; if (cum + h >= remaining) { dsel = d; rem = remaining - cum; break; } cum += h; }
            tmp[16] = dsel; tmp[17] = rem; }
        __syncthreads();
        prefix |= ((unsigned)tmp[16]) << shift; remaining = tmp[17];
        __syncthreads();
    }
    const int per = N / 512;
    const int cnt = isctx ? (c.tid < 256 ? 1 : 0) : per, i0 = isctx ? c.tid : c.tid * per;
    int neq = 0;
    for (int i = 0; i < cnt; ++i) neq += (keys[i0 + i] == prefix) ? 1 : 0;
    int tot; int eqbase = block_excl_scan(c, neq, tmp, tot);
    int nsel = 0;
    { int er = eqbase; for (int i = 0; i < cnt; ++i) { const unsigned k = keys[i0 + i]; if (k > prefix) ++nsel; else if (k == prefix) { if (er < remaining) ++nsel; ++er; } } }
    int slot = block_excl_scan(c, nsel, tmp, tot);
    { int er = eqbase; for (int i = 0; i < cnt; ++i) { const unsigned k = keys[i0 + i]; bool sel = false;
        if (k > prefix) sel = true; else if (k == prefix) { sel = er < remaining; ++er; }
        if (sel && slot < cap) { smap[i0 + i] = slot; idx[rowbase + slot] = tokbase + i0 + i; gate[rowbase + slot] = __uint_as_float(k); ++slot; } else smap[i0 + i] = -1; } }
}

__device__ __forceinline__ void gather_rows(const Ctx& c_, bool with_ctx) { Ctx c = c_; asm volatile("" : "+s"(c.ws), "+s"(c.inp), "+s"(c.out), "+v"(c.tid)); c.lane = c.tid & 63;
    const int gw = c.vcu * NWAVES + c.wave, NGW = c.G * NWAVES;
    const bf16* F = (const bf16*)(c.ws + WS_R3 + 66 * MiB); bf16* xin = (bf16*)(c.ws + WS_R1); const int* idx = (const int*)(c.ws + WS_IDX);
    const int nrows = with_ctx ? XROWS : XLAT;
    for (int r = gw; r < nrows; r += NGW) {
        const bool valid = r < XLAT || ((r - XLAT) & 255) < 64;
        v4u a = (v4u){0u, 0u, 0u, 0u}, b2 = a;
        if (valid) { const bf16* s = F + (size_t)idx[r] * D; a = *(const v4u*)(s + 8 * c.lane); b2 = *(const v4u*)(s + 512 + 8 * c.lane); }
        *(v4u*)(xin + (size_t)r * D + 8 * c.lane) = a; *(v4u*)(xin + (size_t)r * D + 512 + 8 * c.lane) = b2;
    }
}

#ifndef MK_N_LAUNCHES
#define MK_N_LAUNCHES 24
#endif
constexpr int N_PHASES = 24;
constexpr int N_LAUNCHES = MK_N_LAUNCHES;
static_assert(N_LAUNCHES == 1 || N_LAUNCHES == N_PHASES, "MK_N_LAUNCHES is 1 or 24");

__global__ void __launch_bounds__(NWAVES * 64, 2) mega_fwd(Args args) {
    extern __shared__ __attribute__((aligned(16))) unsigned char lds[];
    Ctx c;
    c.lds = (LAS unsigned char*)lds; c.MISC = (volatile LAS unsigned*)(c.lds + MISC_OFF);
    c.tid = threadIdx.x; c.lane = c.tid & 63; c.wave = __builtin_amdgcn_readfirstlane(c.tid >> 6);
    c.G = gridDim.x; { const int bx = blockIdx.x; c.vcu = (c.G % 8 == 0) ? (bx % 8) * (c.G / 8) + bx / 8 : bx; }
    c.inp = (kfptr*)__builtin_amdgcn_kernarg_segment_ptr();
    c.out = args.out; c.ws = args.ws; c.ctl = (gu32*)(args.ws + WS_CTL);
    for (int u = c.tid; u < (LDS_BYTES - LDSCTL_OFF) / 4; u += NWAVES * 64) ((LAS unsigned*)(c.lds + LDSCTL_OFF))[u] = 0u;
    __syncthreads();
    XcdBarrier bar; bar.bar = (unsigned*)(c.ctl + CW_BAR); bar.x = 0; bar.st = nullptr;
    if (N_LAUNCHES == 1) bar = xcd_barrier_post((unsigned*)(c.ctl + CW_BAR), c.MISC + 8);
    const int lo = args.ph_lo, hi = args.ph_hi;
#ifndef KIND_MASK
#define KIND_MASK 0x1fff
#endif
#define KIND_OF(k) ((k) < 2 ? (k) : 2 + ((k) - 2) % 11)
#define IN(k) (((KIND_MASK >> KIND_OF(k)) & 1) && lo <= (k) && (k) < hi)
#define SEAM(k) do { if (IN((k) + 1)) xcd_barrier(bar); } while (0)
#define LAUNDER() asm volatile("" : "+s"(c.ws), "+s"(c.out))
#define A1 ((bf16*)(c.ws + WS_R1))
#define Pb ((bf16*)(c.ws + WS_R2))
#define mixn ((bf16*)(c.ws + WS_R3))
#define xin ((bf16*)(c.ws + WS_R1))
#define hid ((bf16*)(c.ws + WS_R2))
#define Yb ((bf16*)(c.ws + WS_R3))
#define hctx ((float*)(c.ws + WS_HCTX))

    if (IN(0)) { LAUNDER(); p0a(c); SEAM(0); }
    if (IN(1)) { LAUNDER(); p0b_tables(c); LAUNDER(); row_prep(c, 0, 0); SEAM(1); }
#pragma unroll 1
    for (int l = 0; l < 2; ++l) {
        const int pb = 2 + 11 * l;
        if (IN(pb + 0)) { LAUNDER();
            pg8::Gemm g{A1, (const bf16*)(c.ws + WS_WIN) + (size_t)l * INW * 1024, MT, INW, 1024}; pg8::StaticOrder S; S.init(MT, INW, c.G, (int)blockIdx.x);
            pg8::EpiStoreBf16 E{Pb, INW};
            pg8::gemm_phase<pg8::EpiStoreBf16, pg8::StaticOrder, true, true>(c.lds + RING_OFF, g, S, E);
            SEAM(pb + 0);
        }
        if (IN(pb + 1)) { LAUNDER();
            for (;;) { const int u = q_next(c, pb + 1); if (u >= 130 + 260) break; if (u < 130) s5_e_unit(c, l, u); else qk_prep_rows(c, l, u - 130); }
            SEAM(pb + 1);
        }
        if (IN(pb + 2)) { LAUNDER();
            const int natt = l == 0 ? 520 : 512, nsgu = l == 0 ? 260 : 256;
            for (;;) { const int u = q_next(c, pb + 2); if (u >= 8 + natt + nsgu) break;

#ifndef NO_CARRY
                if (u < 8) s5_carry_unit(c, l, u); else
#endif
#ifndef NO_ATT
                if (u < 8 + natt) attn_unit(c, l, u - 8); else
#endif
#ifndef NO_SGU
                sgu_unit(c, l, u - 8 - natt);
#else
                {}
#endif
            }
            SEAM(pb + 2);
        }
        if (IN(pb + 3)) { LAUNDER();
            const int nt = l == 0 ? 130 : 128;
            for (;;) { const int u = q_next(c, pb + 3); if (u >= nt) break; s5_out_unit(c, l, u); }
            SEAM(pb + 3);
        }
        if (IN(pb + 4)) { LAUNDER();
            const int M = l == 0 ? MT : MLAT;
            pg8::Gemm g{mixn, (const bf16*)(c.ws + WS_WOUT) + (size_t)l * 1024 * 1024, M, 1024, 1024}; pg8::StaticOrder S; S.init(M, 1024, c.G, (int)blockIdx.x);
            pg8::EpiResid E{l == 0 ? c.inp[I_X] : c.out, c.out, l == 0 ? c.inp[I_CTX] : hctx, hctx, (const float*)(c.ws + WS_MODV) + (size_t)l * 3 * 6144, MLAT, 2 * 1024};
            pg8::gemm_phase<pg8::EpiResid, pg8::StaticOrder, true, true>(c.lds + RING_OFF, g, S, E);
            SEAM(pb + 4);
        }
        if (IN(pb + 5)) { LAUNDER(); ffn_prep(c, l, l == 0 ? MT : MLAT); SEAM(pb + 5); }
        if (IN(pb + 6)) { LAUNDER(); const int nu = l == 0 ? 64 : 32; for (int u = c.vcu; u < nu; u += c.G) select_unit(c, u); SEAM(pb + 6); }
        if (IN(pb + 7)) { LAUNDER(); gather_rows(c, l == 0); SEAM(pb + 7); }
        if (IN(pb + 8)) { LAUNDER();
            const int M = l == 0 ? XROWS : XLAT;
            pg8::Gemm g{xin, (const bf16*)(c.ws + WS_WGU), M, 2048, 1024}; pg8::StaticOrder S; S.init(M, 2048, c.G, (int)blockIdx.x, 1);
            pg8::EpiSwiGLU E{hid};
            pg8::gemm_phase<pg8::EpiSwiGLU, pg8::StaticOrder, true, true>(c.lds + RING_OFF, g, S, E);
            SEAM(pb + 8);
        }
        if (IN(pb + 9)) { LAUNDER();
            const int M = l == 0 ? XROWS : XLAT;
            pg8::Gemm g{hid, (const bf16*)(c.ws + WS_WD), M, 1024, 1024}; pg8::StaticOrder S; S.init(M, 1024, c.G, (int)blockIdx.x, 1);
            pg8::EpiGateY E{Yb, (const float*)(c.ws + WS_GATE)};
            pg8::gemm_phase<pg8::EpiGateY, pg8::StaticOrder, true, true>(c.lds + RING_OFF, g, S, E);
            SEAM(pb + 9);
        }
        if (IN(pb + 10)) { LAUNDER();
            if (l == 0) { row_prep(c, 1, 1); convert_experts(c, 1); SEAM(pb + 10); }
            else row_prep(c, 2, 1);
        }
    }
#undef IN
#undef SEAM
#undef A1
#undef Pb
#undef mixn
#undef xin
#undef hid
#undef Yb
#undef hctx
}

extern "C" void kernel_launch(void* const* d_in, const int* in_sizes, int n_in, void* d_out, int out_size, void* d_ws, size_t ws_size, hipStream_t stream) {
    static int grid = 0;
    if (grid == 0) {
        if (n_in != 31 || in_sizes[0] != MLAT * D || out_size != MLAT * D || ws_size < WS_END) {
            fprintf(stderr, "kernel_launch: unexpected shapes (n_in %d, in0 %d, out %d, ws %zu < %zu); nothing launched\n", n_in, n_in > 0 ? in_sizes[0] : -1, out_size, ws_size, (size_t)WS_END); grid = -1; return; }
        int dev = 0, cus = 0, per_cu = 0;
        if (hipGetDevice(&dev) != hipSuccess || hipDeviceGetAttribute(&cus, hipDeviceAttributeMultiprocessorCount, dev) != hipSuccess) { grid = -1; return; }
        if (hipFuncSetAttribute((const void*)mega_fwd, hipFuncAttributeMaxDynamicSharedMemorySize, LDS_BYTES) != hipSuccess) { fprintf(stderr, "kernel_launch: hipFuncSetAttribute failed\n"); grid = -1; return; }
        if (hipOccupancyMaxActiveBlocksPerMultiprocessor(&per_cu, (const void*)mega_fwd, NWAVES * 64, LDS_BYTES) != hipSuccess || per_cu < 1)
            fprintf(stderr, "kernel_launch: note: occupancy query reports %d workgroups per CU\n", per_cu);
        (void)hipGetLastError();
        grid = cus;
    }
    if (grid < 0) return;
    if (hipMemsetAsync((char*)d_ws + WS_CTL, 0, CTL_ZERO_BYTES, stream) != hipSuccess) { fprintf(stderr, "kernel_launch: hipMemsetAsync failed\n"); return; }
    Args a{};
    for (int i = 0; i < 31; ++i) a.in[i] = (const float*)d_in[i];
    a.out = (float*)d_out; a.ws = (unsigned char*)d_ws;
    for (int li = 0; li < N_LAUNCHES; ++li) {
        a.ph_lo = (N_LAUNCHES == 1) ? 0 : li; a.ph_hi = (N_LAUNCHES == 1) ? N_PHASES : li + 1;
        hipLaunchKernelGGL(mega_fwd, dim3(grid), dim3(NWAVES * 64), LDS_BYTES, stream, a);
        const hipError_t le = hipPeekAtLastError();
        if (le != hipSuccess) { fprintf(stderr, "kernel_launch: launch %d failed: %s\n", li, hipGetErrorName(le)); break; }
    }
}
```

```cpp
#include <hip/hip_runtime.h>
#include <cstdio>
#include <cstdint>
#include <cmath>

constexpr int D = 1024, NBATCH = 2, SEQ = 16384, LC = 256;
constexpr int MLAT = NBATCH * SEQ, MCTX = NBATCH * LC, MT = MLAT + MCTX;
constexpr int INW = 1536;
constexpr int NE = 16, CAPL = 2048, CAPC = 32;
constexpr int XLAT = NBATCH * NE * CAPL;
constexpr int XROWS = XLAT + NE * 256;
constexpr float EPS = 1e-6f;
constexpr float LOG2E = 1.4426950408889634f;
constexpr int NTILE = MT / 256;
constexpr int NSC = MT / 16;

namespace pg8 {
#define PG8_LAS __attribute__((address_space(3)))
typedef unsigned short bf16_t;
typedef short bf16x8 __attribute__((ext_vector_type(8)));
typedef float f32x4 __attribute__((ext_vector_type(4)));
typedef unsigned u32x4 __attribute__((ext_vector_type(4)));
constexpr int BM = 256, BK = 64, HALF = 128, HTB = HALF * BK * 2  , STAGE_BYTES = 8 * HTB, NXCD = 8, WGM = 8;

__host__ __device__ __forceinline__ int lds_byte(int r, int c) { const int st = (r >> 4) * 2 + (c >> 5), rr = r & 15, cc = c & 31, ob = rr * 64 + cc * 2; return st * 1024 + (ob ^ (((ob >> 9) & 1) << 5)); }
__host__ __device__ __forceinline__ void stage_rc(int b, int& R, int& C) { const int st = b / 1024, sb = b % 1024, swz = sb ^ (((sb >> 9) & 1) << 5); R = (st >> 1) * 16 + swz / 64; C = (st & 1) * 32 + (swz % 64) / 2; }
__host__ __device__ __forceinline__ int perm32(int rho) { const int n = rho >> 4, i = rho & 15; return 8 * (i >> 2) + 4 * n + (i & 3); }

struct Unit { int pm, pn, pb; };
struct Gemm { const bf16_t* A; const bf16_t* Bt; int M, N, K, lda; const int* rowidx; };

struct StaticOrder {
    int nM, nN, nwg, G, c, moe;
    __host__ __device__ void init(int M, int N, int G_, int c_, int moe_ = 0) { nM = M / BM; nN = N / BM; nwg = nM * nN; G = G_; c = c_; moe = moe_; }
    __host__ __device__ bool next(int i, Unit& u) const {
        const long L = (long)i * G + c; if (L >= nwg) return false;
        int wgid = (int)L; { const int q = nwg / NXCD, r = nwg % NXCD, xcd = wgid % NXCD, off = wgid / NXCD; wgid = (xcd < r ? xcd * (q + 1) : r * (q + 1) + (xcd - r) * q) + off; }
        const int nig = WGM * nN, gid = wgid / nig, fm = gid * WGM, gsz = (nM - fm) < WGM ? (nM - fm) : WGM;
        u.pm = fm + ((wgid % nig) % gsz); u.pn = (wgid % nig) / gsz;
        u.pb = moe == 1 ? ((u.pm < 256 ? ((u.pm >> 3) & 15) : (u.pm - 256)) * nN + u.pn) : moe == 2 ? u.pm / 9 : u.pn; return true;
    }
    __device__ __forceinline__ void a_ready(const Unit&) const {}
    __device__ __forceinline__ void done(const Unit&) const {}
};

__device__ __forceinline__ unsigned cvt_pk_bf16(float lo, float hi) { unsigned r; asm volatile("v_cvt_pk_bf16_f32 %0, %1, %2" : "=v"(r) : "v"(lo), "v"(hi)); return r; }

struct EpiResid {
    static constexpr bool PERM = false, AFTER_DRAIN = false;
    const float* src_lat; float* dst_lat; const float* src_ctx; float* dst_ctx; const float* gate3;
    int mlat, gate_off;
    __device__ __forceinline__ void operator()(const f32x4 (&acc)[2][2][4][2], const Unit& u, int wr, int wc, int fr, int fq) const {
        const int r0 = u.pm * BM; const bool isctx = r0 >= mlat; const int mb = isctx ? 2 : (r0 >> 14);
        const float* src = isctx ? src_ctx : src_lat; float* dst = isctx ? dst_ctx : dst_lat;
        const int rb = (isctx ? r0 - mlat : r0) + wr * 64 + fr, col0 = u.pn * BM + wc * 32 + 4 * fq;
        const float* gate = gate3 + mb * 6144 + gate_off;
        f32x4 gv[2][2];
#pragma unroll
        for (int bj = 0; bj < 2; ++bj)
#pragma unroll
            for (int n = 0; n < 2; ++n) gv[bj][n] = *(const f32x4*)(gate + col0 + bj * HALF + n * 16);
#pragma unroll
        for (int ai = 0; ai < 2; ++ai)
#pragma unroll
            for (int m = 0; m < 4; ++m) { const size_t off = (size_t)(rb + ai * HALF + m * 16) * 1024 + col0;
#pragma unroll
                for (int bj = 0; bj < 2; ++bj)
#pragma unroll
                    for (int n = 0; n < 2; ++n) { const f32x4 h = *(const f32x4*)(src + off + bj * HALF + n * 16); *(f32x4*)(dst + off + bj * HALF + n * 16) = h + gv[bj][n] * acc[ai][bj][m][n]; }
                if (m & 1) asm volatile("" ::: "memory"); }
    }
};
struct EpiResidBf {
    static constexpr bool PERM = true, AFTER_DRAIN = false;
    const float* src_f32; bf16_t* hb; const float* gate3; int gate_off;
    __device__ __forceinline__ void operator()(const f32x4 (&acc)[2][2][4][2], const Unit& u, int wr, int wc, int fr, int fq) const {
        const int r0 = u.pm * BM, mb = r0 >> 14, row0 = r0 + wr * 64 + fr, col0 = u.pn * BM + wc * 32 + 8 * fq;
        const float* gate = gate3 + mb * 6144 + gate_off;
        f32x4 gv[2][2];
#pragma unroll
        for (int bj = 0; bj < 2; ++bj)
#pragma unroll
            for (int n = 0; n < 2; ++n) gv[bj][n] = *(const f32x4*)(gate + col0 + bj * HALF + 4 * n);
#pragma unroll
        for (int ai = 0; ai < 2; ++ai)
#pragma unroll
            for (int m = 0; m < 4; ++m) { const int row = row0 + ai * HALF + m * 16;
#pragma unroll
                for (int bj = 0; bj < 2; ++bj) { const int col = col0 + bj * HALF; f32x4 h0, h1;
                    if (src_f32) { h0 = *(const f32x4*)(src_f32 + (size_t)row * 1024 + col); h1 = *(const f32x4*)(src_f32 + (size_t)row * 1024 + col + 4); }
                    else { const u32x4 w = *(const u32x4*)(hb + (size_t)row * 2048 + col);
                        h0 = (f32x4){__uint_as_float(w.x << 16), __uint_as_float(w.x & 0xffff0000u), __uint_as_float(w.y << 16), __uint_as_float(w.y & 0xffff0000u)};
                        h1 = (f32x4){__uint_as_float(w.z << 16), __uint_as_float(w.z & 0xffff0000u), __uint_as_float(w.w << 16), __uint_as_float(w.w & 0xffff0000u)}; }
                    const f32x4 o0 = h0 + gv[bj][0] * acc[ai][bj][m][0], o1 = h1 + gv[bj][1] * acc[ai][bj][m][1];
                    u32x4 ow; ow.x = cvt_pk_bf16(o0[0], o0[1]); ow.y = cvt_pk_bf16(o0[2], o0[3]); ow.z = cvt_pk_bf16(o1[0], o1[1]); ow.w = cvt_pk_bf16(o1[2], o1[3]);
                    *(u32x4*)(hb + (size_t)row * 2048 + col) = ow; }
                if (m & 1) asm volatile("" ::: "memory"); }
    }
};
struct EpiSwiGLU {
    static constexpr bool PERM = true, AFTER_DRAIN = false;
    bf16_t* O;
    __device__ __forceinline__ void operator()(const f32x4 (&acc)[2][2][4][2], const Unit& u, int wr, int wc, int fr, int fq) const {
        const int row0 = u.pm * BM + wr * 64 + fr, col0 = u.pn * HALF + wc * 32 + 8 * fq;
#pragma unroll
        for (int ai = 0; ai < 2; ++ai)
#pragma unroll
            for (int m = 0; m < 4; ++m) { bf16_t* rowp = O + (size_t)(row0 + ai * HALF + m * 16) * 1024 + col0;
                float hv[8];
#pragma unroll
                for (int n = 0; n < 2; ++n)
#pragma unroll
                    for (int i = 0; i < 4; ++i) { const float g = acc[ai][0][m][n][i], up = acc[ai][1][m][n][i];
                        const float sg = g * __builtin_amdgcn_rcpf(1.0f + __builtin_amdgcn_exp2f(-g * 1.4426950408889634f)); hv[n * 4 + i] = sg * up; }
                u32x4 w; w.x = cvt_pk_bf16(hv[0], hv[1]); w.y = cvt_pk_bf16(hv[2], hv[3]); w.z = cvt_pk_bf16(hv[4], hv[5]); w.w = cvt_pk_bf16(hv[6], hv[7]);
                *(u32x4*)rowp = w; }
    }
};
struct EpiGateY {
    static constexpr bool PERM = true, AFTER_DRAIN = false;
    bf16_t* O; const float* gate;
    __device__ __forceinline__ void operator()(const f32x4 (&acc)[2][2][4][2], const Unit& u, int wr, int wc, int fr, int fq) const {
        const int row0 = u.pm * BM + wr * 64 + fr, col0 = u.pn * BM + wc * 32 + 8 * fq;
        float gts[2][4];
#pragma unroll
        for (int ai = 0; ai < 2; ++ai)
#pragma unroll
            for (int m = 0; m < 4; ++m) gts[ai][m] = gate[row0 + ai * HALF + m * 16];
#pragma unroll
        for (int ai = 0; ai < 2; ++ai)
#pragma unroll
            for (int m = 0; m < 4; ++m) { const int row = row0 + ai * HALF + m * 16; const float gt = gts[ai][m]; bf16_t* rowp = O + (size_t)row * 1024 + col0;
#pragma unroll
                for (int bj = 0; bj < 2; ++bj) { const f32x4 v0 = acc[ai][bj][m][0] * gt, v1 = acc[ai][bj][m][1] * gt;
                    u32x4 w; w.x = cvt_pk_bf16(v0[0], v0[1]); w.y = cvt_pk_bf16(v0[2], v0[3]); w.z = cvt_pk_bf16(v1[0], v1[1]); w.w = cvt_pk_bf16(v1[2], v1[3]);
                    *(u32x4*)(rowp + bj * HALF) = w; } }
    }
};

struct EpiInProj {
    static constexpr bool PERM = true, AFTER_DRAIN = false;
    bf16_t* O; bf16_t* Amat; bf16_t* U2;
    __device__ __forceinline__ void operator()(const f32x4 (&acc)[2][2][4][2], const Unit& u, int wr, int wc, int fr, int fq) const {
        const int row0 = u.pm * BM + wr * 64 + fr, cw = wc * 32 + 8 * fq;
#pragma unroll
        for (int ai = 0; ai < 2; ++ai)
#pragma unroll
            for (int m = 0; m < 4; ++m) { const int row = row0 + ai * HALF + m * 16;
#pragma unroll
                for (int bj = 0; bj < 2; ++bj) { const f32x4 v0 = acc[ai][bj][m][0], v1 = acc[ai][bj][m][1];
                    u32x4 w; w.x = cvt_pk_bf16(v0[0], v0[1]); w.y = cvt_pk_bf16(v0[2], v0[3]); w.z = cvt_pk_bf16(v1[0], v1[1]); w.w = cvt_pk_bf16(v1[2], v1[3]);
                    const int cl = cw + bj * HALF;
                    if (u.pn == 3) { const size_t r = (size_t)(cl >> 4) * 2304 + (row >> 4); const int k = (row & 15) * 16 + (cl & 15); *(u32x4*)(Amat + r * 512 + k) = w; *(u32x4*)(U2 + r * 256 + k) = w; }
                    else *(u32x4*)(O + (size_t)row * 1536 + u.pn * BM + cl) = w; } }
    }
};
struct EpiF32x256 {
    static constexpr bool PERM = false, AFTER_DRAIN = false;
    float* C;
    __device__ __forceinline__ void operator()(const f32x4 (&acc)[2][2][4][2], const Unit& u, int wr, int wc, int fr, int fq) const {
        const int row0 = u.pm * BM + wr * 64 + fr, col0 = wc * 32 + 4 * fq;
#pragma unroll
        for (int ai = 0; ai < 2; ++ai)
#pragma unroll
            for (int m = 0; m < 4; ++m) { float* rowp = C + (size_t)(row0 + ai * HALF + m * 16) * 256 + col0;
#pragma unroll
                for (int bj = 0; bj < 2; ++bj)
#pragma unroll
                    for (int n = 0; n < 2; ++n) *(f32x4*)(rowp + bj * HALF + n * 16) = acc[ai][bj][m][n];
                asm volatile("" ::: "memory"); }
    }
};
__device__ __forceinline__ float gelu_t(float x) { const float z2 = 1.5957691216057308f * (x + 0.044715f * x * x * x); return x * __builtin_amdgcn_rcpf(1.0f + __builtin_amdgcn_exp2f(-z2 * 1.4426950408889634f)); }
struct EpiS5Out {
    static constexpr bool PERM = false, AFTER_DRAIN = false;
    bf16_t* Gs; int nsc;
    __device__ __forceinline__ void operator()(const f32x4 (&acc)[2][2][4][2], const Unit& u, int wr, int wc, int fr, int fq) const {
        const int g = u.pm / 9, sc0 = (u.pm % 9) * BM + wr * 64 + fr;
#pragma unroll
        for (int ai = 0; ai < 2; ++ai)
#pragma unroll
            for (int m = 0; m < 4; ++m) { const int sc = sc0 + ai * HALF + m * 16;
                if (sc < nsc) {
#pragma unroll
                    for (int bj = 0; bj < 2; ++bj)
#pragma unroll
                        for (int n = 0; n < 2; ++n) { const int tau = 8 * bj + 2 * wc + n; const f32x4 v = acc[ai][bj][m][n];
                            unsigned lo = cvt_pk_bf16(gelu_t(v[0]), gelu_t(v[1])), hi = cvt_pk_bf16(gelu_t(v[2]), gelu_t(v[3]));
                            *(unsigned long long*)(Gs + (size_t)(16 * sc + tau) * 256 + 16 * g + 4 * fq) = ((unsigned long long)hi << 32) | lo; } } }
    }
};
struct EpiGluNorm {
    static constexpr bool PERM = true, AFTER_DRAIN = true;
    const bf16_t* Gs; bf16_t* mix; bf16_t* mixn; const float* glu_b; const float* ong; float eps;
    __device__ __forceinline__ void fused(f32x4 (&acc)[2][2][4][2], const Unit& u, int wr, int wc, int fr, int fq, PG8_LAS unsigned char* lds, int wid, int lane) const {
        const int row0 = u.pm * BM + wr * 64 + fr, col0 = wc * 32 + 8 * fq;
        f32x4 bv[2][2];
#pragma unroll
        for (int bj = 0; bj < 2; ++bj)
#pragma unroll
            for (int n = 0; n < 2; ++n) bv[bj][n] = *(const f32x4*)(glu_b + col0 + bj * HALF + 4 * n);
        PG8_LAS float* Pq = (PG8_LAS float*)lds;
#pragma unroll
        for (int ai = 0; ai < 2; ++ai)
#pragma unroll
            for (int m = 0; m < 4; ++m) { const int row = row0 + ai * HALF + m * 16; float ss = 0.f;
#pragma unroll
                for (int bj = 0; bj < 2; ++bj) { const int col = col0 + bj * HALF;
                    const u32x4 gw = *(const u32x4*)(Gs + (size_t)row * 256 + col);
                    const unsigned gws[4] = {gw.x, gw.y, gw.z, gw.w};
#pragma unroll
                    for (int i = 0; i < 8; ++i) { const float gv = __uint_as_float((i & 1) ? (gws[i >> 1] & 0xffff0000u) : (gws[i >> 1] << 16));
                        const float z = acc[ai][bj][m][i >> 2][i & 3] + bv[bj][i >> 2][i & 3];
                        const float o = gv * __builtin_amdgcn_rcpf(1.0f + __builtin_amdgcn_exp2f(-z * 1.4426950408889634f));
                        acc[ai][bj][m][i >> 2][i & 3] = o; ss += o * o; } }
                ss += __shfl_xor(ss, 16); ss += __shfl_xor(ss, 32);
                if (fq == 0) Pq[(ai * HALF + wr * 64 + m * 16 + fr) * 4 + wc] = ss; }
        asm volatile("s_waitcnt lgkmcnt(0)" ::: "memory"); __syncthreads();
        f32x4 gv4[2][2];
#pragma unroll
        for (int bj = 0; bj < 2; ++bj)
#pragma unroll
            for (int n = 0; n < 2; ++n) gv4[bj][n] = *(const f32x4*)(ong + 512 + col0 + bj * HALF + 4 * n);
#pragma unroll
        for (int ai = 0; ai < 2; ++ai)
#pragma unroll
            for (int m = 0; m < 4; ++m) { const int rl = ai * HALF + wr * 64 + m * 16 + fr, row = u.pm * BM + rl;
                const f32x4 p4 = *(const PG8_LAS f32x4*)(Pq + rl * 4);
                const float r = 1.0f / sqrtf(((p4[0] + p4[1]) + (p4[2] + p4[3])) * (1.0f / 256.0f) + eps);
#pragma unroll
                for (int bj = 0; bj < 2; ++bj) { const f32x4 v0 = acc[ai][bj][m][0] * r * gv4[bj][0], v1 = acc[ai][bj][m][1] * r * gv4[bj][1];
                    u32x4 w; w.x = cvt_pk_bf16(v0[0], v0[1]); w.y = cvt_pk_bf16(v0[2], v0[3]); w.z = cvt_pk_bf16(v1[0], v1[1]); w.w = cvt_pk_bf16(v1[2], v1[3]);
                    *(u32x4*)(mixn + (size_t)row * 1024 + 512 + col0 + bj * HALF) = w; } }
        asm volatile("s_waitcnt lgkmcnt(0)" ::: "memory"); __syncthreads();
    }
};

template <class Epi, class Sched, bool ALIGN_EPI = false, bool SP2 = false, bool GATHER = false>
__device__ __forceinline__ void gemm_phase(PG8_LAS unsigned char* lds, const Gemm g, const Sched& S, const Epi& E) {
    int tid_ = threadIdx.x; asm volatile("" : "+v"(tid_));
    const int tid = tid_, wid = __builtin_amdgcn_readfirstlane(tid >> 6), lane = tid & 63, wr = wid >> 2, wc = wid & 3, fr = lane & 15, fq = lane >> 4;
    const int K = g.K, nt = K / BK, lda = g.lda;
    unsigned voffA[2], voffB[2];
#pragma unroll
    for (int i = 0; i < 2; ++i) { int R, C; stage_rc(tid * 16 + i * 8192, R, C); const int Rb = Epi::PERM ? ((R & ~31) + perm32(R & 31)) : R;
        voffA[i] = (unsigned)(R * lda + C) * 2u; voffB[i] = (unsigned)(Rb * K + C) * 2u; }
    const size_t kstep = (size_t)(BK * 2);
    const size_t hstepB = (size_t)HALF * K * 2, hstepA = (size_t)HALF * lda * 2;
    const size_t tstepB = 2 * hstepB, tstepA = 2 * hstepA;
    const unsigned ldsw = (unsigned)wid * 1024u;
    const int aoff = lds_byte(wr * 64 + fr, fq * 8), boff = lds_byte(wc * 32 + fr, fq * 8);
#define PG8_SA(b, h) (((b) * 2 + (h)) * HTB)
#define PG8_SB(b, h) ((4 + (b) * 2 + (h)) * HTB)
#define PG8_STAGE(bufoff, gbase, voff) do { _Pragma("unroll") for (int _i = 0; _i < 2; ++_i) \
        __builtin_amdgcn_global_load_lds((const unsigned*)((const char*)(gbase) + (voff)[_i]), (PG8_LAS unsigned*)(lds + (bufoff) + ldsw + _i * 8192), 16, 0, 0); } while (0)
#define PG8_STAGE_A(bufoff, gbase, h, nx) do { if constexpr (GATHER) { _Pragma("unroll") for (int _i = 0; _i < 2; ++_i) \
        __builtin_amdgcn_global_load_lds((const unsigned*)((const char*)(gbase) + ((nx) ? vAn[h][_i] : vAc[h][_i])), (PG8_LAS unsigned*)(lds + (bufoff) + ldsw + _i * 8192), 16, 0, 0); } \
        else { PG8_STAGE(bufoff, (gbase) + ((h) ? hstepA : 0), voffA); } } while (0)
#define PG8_LDA(dst, b, h) do { _Pragma("unroll") for (int m = 0; m < 4; ++m) _Pragma("unroll") for (int k = 0; k < 2; ++k) dst[m][k] = *(const PG8_LAS bf16x8*)(lds + PG8_SA(b, h) + aoff + m * 2048 + k * 1024); } while (0)
#define PG8_LDB(dst, b, h) do { _Pragma("unroll") for (int n = 0; n < 2; ++n) _Pragma("unroll") for (int k = 0; k < 2; ++k) dst[n][k] = *(const PG8_LAS bf16x8*)(lds + PG8_SB(b, h) + boff + n * 2048 + k * 1024); } while (0)
#define PG8_MMA(ai, bj, At, Bt) do { __builtin_amdgcn_s_setprio(1); _Pragma("unroll") for (int m = 0; m < 4; ++m) _Pragma("unroll") for (int n = 0; n < 2; ++n) _Pragma("unroll") for (int k = 0; k < 2; ++k) \
        acc[ai][bj][m][n] = __builtin_amdgcn_mfma_f32_16x16x32_bf16(Bt[n][k], At[m][k], acc[ai][bj][m][n], 0, 0, 0); __builtin_amdgcn_s_setprio(0); } while (0)
#define PG8_WAIT_V(n) asm volatile("s_waitcnt vmcnt(" #n ")" ::: "memory")
#define PG8_WAIT_L(n) asm volatile("s_waitcnt lgkmcnt(" #n ")" ::: "memory")
#define PG8_BAR __builtin_amdgcn_s_barrier()
#define PG8_SCHED __builtin_amdgcn_sched_barrier(0)
    Unit cur, nxt; int ui = 0;
    if (!S.next(0, cur)) return;
    unsigned vAc[2][2] = {{0u, 0u}, {0u, 0u}}, vAn[2][2] = {{0u, 0u}, {0u, 0u}}; int RA[2], CA[2];
#pragma unroll
    for (int i = 0; i < 2; ++i) stage_rc(tid * 16 + i * 8192, RA[i], CA[i]);
    PG8_LAS int* const ridx = (PG8_LAS int*)(lds + STAGE_BYTES + 1024);
    if constexpr (GATHER) {
        Unit tu; for (int k = 0; k < 15 && S.next(k, tu); ++k) if (tid < 256) ridx[k * 256 + tid] = g.rowidx[tu.pm * BM + tid];
        asm volatile("s_waitcnt vmcnt(0) lgkmcnt(0)" ::: "memory"); __builtin_amdgcn_s_barrier(); asm volatile("" ::: "memory");
#pragma unroll
        for (int h = 0; h < 2; ++h)
#pragma unroll
            for (int i = 0; i < 2; ++i) vAc[h][i] = (unsigned)(ridx[h * HALF + RA[i]] * lda + CA[i]) * 2u;
    }
    f32x4 acc[2][2][4][2];
#pragma unroll
    for (int a = 0; a < 2; ++a)
#pragma unroll
        for (int b = 0; b < 2; ++b)
#pragma unroll
            for (int m = 0; m < 4; ++m)
#pragma unroll
                for (int n = 0; n < 2; ++n) acc[a][b][m][n] = (f32x4){0.f, 0.f, 0.f, 0.f};
    bf16x8 At[4][2], B0[2][2], B1[2][2];
    const char* cA = (const char*)g.A + (GATHER ? (size_t)0 : (size_t)cur.pm * tstepA); const char* cB = (const char*)g.Bt + (size_t)cur.pb * tstepB;
    S.a_ready(cur);
    if constexpr (SP2) {
        PG8_STAGE(PG8_SB(0, 0), cB, voffB); PG8_STAGE(PG8_SB(0, 1), cB + hstepB, voffB); PG8_STAGE_A(PG8_SA(0, 0), cA, 0, false); PG8_STAGE_A(PG8_SA(0, 1), cA, 1, false);
        if (wr == 1) PG8_BAR;
        PG8_WAIT_V(2); PG8_BAR;
        PG8_STAGE(PG8_SB(1, 0), cB + kstep, voffB); PG8_STAGE_A(PG8_SA(1, 0), cA + kstep, 0, false); PG8_STAGE(PG8_SB(1, 1), cB + hstepB + kstep, voffB);
        PG8_WAIT_V(6); PG8_BAR;
    } else {
        PG8_STAGE(PG8_SB(0, 0), cB, voffB); PG8_STAGE_A(PG8_SA(0, 0), cA, 0, false); PG8_STAGE(PG8_SB(0, 1), cB + hstepB, voffB); PG8_STAGE_A(PG8_SA(0, 1), cA, 1, false);
        if (wr == 1) PG8_BAR;
        PG8_WAIT_V(4); PG8_BAR;
        PG8_STAGE(PG8_SB(1, 0), cB + kstep, voffB); PG8_STAGE_A(PG8_SA(1, 0), cA + kstep, 0, false); PG8_STAGE(PG8_SB(1, 1), cB + hstepB + kstep, voffB);
        PG8_WAIT_V(6); PG8_BAR;
    }
    for (;;) {
        const bool has_next = S.next(ui + 1, nxt);
        const char* nA = GATHER ? (const char*)g.A : (has_next ? (const char*)g.A + (size_t)nxt.pm * tstepA : cA);
        if constexpr (GATHER) {
#pragma unroll
            for (int h = 0; h < 2; ++h)
#pragma unroll
                for (int i = 0; i < 2; ++i) vAn[h][i] = has_next ? (unsigned)(ridx[(ui + 1) * 256 + h * HALF + RA[i]] * lda + CA[i]) * 2u : vAc[h][i]; } const char* nB = has_next ? (const char*)g.Bt + (size_t)nxt.pb * tstepB : cB;
        for (int t = 0; t < nt; t += 2) {
            const bool last = (t == nt - 2);
            const char* a1 = cA + (size_t)(t + 1) * kstep;
            const char* a2 = last ? nA : cA + (size_t)(t + 2) * kstep; const char* b2 = last ? nB : cB + (size_t)(t + 2) * kstep;
            const char* a3 = a2 + kstep; const char* b3 = b2 + kstep;
            if (last && has_next) S.a_ready(nxt);
            if constexpr (SP2) {
            PG8_LDB(B0, 0, 0); PG8_LDB(B1, 0, 1); PG8_SCHED; PG8_LDA(At, 0, 0); PG8_STAGE_A(PG8_SA(1, 1), a1, 1, false);
            PG8_WAIT_V(8); PG8_WAIT_L(0); PG8_BAR; PG8_MMA(0, 0, At, B0); PG8_MMA(0, 1, At, B1); PG8_BAR; PG8_SCHED;
            PG8_LDA(At, 0, 1); PG8_STAGE(PG8_SB(0, 0), b2, voffB); PG8_STAGE(PG8_SB(0, 1), b2 + hstepB, voffB); PG8_STAGE_A(PG8_SA(0, 0), a2, 0, last);
            PG8_WAIT_V(8); PG8_WAIT_L(0); PG8_BAR; PG8_MMA(1, 0, At, B0); PG8_MMA(1, 1, At, B1); PG8_BAR; PG8_SCHED;
            PG8_LDB(B0, 1, 0); PG8_LDB(B1, 1, 1); PG8_SCHED; PG8_LDA(At, 1, 0); PG8_STAGE_A(PG8_SA(0, 1), a2, 1, last);
            PG8_WAIT_V(8); PG8_WAIT_L(0); PG8_BAR; PG8_MMA(0, 0, At, B0); PG8_MMA(0, 1, At, B1); PG8_BAR; PG8_SCHED;
            PG8_LDA(At, 1, 1); PG8_STAGE(PG8_SB(1, 0), b3, voffB); PG8_STAGE(PG8_SB(1, 1), b3 + hstepB, voffB); PG8_STAGE_A(PG8_SA(1, 0), a3, 0, last);
            PG8_WAIT_V(8); PG8_WAIT_L(0); PG8_BAR; PG8_MMA(1, 0, At, B0); PG8_MMA(1, 1, At, B1); PG8_BAR; PG8_SCHED;
            } else {
            PG8_LDB(B0, 0, 0); PG8_SCHED; PG8_LDA(At, 0, 0); PG8_STAGE_A(PG8_SA(1, 1), a1, 1, false);
            PG8_WAIT_L(8); PG8_BAR; PG8_WAIT_L(0); PG8_MMA(0, 0, At, B0); PG8_BAR; PG8_SCHED;
            PG8_LDB(B1, 0, 1); PG8_STAGE(PG8_SB(0, 0), b2, voffB);
            PG8_BAR; PG8_WAIT_L(0); PG8_MMA(0, 1, At, B1); PG8_BAR;
            PG8_LDA(At, 0, 1); PG8_STAGE_A(PG8_SA(0, 0), a2, 0, last);
            PG8_BAR; PG8_WAIT_L(0); PG8_MMA(1, 0, At, B0); PG8_BAR; PG8_SCHED;
            PG8_STAGE(PG8_SB(0, 1), b2 + hstepB, voffB);
            PG8_WAIT_V(6); PG8_BAR; PG8_MMA(1, 1, At, B1); PG8_BAR;
            PG8_LDB(B0, 1, 0); PG8_SCHED; PG8_LDA(At, 1, 0); PG8_STAGE_A(PG8_SA(0, 1), a2, 1, last);
            PG8_WAIT_L(8); PG8_BAR; PG8_WAIT_L(0); PG8_MMA(0, 0, At, B0); PG8_BAR; PG8_SCHED;
            PG8_LDB(B1, 1, 1); PG8_STAGE(PG8_SB(1, 0), b3, voffB);
            PG8_BAR; PG8_WAIT_L(0); PG8_MMA(0, 1, At, B1); PG8_BAR;
            PG8_LDA(At, 1, 1); PG8_STAGE_A(PG8_SA(1, 0), a3, 0, last);
            PG8_BAR; PG8_WAIT_L(0); PG8_MMA(1, 0, At, B0); PG8_BAR; PG8_SCHED;
            PG8_STAGE(PG8_SB(1, 1), b3 + hstepB, voffB);
            PG8_WAIT_V(6); PG8_BAR; PG8_MMA(1, 1, At, B1); PG8_BAR;
            }
        }
        if constexpr (ALIGN_EPI) { if (wr == 0) PG8_BAR; }
        if constexpr (!Epi::AFTER_DRAIN) { E(acc, cur, wr, wc, fr, fq); S.done(cur); }
        if (!has_next) break;
#pragma unroll
        for (int a = 0; a < 2; ++a)
#pragma unroll
            for (int b = 0; b < 2; ++b)
#pragma unroll
                for (int m = 0; m < 4; ++m)
#pragma unroll
                    for (int n = 0; n < 2; ++n) acc[a][b][m][n] = (f32x4){0.f, 0.f, 0.f, 0.f};
        cur = nxt; cA = nA; cB = nB; ++ui;
        if constexpr (GATHER) {
#pragma unroll
            for (int h = 0; h < 2; ++h)
#pragma unroll
                for (int i = 0; i < 2; ++i) vAc[h][i] = vAn[h][i]; }
        if constexpr (ALIGN_EPI) { if (wr == 1) PG8_BAR; }
    }
    PG8_WAIT_V(0);
    if constexpr (!ALIGN_EPI) { if (wr == 0) PG8_BAR; }
    PG8_BAR;
    if constexpr (Epi::AFTER_DRAIN) { E.fused(acc, cur, wr, wc, fr, fq, lds, wid, lane); S.done(cur); }
#undef PG8_SA
#undef PG8_SB
#undef PG8_STAGE
#undef PG8_LDA
#undef PG8_LDB
#undef PG8_MMA
#undef PG8_WAIT_V
#undef PG8_WAIT_L
#undef PG8_BAR
#undef PG8_SCHED
}
}
#define GAS __attribute__((address_space(1)))
#define LAS __attribute__((address_space(3)))
typedef unsigned short bf16;
typedef unsigned v4u __attribute__((ext_vector_type(4)));
typedef float f32x4 __attribute__((ext_vector_type(4)));
typedef short bf16x8 __attribute__((ext_vector_type(8)));
typedef GAS unsigned gu32;
typedef GAS unsigned long long gu64;
#define RLX_AGENT __ATOMIC_RELAXED, __HIP_MEMORY_SCOPE_AGENT
#define LDS_WAIT() asm volatile("s_waitcnt lgkmcnt(0)" ::: "memory")
#define VM_WAIT() asm volatile("s_waitcnt vmcnt(0)" ::: "memory")
__device__ __forceinline__ unsigned long long rt() { return __builtin_amdgcn_s_memrealtime(); }
__device__ __forceinline__ unsigned f2bf(float f) { unsigned u = __builtin_bit_cast(unsigned, f); return (u + 0x7fffu + ((u >> 16) & 1u)) >> 16; }
typedef float pk_f32x2 __attribute__((ext_vector_type(2))); typedef __bf16 pk_bf16x2 __attribute__((ext_vector_type(2)));
__device__ __forceinline__ unsigned pk2(float lo, float hi) { pk_f32x2 v = {lo, hi}; pk_bf16x2 b = __builtin_convertvector(v, pk_bf16x2); return __builtin_bit_cast(unsigned, b); }

#define XB_TMO      128
#define XB_XCNT(j)  (256  + 64 * (j))
#define XB_XSUB(j)  (1280 + 64 * (j))
#define XB_XGEN(j)  (2304 + 64 * (j))
#define XB_TOP      3328
#define XB_TOPGEN   3392
#define XCD_BAR_WORDS 3456
#define XB_SPIN_CAP (1u << 18)

__device__ __forceinline__ unsigned xb_ld(unsigned* p)              { return __hip_atomic_load(p, __ATOMIC_RELAXED, __HIP_MEMORY_SCOPE_AGENT); }
__device__ __forceinline__ unsigned xb_add(unsigned* p, unsigned v) { return __hip_atomic_fetch_add(p, v, __ATOMIC_RELAXED, __HIP_MEMORY_SCOPE_AGENT); }
__device__ __forceinline__ unsigned xb_xcc_id() { return (unsigned)__builtin_amdgcn_s_getreg((3 << 11) | 20) & 0xFu; }
#define XB_SPIN(cond, bar) do { unsigned _sp = 0; while (cond) { __builtin_amdgcn_s_sleep(1); \
    if ((++_sp & 255u) == 0u) { if (xb_ld(&(bar)[XB_TMO])) break; if (_sp > XB_SPIN_CAP) { atomicAdd(&(bar)[XB_TMO], 1u); break; } } } } while (0)

struct XcdBarrier {
    unsigned* bar; unsigned x;
    volatile LAS unsigned* st;
};

__device__ __forceinline__ XcdBarrier xcd_barrier_post(unsigned* bar, volatile LAS unsigned* st) {
    XcdBarrier b; b.bar = bar; b.x = xb_xcc_id(); b.st = st;
    if (threadIdx.x == 0) (void)xb_add(&bar[XB_XCNT(b.x)], 1u);
    return b;
}
__device__ __forceinline__ void xcd_barrier_complete(unsigned* bar, unsigned x, unsigned& nloc, unsigned& nx) {
    const unsigned G = gridDim.x * gridDim.y * gridDim.z;
    unsigned sum, cnt, mine, sp = 0u;
    for (;;) {
        sum = 0u; cnt = 0u; mine = 0u;
#pragma unroll
        for (unsigned j = 0; j < 16; ++j) { const unsigned c = xb_ld(&bar[XB_XCNT(j)]); sum += c; cnt += (c > 0u) ? 1u : 0u; mine = (j == x) ? c : mine; }
        if (sum == G) break;
        __builtin_amdgcn_s_sleep(1);
        if ((++sp & 255u) == 0u) { if (xb_ld(&bar[XB_TMO])) break; if (sp > XB_SPIN_CAP) { atomicAdd(&bar[XB_TMO], 1u); break; } }
    }
    nloc = mine > 0u ? mine : 1u; nx = cnt > 0u ? cnt : 1u;
}

__device__ __forceinline__ void xcd_barrier(const XcdBarrier& b) {
    asm volatile("s_waitcnt vmcnt(0)" ::: "memory");
    __syncthreads();
    if (threadIdx.x == 0) {
        unsigned* bar = b.bar;
        __builtin_amdgcn_s_waitcnt(0);
        unsigned nloc = b.st[0], nx = b.st[1];
        if (nloc == 0u) { xcd_barrier_complete(bar, b.x, nloc, nx); b.st[0] = nloc; b.st[1] = nx; }
        const unsigned old = xb_add(&bar[XB_XSUB(b.x)], 1u);
        const unsigned gen = old / nloc;
        if (old + 1u == (gen + 1u) * nloc) {
            __builtin_amdgcn_fence(__ATOMIC_RELEASE, "agent");
            asm volatile("s_waitcnt vmcnt(0)" ::: "memory");
            const unsigned og = xb_add(&bar[XB_TOP], 1u);
            const unsigned tg = og / nx;
            if (og + 1u == (tg + 1u) * nx) xb_add(&bar[XB_TOPGEN], 1u);
            else XB_SPIN(xb_ld(&bar[XB_TOPGEN]) == tg, bar);
            __builtin_amdgcn_fence(__ATOMIC_ACQUIRE, "agent");
            xb_add(&bar[XB_XGEN(b.x)], 1u);
            asm volatile("s_waitcnt vmcnt(0)" ::: "memory");
        } else {
            XB_SPIN(xb_ld(&bar[XB_XGEN(b.x)]) == gen, bar);
            __builtin_amdgcn_fence(__ATOMIC_ACQUIRE, "agent");
            asm volatile("s_waitcnt vmcnt(0)" ::: "memory");
        }
    }
    __syncthreads();
}

typedef float f32x2 __attribute__((ext_vector_type(2)));
typedef float f32x16 __attribute__((ext_vector_type(16)));
typedef unsigned u32x2 __attribute__((ext_vector_type(2)));
typedef short v4i16_t __attribute__((ext_vector_type(4)));

constexpr size_t MiB = 1u << 20;
constexpr size_t WS_CTL = 0, CTL_ZERO_BYTES = 1 * MiB;
constexpr size_t WS_MODV = 1 * MiB;
constexpr size_t WS_POW  = 1 * MiB + 256 * 1024;
constexpr size_t WS_BBAR = 2 * MiB;
constexpr size_t WS_WGLU = 2 * MiB + 512 * 1024;
constexpr size_t WS_WSGU = 2 * MiB + 768 * 1024;
constexpr size_t WS_HCTX = 3 * MiB;
constexpr size_t WS_EB   = 5 * MiB;
constexpr size_t WS_TG   = 9 * MiB;
constexpr size_t WS_ROPE = 17 * MiB;
constexpr size_t WS_KTAB = 19 * MiB + 512 * 1024;
constexpr size_t WS_PROBS = 22 * MiB;
constexpr size_t WS_SMAP = 24 * MiB + 256 * 1024;
constexpr size_t WS_IDX  = 26 * MiB + 512 * 1024;
constexpr size_t WS_GATE = 27 * MiB;
constexpr size_t WS_WIN  = 28 * MiB;
constexpr size_t WS_WOUT = 34 * MiB;
constexpr size_t WS_WGU  = 38 * MiB;
constexpr size_t WS_WD   = 102 * MiB;
constexpr size_t WS_R1   = 134 * MiB;
constexpr size_t WS_R2   = 270 * MiB;
constexpr size_t WS_R3   = 406 * MiB;
constexpr size_t WS_WD1  = 542 * MiB;
constexpr size_t WS_END  = 574 * MiB;
constexpr size_t OFF_GS = 66 * MiB, OFF_AMAT = 84 * MiB;
constexpr size_t OFF_E = 98 * MiB;
constexpr int POWS = 20;
static_assert((size_t)XROWS * 2048 == 136 * MiB, "MoE row buffers are 136 MiB");
constexpr int CW_TMO = 0, CW_CODE = 1;
constexpr int CW_BAR = 4096;
constexpr int CW_TS = 8192;
constexpr int CW_Q = 16384;
constexpr int RING_OFF = 0, RING_BYTES = 131072;
constexpr int LDSCTL_OFF = RING_BYTES, MISC_OFF = LDSCTL_OFF + 320;
constexpr int LDS_BYTES = 147456;
constexpr int NWAVES = 8;


struct Args { const float* in[31]; float* out; unsigned char* ws; int ph_lo, ph_hi; };
typedef const GAS float* fptr_t;
typedef const __attribute__((address_space(4))) fptr_t kfptr;
struct Ctx {
    LAS unsigned char* lds; volatile LAS unsigned* MISC; gu32* ctl;
    int tid, lane, wave, vcu, G;
    kfptr* inp; GAS float* out; GAS unsigned char* ws;
};
enum InIdx { I_X = 0, I_C, I_CTX, I_CCTX, I_ADAW, I_ADAB, I_NMIXG, I_NFFNG, I_WIN, I_QNG, I_KNG, I_SINK, I_LRE, I_LIM, I_LOGDT, I_BRE, I_BIM, I_CRE, I_CIM,
             I_S5D, I_GLUW, I_GLUB, I_SGUNG, I_SGUW, I_SGUB, I_ONG, I_WOUT, I_ROUTW, I_WG, I_WU, I_WDN };

__device__ __forceinline__ float bf2f(unsigned h) { return __uint_as_float(h << 16); }
__device__ __forceinline__ float wave_sum(float v) {
#pragma unroll
    for (int o = 1; o < 64; o <<= 1) v += __shfl_xor(v, o);
    return v;
}
__device__ __forceinline__ float gelu_tanh(float x) {
    const float z2 = 1.5957691216057308f * (x + 0.044715f * x * x * x);
    return x * __builtin_amdgcn_rcpf(1.0f + __builtin_amdgcn_exp2f(-z2 * LOG2E));
}
__device__ __forceinline__ float silu_f(float x) { return x / (1.0f + __expf(-x)); }
#define WG_SYNC() do { asm volatile("s_waitcnt vmcnt(0) lgkmcnt(0)" ::: "memory"); __syncthreads(); } while (0)

__device__ __forceinline__ int q_next(const Ctx& c, int qi) {
    LDS_WAIT(); __syncthreads();
    if (c.tid == 0) c.MISC[16] = __hip_atomic_fetch_add(c.ctl + CW_Q + 64 * qi, 1u, RLX_AGENT);
    __syncthreads();
    const int u = (int)c.MISC[16];
    return __builtin_amdgcn_readfirstlane(u);
}

__device__ __forceinline__ void transpose_item(const GAS float* W, int K, int N, bf16* WT, int ilv, LAS float* scr, int item, int lane) {
    const int nblk = N / 32, kb = item / nblk, nb = item % nblk, k0 = 64 * kb, n0 = 32 * nb;
    const int row_off = ilv ? ((n0 >> 7) * 128 + (ilv == 2 ? 128 : 0)) : 0;
    { const int n4 = (lane & 7) * 4; f32x4 v[8];
#pragma unroll
      for (int i = 0; i < 8; ++i) v[i] = *(const GAS f32x4*)(W + (size_t)(k0 + (lane >> 3) + 8 * i) * N + n0 + n4);
#pragma unroll
      for (int i = 0; i < 8; ++i) { LAS float* d = scr + ((lane >> 3) + 8 * i) * 33 + n4; d[0] = v[i][0]; d[1] = v[i][1]; d[2] = v[i][2]; d[3] = v[i][3]; } }
    LDS_WAIT(); asm volatile("" ::: "memory");
    const int cc = lane & 7;
#pragma unroll
    for (int j = 0; j < 4; ++j) { const int n = (lane >> 3) + 8 * j; const LAS float* s = scr + (8 * cc) * 33 + n;
        v4u o; o.x = pk2(s[0 * 33], s[1 * 33]); o.y = pk2(s[2 * 33], s[3 * 33]); o.z = pk2(s[4 * 33], s[5 * 33]); o.w = pk2(s[6 * 33], s[7 * 33]);
        *(GAS v4u*)(WT + (size_t)(row_off + n0 + n) * K + k0 + 8 * cc) = o; }
    LDS_WAIT(); asm volatile("" ::: "memory");
}
__device__ __forceinline__ void convert_experts(const Ctx& c_, int l, int w_lo, int w_hi, int blk_lo) { Ctx c = c_; asm volatile("" : "+s"(c.ws), "+s"(c.inp), "+s"(c.out), "+v"(c.tid)); c.lane = c.tid & 63; asm volatile("" : "+s"(l));
    LAS float* scr = (LAS float*)(c.lds + RING_OFF + c.wave * 16384);
    const int gw = (blk_lo ? (int)blockIdx.x - blk_lo : c.vcu) * NWAVES + c.wave, NGW = (c.G - blk_lo) * NWAVES;
    bf16* WGU = (bf16*)(c.ws + WS_WGU); bf16* WD = (bf16*)(c.ws + (l == 0 ? WS_WD : WS_WD1));
    if (gw < 0) return;
    for (int it = w_lo * 16 * 512 + gw; it < w_hi * 16 * 512; it += NGW) {
        const int which = it / (16 * 512), r = it % (16 * 512), e = r / 512, item = r % 512;
        const size_t wofs = ((size_t)l * 16 + e) * 1024 * 1024;
        if (which == 0) transpose_item(c.inp[I_WG] + wofs, 1024, 1024, WGU + (size_t)e * 2048 * 1024, 1, scr, item, c.lane);
        else if (which == 1) transpose_item(c.inp[I_WU] + wofs, 1024, 1024, WGU + (size_t)e * 2048 * 1024, 2, scr, item, c.lane);
        else transpose_item(c.inp[I_WDN] + wofs, 1024, 1024, WD + (size_t)e * 1024 * 1024, 0, scr, item, c.lane);
    }
}

__device__ __forceinline__ void p0a(const Ctx& c_) { Ctx c = c_; asm volatile("" : "+s"(c.ws), "+s"(c.inp), "+s"(c.out), "+v"(c.tid)); c.lane = c.tid & 63;
    {
        float* modv = (float*)(c.ws + WS_MODV); LAS float* red = (LAS float*)(c.lds + RING_OFF);
        for (int it = (int)blockIdx.x; it < 192; it += c.G) {
            const int l = it / 96, col = (it % 96) * 64 + c.lane;
            const GAS float* W = c.inp[I_ADAW] + (size_t)l * 1024 * 6144 + col;
            float a0 = 0.f, a1 = 0.f, a2 = 0.f;
            const int kb = c.wave * 128;
#pragma unroll 8
            for (int k = 0; k < 128; ++k) { const float w = W[(size_t)(kb + k) * 6144];
                a0 += silu_f(c.inp[I_C][kb + k]) * w; a1 += silu_f(c.inp[I_C][1024 + kb + k]) * w; a2 += silu_f(c.inp[I_CCTX][kb + k]) * w; }
            red[(c.wave * 3 + 0) * 64 + c.lane] = a0; red[(c.wave * 3 + 1) * 64 + c.lane] = a1; red[(c.wave * 3 + 2) * 64 + c.lane] = a2;
            WG_SYNC();
            if (c.wave < 3) { float s = 0.f;
#pragma unroll
                for (int w = 0; w < 8; ++w) s += red[(w * 3 + c.wave) * 64 + c.lane];
                modv[(size_t)(l * 3 + c.wave) * 6144 + col] = s + c.inp[I_ADAB][l * 6144 + col]; }
            WG_SYNC();
        }
    }
    {
        LAS float* scr = (LAS float*)(c.lds + RING_OFF + c.wave * 16384);
        const int gw = c.vcu * NWAVES + c.wave, NGW = c.G * NWAVES;
        constexpr int I_IN = 16 * 48, I_OUT = 16 * 32, I_GLU = 4 * 8;
        constexpr int NIT = 2 * (I_IN + I_OUT + I_GLU);
        for (int it = gw; it < NIT; it += NGW) {
            int r = it; const int l = r / (I_IN + I_OUT + I_GLU); r %= (I_IN + I_OUT + I_GLU);
            if (r < I_IN) { transpose_item(c.inp[I_WIN] + (size_t)l * 1024 * INW, 1024, INW, (bf16*)(c.ws + WS_WIN) + (size_t)l * INW * 1024, 0, scr, r, c.lane); continue; } r -= I_IN;
            if (r < I_OUT) { transpose_item(c.inp[I_WOUT] + (size_t)l * 1024 * 1024, 1024, 1024, (bf16*)(c.ws + WS_WOUT) + (size_t)l * 1024 * 1024, 0, scr, r, c.lane); continue; } r -= I_OUT;
            transpose_item(c.inp[I_GLUW] + (size_t)l * 256 * 256, 256, 256, (bf16*)(c.ws + WS_WGLU) + (size_t)l * 256 * 256, 0, scr, r, c.lane);
        }
        bf16* wsgu = (bf16*)(c.ws + WS_WSGU);
        for (int i = c.vcu * 512 + c.tid; i < 131072 / 8; i += c.G * 512) { const GAS float* s = c.inp[I_SGUW] + (size_t)i * 8;
            v4u o; o.x = pk2(s[0], s[1]); o.y = pk2(s[2], s[3]); o.z = pk2(s[4], s[5]); o.w = pk2(s[6], s[7]); *(GAS v4u*)(wsgu + (size_t)i * 8) = o; }
    }
    {
        f32x2* POW = (f32x2*)(c.ws + WS_POW); f32x2* BBAR = (f32x2*)(c.ws + WS_BBAR);
        for (int idx = c.vcu * 512 + c.tid; idx < 2 * 2 * 16 * 64; idx += c.G * 512) {
            const double lr = (double)c.inp[I_LRE][idx], li = (double)c.inp[I_LIM][idx], dt = exp((double)c.inp[I_LOGDT][idx >> 6]);
            for (int k = 0; k < 19; ++k) { const double kk = (k == 17) ? 256.0 : (k == 18) ? 2080.0 : (double)k; const double mag = exp(lr * dt * kk), ang = li * dt * kk;
                POW[(size_t)idx * POWS + k] = (f32x2){(float)(mag * cos(ang)), (float)(mag * sin(ang))}; }
            const double mag = exp(lr * dt), ang = li * dt; const double abr = mag * cos(ang), abi = mag * sin(ang);
            const double nr = abr - 1.0, ni = abi, den = lr * lr + li * li;
            const double cr = (nr * lr + ni * li) / den, ci = (ni * lr - nr * li) / den;
            for (int ch = 0; ch < 16; ++ch) { const double br = (double)c.inp[I_BRE][(size_t)idx * 16 + ch], bi = (double)c.inp[I_BIM][(size_t)idx * 16 + ch];
                BBAR[(size_t)idx * 16 + ch] = (f32x2){(float)(cr * br - ci * bi), (float)(cr * bi + ci * br)}; }
        }
    }
    { f32x2* ROPE = (f32x2*)(c.ws + WS_ROPE);
      for (int i = c.vcu * 512 + c.tid; i < 256 * 16; i += c.G * 512) { const int pos = i >> 4, f = i & 15;
          const double inv = exp2(-(double)(2 * f) * (13.287712379549449 / 32.0)), ang = (double)pos * inv; ROPE[i] = (f32x2){(float)cos(ang), (float)sin(ang)}; } }
    convert_experts(c, 0, 0, 3, 0);
}

__device__ __forceinline__ void p0b_tables(const Ctx& c_) { Ctx c = c_; asm volatile("" : "+s"(c.ws), "+s"(c.inp), "+s"(c.out), "+v"(c.tid)); c.lane = c.tid & 63;
    const GAS f32x2* POW = (const GAS f32x2*)(c.ws + WS_POW); const GAS f32x2* BBAR = (const GAS f32x2*)(c.ws + WS_BBAR);
    bf16* EB = (bf16*)(c.ws + WS_EB);
    const int gt = c.vcu * 512 + c.tid, NT = c.G * 512;
    for (int it = gt; it < 262144; it += NT) {
        const int k0 = (it & 31) * 8, n = (it >> 5) & 255, g = (it >> 13) & 15, l = it >> 17;
        const int d = n >> 7, p = (n & 127) >> 1, ri = n & 1, s = k0 >> 4, c0 = k0 & 15;
        const int cidx = ((l * 2 + d) * 16 + g) * 64 + p;
        const f32x2 pw = POW[(size_t)cidx * POWS + (d == 0 ? 15 - s : s)];
        float v[8];
#pragma unroll
        for (int j = 0; j < 8; ++j) { const f32x2 bb = BBAR[(size_t)cidx * 16 + c0 + j]; v[j] = ri ? (pw.x * bb.y + pw.y * bb.x) : (pw.x * bb.x - pw.y * bb.y); }
        v4u o; o.x = pk2(v[0], v[1]); o.y = pk2(v[2], v[3]); o.z = pk2(v[4], v[5]); o.w = pk2(v[6], v[7]);
        *(GAS v4u*)(EB + ((size_t)((l * 16 + g) * 256 + n)) * 256 + k0) = o;
    }
    float* KT = (float*)(c.ws + WS_KTAB);
    for (int it = gt; it < 32768; it += NT) {
        const int c0 = (it & 1) * 8, ch = (it >> 1) & 15, dl = (it >> 5) & 15, d = (it >> 9) & 1, g = (it >> 10) & 15, l = it >> 14;
        const int cb = ((l * 2 + d) * 16 + g) * 64; const size_t cofs = ((size_t)((l * 2 + d) * 16 + g) * 16 + ch) * 64;
        float v[8];
#pragma unroll
        for (int j = 0; j < 8; ++j) v[j] = 0.f;
        for (int p = 0; p < 64; ++p) {
            const float cre = c.inp[I_CRE][cofs + p], cim = c.inp[I_CIM][cofs + p];
            const f32x2 pw = POW[(size_t)(cb + p) * POWS + dl];
            const float wr = cre * pw.x - cim * pw.y, wi = cre * pw.y + cim * pw.x;
#pragma unroll
            for (int j = 0; j < 8; ++j) { const f32x2 bb = BBAR[(size_t)(cb + p) * 16 + c0 + j]; v[j] += wr * bb.x - wi * bb.y; }
        }
        float* dst = KT + ((size_t)(((l * 16 + g) * 2 + d) * 16 + dl) * 16 + ch) * 16 + c0;
        *(GAS f32x4*)dst = (f32x4){v[0], v[1], v[2], v[3]}; *(GAS f32x4*)(dst + 4) = (f32x4){v[4], v[5], v[6], v[7]};
    }
}
__device__ __forceinline__ void tg_assemble(const Ctx& c_) { Ctx c = c_; asm volatile("" : "+s"(c.ws), "+s"(c.inp), "+s"(c.out), "+v"(c.tid)); c.lane = c.tid & 63;
    const GAS f32x2* POW = (const GAS f32x2*)(c.ws + WS_POW); const GAS float* KT = (const GAS float*)(c.ws + WS_KTAB); bf16* TG = (bf16*)(c.ws + WS_TG);
    const int gt = c.vcu * 512 + c.tid, NT = c.G * 512;
    for (int it = gt; it < 524288; it += NT) {
        const int k0 = (it & 63) * 8, n = (it >> 6) & 255, g = (it >> 14) & 15, l = it >> 18;
        const int tau = n >> 4, ch = n & 15;
        float v[8];
        if (k0 < 256) {
            const int s = k0 >> 4, c0 = k0 & 15;
#pragma unroll
            for (int j = 0; j < 8; ++j) v[j] = (s == tau && (c0 + j) == ch) ? c.inp[I_S5D][l * 256 + g * 16 + ch] : 0.f;
#pragma unroll
            for (int d = 0; d < 2; ++d) { const int dl = d == 0 ? tau - s : s - tau;
                if (dl >= 0) { const GAS float* kp = KT + ((size_t)(((l * 16 + g) * 2 + d) * 16 + dl) * 16 + ch) * 16 + c0; const f32x4 k0v = *(const GAS f32x4*)kp, k1v = *(const GAS f32x4*)(kp + 4);
                    v[0] += k0v[0]; v[1] += k0v[1]; v[2] += k0v[2]; v[3] += k0v[3]; v[4] += k1v[0]; v[5] += k1v[1]; v[6] += k1v[2]; v[7] += k1v[3]; } }
        } else {
#pragma unroll
            for (int j = 0; j < 8; ++j) { const int kk = k0 - 256 + j, d = kk >> 7, p = (kk & 127) >> 1, ri = kk & 1;
                const int cidx = ((l * 2 + d) * 16 + g) * 64 + p;
                const float cre = c.inp[I_CRE][((size_t)((l * 2 + d) * 16 + g) * 16 + ch) * 64 + p], cim = c.inp[I_CIM][((size_t)((l * 2 + d) * 16 + g) * 16 + ch) * 64 + p];
                const f32x2 pw = POW[(size_t)cidx * POWS + (d == 0 ? tau + 1 : 16 - tau)];
                const float wr = cre * pw.x - cim * pw.y, wi = cre * pw.y + cim * pw.x;
                v[j] = ri ? -wi : wr; }
        }
        v4u o; o.x = pk2(v[0], v[1]); o.y = pk2(v[2], v[3]); o.z = pk2(v[4], v[5]); o.w = pk2(v[6], v[7]);
        *(GAS v4u*)(TG + ((size_t)((l * 16 + g) * 256 + n)) * 512 + k0) = o;
    }
}

__device__ __forceinline__ void row_prep(const Ctx& c_, int mode, int l) { Ctx c = c_; asm volatile("" : "+s"(c.ws), "+s"(c.inp), "+s"(c.out), "+v"(c.tid)); c.lane = c.tid & 63; asm volatile("" : "+s"(l));
    const int gw = c.vcu * NWAVES + c.wave, NGW = c.G * NWAVES;
    const GAS float* modv = (const GAS float*)(c.ws + WS_MODV);
    const GAS bf16* Y = (const GAS bf16*)(c.ws + WS_R3); GAS bf16* A1 = (GAS bf16*)(c.ws + WS_R1);
    const GAS int* smapL = (const GAS int*)(c.ws + WS_SMAP); const GAS int* smapC = smapL + 2 * 16 * 16384;
    GAS float* hctx = (GAS float*)(c.ws + WS_HCTX);
    const int nrows = (mode == 2) ? MLAT : MT;
    float dscale = 1.0f;
#if defined(TPROBE) || defined(TPROBE_UNIT)
    if (mode == 2) {
#if defined(TPROBE_UNIT)
        const unsigned su = __hip_atomic_load(c.ctl + CW_TS + 40, RLX_AGENT), cn = __hip_atomic_load(c.ctl + CW_TS + 41, RLX_AGENT);
        dscale = 1.0f + floorf((cn ? (float)su / (float)cn : 0.f) * (0.01f / TPQ) + 0.5f) * (TPQ / 1000.0f);
#else
        const unsigned ta = __hip_atomic_load(c.ctl + CW_TS + TPROBE, RLX_AGENT), tb = __hip_atomic_load(c.ctl + CW_TS + TPROBE + 1, RLX_AGENT);
        dscale = 1.0f + floorf((float)(tb - ta) * (0.01f / TPQ) + 0.5f) * (TPQ / 1000.0f);
#endif
    }
#endif
#define RP_LOAD_X(M0, DST) do { const int m0_ = (M0); const bool ic_ = m0_ >= MLAT; _Pragma("unroll") for (int q = 0; q < 4; ++q) { const int m_ = m0_ + q; \
        const GAS float* src_ = ic_ ? c.inp[I_CTX] + (size_t)(m_ - MLAT) * D : c.inp[I_X] + (size_t)m_ * D; \
        _Pragma("unroll") for (int j = 0; j < 4; ++j) DST[q][j] = *(const GAS f32x4*)(src_ + 4 * c.lane + 256 * j); } } while (0)
    f32x4 vnx[4][4];
    if (mode == 0 && gw * 4 < nrows) RP_LOAD_X(gw * 4, vnx);
    for (int m0 = gw * 4; m0 < nrows; m0 += NGW * 4) {
        const bool isctx = m0 >= MLAT; const int b = isctx ? ((m0 - MLAT) >> 8) : (m0 >> 14), mb = isctx ? 2 : b;
        f32x4 v[4][4];
        if (mode == 0) {
#pragma unroll
            for (int q = 0; q < 4; ++q)
#pragma unroll
                for (int j = 0; j < 4; ++j) v[q][j] = vnx[q][j];
            if (m0 + NGW * 4 < nrows) RP_LOAD_X(m0 + NGW * 4, vnx);
        } else
#pragma unroll
        for (int q = 0; q < 4; ++q) { const int m = m0 + q;
            if (mode != 0 && !isctx) { const GAS bf16* hb = (const GAS bf16*)c.out + (size_t)m * 2048;
#pragma unroll
                for (int j = 0; j < 4; ++j) { const u32x2 w = *(const GAS u32x2*)(hb + 4 * c.lane + 256 * j); v[q][j] = (f32x4){bf2f(w.x & 0xffffu), bf2f(w.x >> 16), bf2f(w.y & 0xffffu), bf2f(w.y >> 16)}; } }
            else { const GAS float* src = (mode == 0) ? (isctx ? c.inp[I_CTX] + (size_t)(m - MLAT) * D : c.inp[I_X] + (size_t)m * D) : hctx + (size_t)(m - MLAT) * D;
#pragma unroll
                for (int j = 0; j < 4; ++j) v[q][j] = *(const GAS f32x4*)(src + 4 * c.lane + 256 * j); } }
        if (mode != 0) {
            const GAS float* gff = modv + (size_t)((l - 1 + (mode == 2 ? 1 : 0)) * 3 + mb) * 6144 + 5 * 1024;
            f32x4 acc[4][4]; int myslot[4]; unsigned long long msk[4];
#pragma unroll
            for (int q = 0; q < 4; ++q) { const int m = m0 + q, t = isctx ? ((m - MLAT) & 255) : (m & 16383);
                myslot[q] = (c.lane < NE) ? (isctx ? smapC[(b * 16 + c.lane) * 256 + t] : smapL[(b * 16 + c.lane) * 16384 + t]) : -1;
#pragma unroll
                for (int j = 0; j < 4; ++j) acc[q][j] = (f32x4){0.f, 0.f, 0.f, 0.f}; }
#pragma unroll
            for (int q = 0; q < 4; ++q) msk[q] = __ballot(myslot[q] >= 0);
            while (msk[0] | msk[1] | msk[2] | msk[3]) {
                u32x2 w[4][4]; float f[4];
#pragma unroll
                for (int q = 0; q < 4; ++q) { const bool has = msk[q] != 0; const int e = has ? __builtin_ctzll(msk[q]) : 0; if (has) msk[q] &= msk[q] - 1;
                    const int sl = __shfl(myslot[q], e); f[q] = has ? 1.0f : 0.0f;
                    const size_t y = !has ? (size_t)0 : isctx ? (size_t)(XLAT + e * 256 + b * 32 + sl) : (size_t)((b * 16 + e) * CAPL + sl);
#pragma unroll
                    for (int j = 0; j < 4; ++j) w[q][j] = *(const GAS u32x2*)(Y + y * D + 4 * c.lane + 256 * j); }
#pragma unroll
                for (int q = 0; q < 4; ++q)
#pragma unroll
                    for (int j = 0; j < 4; ++j) acc[q][j] += (f32x4){bf2f(w[q][j].x & 0xffffu), bf2f(w[q][j].x >> 16), bf2f(w[q][j].y & 0xffffu), bf2f(w[q][j].y >> 16)} * f[q];
            }
#pragma unroll
            for (int q = 0; q < 4; ++q) { const int m = m0 + q;
#pragma unroll
                for (int j = 0; j < 4; ++j) { v[q][j] += *(const GAS f32x4*)(gff + 4 * c.lane + 256 * j) * acc[q][j];
                    if (mode == 2) *(GAS f32x4*)(c.out + (size_t)m * D + 4 * c.lane + 256 * j) = v[q][j] * dscale;
                    else if (isctx) *(GAS f32x4*)(hctx + (size_t)(m - MLAT) * D + 4 * c.lane + 256 * j) = v[q][j];
                    else { u32x2 w; w.x = pk2(v[q][j].x, v[q][j].y); w.y = pk2(v[q][j].z, v[q][j].w); *(GAS u32x2*)((GAS bf16*)c.out + (size_t)m * 2048 + 4 * c.lane + 256 * j) = w; } } }
        }
        if (mode == 2) continue;
        float rstd[4];
#pragma unroll
        for (int q = 0; q < 4; ++q) { float ss = 0.f;
#pragma unroll
            for (int j = 0; j < 4; ++j) ss += (v[q][j].x * v[q][j].x + v[q][j].y * v[q][j].y) + (v[q][j].z * v[q][j].z + v[q][j].w * v[q][j].w);
            rstd[q] = ss; }
#pragma unroll
        for (int o = 1; o < 64; o <<= 1) {
#pragma unroll
            for (int q = 0; q < 4; ++q) rstd[q] += __shfl_xor(rstd[q], o); }
#pragma unroll
        for (int q = 0; q < 4; ++q) rstd[q] = 1.0f / sqrtf(rstd[q] * (1.0f / D) + EPS);
        const GAS float* mo = modv + (size_t)(l * 3 + mb) * 6144; const GAS float* gn = c.inp[I_NMIXG] + l * D;
#pragma unroll
        for (int j = 0; j < 4; ++j) { const int col = 4 * c.lane + 256 * j;
            const f32x4 g = *(const GAS f32x4*)(gn + col), sh = *(const GAS f32x4*)(mo + col), sc = *(const GAS f32x4*)(mo + 1024 + col);
            const f32x4 gs = g * (sc + 1.0f);
#pragma unroll
            for (int q = 0; q < 4; ++q) { const f32x4 a = v[q][j] * rstd[q] * gs + sh;
                u32x2 w; w.x = pk2(a.x, a.y); w.y = pk2(a.z, a.w); *(GAS u32x2*)(A1 + (size_t)(m0 + q) * D + col) = w; } }
    }
}
#undef RP_LOAD_X

__device__ __forceinline__ f32x4 mfma16(bf16x8 a, bf16x8 b, f32x4 c) { return __builtin_amdgcn_mfma_f32_16x16x32_bf16(a, b, c, 0, 0, 0); }
__device__ __forceinline__ f32x16 mfma32(bf16x8 a, bf16x8 b, f32x16 c) { return __builtin_amdgcn_mfma_f32_32x32x16_bf16(a, b, c, 0, 0, 0); }

__device__ __forceinline__ void qk_prep_rows(const Ctx& c_, int l) { Ctx c = c_; asm volatile("" : "+s"(c.ws), "+s"(c.inp), "+s"(c.out), "+v"(c.tid)); c.lane = c.tid & 63; asm volatile("" : "+s"(l));
    bf16* P = (bf16*)(c.ws + WS_R2); const GAS f32x2* ROPE = (const GAS f32x2*)(c.ws + WS_ROPE);
    const int j = c.lane & 7, rsub = c.lane >> 4, chunk = c.lane & 15;
    const f32x4 kg0 = *(const GAS f32x4*)(c.inp[I_KNG] + l * 64 + 8 * j), kg1 = *(const GAS f32x4*)(c.inp[I_KNG] + l * 64 + 8 * j + 4);
    const float kgn[8] = {kg0[0], kg0[1], kg0[2], kg0[3], kg1[0], kg1[1], kg1[2], kg1[3]};
#pragma unroll 2
    for (int blk = c.vcu * NWAVES + c.wave; blk < MT / 4; blk += c.G * NWAVES) {
        const int m = blk * 4 + rsub;
        const bool isctx = m >= MLAT;
        bf16* kp = P + (size_t)m * INW + 512 + 8 * chunk;
        const v4u w = *(const GAS v4u*)kp; const unsigned ws4[4] = {w.x, w.y, w.z, w.w};
        float cs[8], sn[8];
        if (!isctx) { const int n = m & 16383, pos = (j < 4) ? (n >> 6) : (n & 63); const GAS f32x4* tp = (const GAS f32x4*)(ROPE + pos * 16 + 8 * (j & 1));
#pragma unroll
            for (int q = 0; q < 4; ++q) { const f32x4 t4 = tp[q]; cs[2 * q] = t4[0]; sn[2 * q] = t4[1]; cs[2 * q + 1] = t4[2]; sn[2 * q + 1] = t4[3]; } }
        else {
#pragma unroll
            for (int e = 0; e < 8; ++e) { cs[e] = 1.f; sn[e] = 0.f; } }
        float x[8]; float ss = 0.f;
#pragma unroll
        for (int e = 0; e < 8; ++e) { x[e] = __uint_as_float((e & 1) ? (ws4[e >> 1] & 0xffff0000u) : (ws4[e >> 1] << 16)); ss += x[e] * x[e]; }
        ss += __shfl_xor(ss, 1); ss += __shfl_xor(ss, 2); ss += __shfl_xor(ss, 4);
        const float rstd = 1.0f / sqrtf(ss * (1.0f / 64.0f) + EPS);
        float o[8];
#pragma unroll
        for (int e = 0; e < 8; ++e) { const float xn = x[e] * rstd * kgn[e]; const float pr = __shfl_xor(xn, 2);
            o[e] = (j & 2) ? (xn * cs[e] + pr * sn[e]) : (xn * cs[e] - pr * sn[e]); }
        v4u ow; ow.x = pk2(o[0], o[1]); ow.y = pk2(o[2], o[3]); ow.z = pk2(o[4], o[5]); ow.w = pk2(o[6], o[7]);
        *(GAS v4u*)kp = ow;
    }
}
__device__ __forceinline__ int s5_scan_sc(int q, int b, int d) { return q < 16 ? (2048 + 16 * b + (d ? 15 - q : q)) : (b * 1024 + (d ? 1039 - q : q - 16)); }
__device__ __forceinline__ void s5_scan_unit(const Ctx& c_, int l, int unit) { Ctx c = c_; asm volatile("" : "+s"(c.ws), "+s"(c.inp), "+s"(c.out), "+v"(c.tid)); c.lane = c.tid & 63; asm volatile("" : "+s"(l));
    const int g = unit & 15, d = (unit >> 4) & 1, b = unit >> 5;
    const GAS float* E = (const GAS float*)(c.ws + WS_R2 + OFF_E) + (size_t)g * 2304 * 256 + d * 128 + 2 * c.lane;
    bf16* Am = (bf16*)(c.ws + WS_R1 + OFF_AMAT) + (size_t)g * 2304 * 512 + 256 + d * 128 + 2 * c.lane;
    const GAS f32x2* POW = (const GAS f32x2*)(c.ws + WS_POW) + (size_t)(((l * 2 + d) * 16 + g) * 64 + c.lane) * POWS;
    const f32x2 a16 = POW[16], aseg = POW[18];
    LAS f32x2* X = (LAS f32x2*)(c.lds + RING_OFF);
    const int q0 = 130 * c.wave;
    float hr = 0.f, hi = 0.f;
#pragma unroll 1
    for (int s0 = 0; s0 < 130; s0 += 26) {
        f32x2 e[26];
#pragma unroll
        for (int j = 0; j < 26; ++j) e[j] = *(const GAS f32x2*)(E + (size_t)s5_scan_sc(q0 + s0 + j, b, d) * 256);
#pragma unroll
        for (int j = 0; j < 26; ++j) { const float nr = a16.x * hr - a16.y * hi + e[j].x, ni = a16.x * hi + a16.y * hr + e[j].y; hr = nr; hi = ni; }
    }
    __syncthreads();
    X[c.wave * 64 + c.lane] = (f32x2){hr, hi};
    LDS_WAIT(); __syncthreads();
    hr = 0.f; hi = 0.f;
    for (int w = 0; w < c.wave; ++w) { const f32x2 x = X[w * 64 + c.lane]; const float nr = aseg.x * hr - aseg.y * hi + x.x, ni = aseg.x * hi + aseg.y * hr + x.y; hr = nr; hi = ni; }
#pragma unroll 1
    for (int s0 = 0; s0 < 130; s0 += 26) {
        f32x2 e[26];
#pragma unroll
        for (int j = 0; j < 26; ++j) e[j] = *(const GAS f32x2*)(E + (size_t)s5_scan_sc(q0 + s0 + j, b, d) * 256);
#pragma unroll
        for (int j = 0; j < 26; ++j) { *(GAS unsigned*)(Am + (size_t)s5_scan_sc(q0 + s0 + j, b, d) * 512) = pk2(hr, hi);
            const float nr = a16.x * hr - a16.y * hi + e[j].x, ni = a16.x * hi + a16.y * hr + e[j].y; hr = nr; hi = ni; }
    }
}

constexpr int ATT_ROWB = 144;
constexpr int ATT_TILEB = 64 * ATT_ROWB, ATT_BUFB = 4 * ATT_TILEB;
constexpr float ATT_SUMMAX = 1099511627776.0f;
__device__ __forceinline__ void attn_unit(const Ctx& c_, int l, int unit) { Ctx c = c_; asm volatile("" : "+s"(c.ws), "+s"(c.inp), "+s"(c.out), "+v"(c.tid)); c.lane = c.tid & 63; asm volatile("" : "+s"(l));
    const GAS bf16* P = (const GAS bf16*)(c.ws + WS_R2); GAS bf16* mix = (GAS bf16*)(c.ws + WS_R1);
    int b, kvh, qb; bool isctx;
    if (unit < 512) { b = unit >> 8; kvh = (unit >> 7) & 1; qb = unit & 127; isctx = false; }
    else { const int u2 = unit - 512; b = u2 >> 2; kvh = (u2 >> 1) & 1; qb = u2 & 1; isctx = true; }
    const int r32 = c.lane & 31, hi = c.lane >> 5, wsub = c.wave >> 2;
    const int hq = kvh * 4 + (c.wave & 3);
    const float sink2 = c.inp[I_SINK][l * 8 + hq] * LOG2E;
    const int q4 = (c.lane & 15) >> 2, p4 = c.lane & 3, d0 = 16 * ((c.lane >> 4) & 1);
    const int vlane_off = (4 * hi + q4) * ATT_ROWB + (d0 + 4 * p4) * 2;
    const int qrow0 = (isctx ? (MLAT + b * LC + qb * 128) : (b * SEQ + qb * 128)) + 64 * wsub + r32;
    const int key = c.tid >> 3, chk = c.tid & 7;
    int p = isctx ? 3 : 0;
    while (p < 3 && (128 * (qb - 1 + p) < 0 || 128 * (qb - 1 + p) >= SEQ)) ++p;
    int pn = p + 1;
    while (pn < 3 && (128 * (qb - 1 + pn) < 0 || 128 * (qb - 1 + pn) >= SEQ)) ++pn;
    v4u kv[2], vv[2];
#define ATT_LOAD(PP) do { const int krow_ = ((PP) < 3 ? b * SEQ + 128 * (qb - 1 + (PP)) : MLAT + b * LC + 128 * ((PP) - 3)) + key; const GAS bf16* src_ = P + (size_t)krow_ * INW + 64 * kvh + 8 * chk; \
        kv[0] = *(const GAS v4u*)(src_ + 512); vv[0] = *(const GAS v4u*)(src_ + 640); kv[1] = *(const GAS v4u*)(src_ + 64 * INW + 512); vv[1] = *(const GAS v4u*)(src_ + 64 * INW + 640); } while (0)
#define ATT_STORE(BUF) do { LAS unsigned char* d_ = c.lds + (BUF) * ATT_BUFB + key * ATT_ROWB + chk * 16; \
        *(LAS v4u*)(d_) = kv[0]; *(LAS v4u*)(d_ + ATT_TILEB) = kv[1]; *(LAS v4u*)(d_ + 2 * ATT_TILEB) = vv[0]; *(LAS v4u*)(d_ + 3 * ATT_TILEB) = vv[1]; } while (0)
    ATT_LOAD(p);
    bf16x8 qf[2][4];
#pragma unroll
    for (int qg = 0; qg < 2; ++qg)
#pragma unroll
        for (int ks = 0; ks < 4; ++ks) qf[qg][ks] = *(const GAS bf16x8*)(P + (size_t)(qrow0 + 32 * qg) * INW + 64 * hq + 16 * ks + 8 * hi);
    { const GAS f32x2* ROPE = (const GAS f32x2*)(c.ws + WS_ROPE);
      float qgn[4][8];
#pragma unroll
      for (int ks = 0; ks < 4; ++ks) { const f32x4 g0 = *(const GAS f32x4*)(c.inp[I_QNG] + l * 64 + 16 * ks + 8 * hi), g1 = *(const GAS f32x4*)(c.inp[I_QNG] + l * 64 + 16 * ks + 8 * hi + 4);
          qgn[ks][0] = g0[0]; qgn[ks][1] = g0[1]; qgn[ks][2] = g0[2]; qgn[ks][3] = g0[3]; qgn[ks][4] = g1[0]; qgn[ks][5] = g1[1]; qgn[ks][6] = g1[2]; qgn[ks][7] = g1[3]; }
#pragma unroll
      for (int qg = 0; qg < 2; ++qg) {
          float x[4][8]; float ss = 0.f;
#pragma unroll
          for (int ks = 0; ks < 4; ++ks) { const v4u w = __builtin_bit_cast(v4u, qf[qg][ks]); const unsigned ws4[4] = {w.x, w.y, w.z, w.w};
#pragma unroll
              for (int e = 0; e < 8; ++e) { x[ks][e] = __uint_as_float((e & 1) ? (ws4[e >> 1] & 0xffff0000u) : (ws4[e >> 1] << 16)); ss += x[ks][e] * x[ks][e]; } }
          ss += __shfl_xor(ss, 32);
          const float rstd = 1.0f / sqrtf(ss * (1.0f / 64.0f) + EPS) * (0.125f * LOG2E);
#pragma unroll
          for (int ks = 0; ks < 4; ++ks)
#pragma unroll
              for (int e = 0; e < 8; ++e) x[ks][e] *= rstd * qgn[ks][e];
          if (!isctx) { const int n = qb * 128 + 64 * wsub + 32 * qg + r32;
#pragma unroll
              for (int ax = 0; ax < 2; ++ax) { const int pos = ax == 0 ? (n >> 6) : (n & 63); const GAS f32x4* tp = (const GAS f32x4*)(ROPE + pos * 16 + 8 * hi);
#pragma unroll
                  for (int q = 0; q < 4; ++q) { const f32x4 t4 = tp[q];
#pragma unroll
                      for (int h2 = 0; h2 < 2; ++h2) { const int e = 2 * q + h2; const float cs = t4[2 * h2], sn = t4[2 * h2 + 1];
                          const float x1 = x[2 * ax][e], x2 = x[2 * ax + 1][e]; x[2 * ax][e] = x1 * cs - x2 * sn; x[2 * ax + 1][e] = x2 * cs + x1 * sn; } } } }
#pragma unroll
          for (int ks = 0; ks < 4; ++ks) { v4u w; w.x = pk2(x[ks][0], x[ks][1]); w.y = pk2(x[ks][2], x[ks][3]); w.z = pk2(x[ks][4], x[ks][5]); w.w = pk2(x[ks][6], x[ks][7]); qf[qg][ks] = __builtin_bit_cast(bf16x8, w); }
      } }
    float m_run[2], l_run[2]; f32x16 o[2][2];
#pragma unroll
    for (int qg = 0; qg < 2; ++qg) { m_run[qg] = sink2; l_run[qg] = hi == 0 ? 1.0f : 0.0f;
#pragma unroll
        for (int dt = 0; dt < 2; ++dt)
#pragma unroll
            for (int r = 0; r < 16; ++r) o[qg][dt][r] = 0.f; }
    __syncthreads();
    ATT_STORE(0);
    if (pn < 5) ATT_LOAD(pn);
    LDS_WAIT(); __syncthreads();
    int cur = 0;
#pragma unroll 1
    while (p < 5) {
        int pnn = pn + 1;
        while (pnn < 3 && (128 * (qb - 1 + pnn) < 0 || 128 * (qb - 1 + pnn) >= SEQ)) ++pnn;
        if (pn < 5) { ATT_STORE(cur ^ 1); if (pnn < 5) ATT_LOAD(pnn); }
        const bool win = p < 3;
#pragma unroll
        for (int sb = 0; sb < 2; ++sb) {
            const int t = 2 * p + sb;
            LAS unsigned char* kbase = c.lds + cur * ATT_BUFB + sb * ATT_TILEB; LAS unsigned char* vbase = kbase + 2 * ATT_TILEB;
            bool skip[2] = {false, false}, need_mask[2] = {false, false};
            if (win) {
    #pragma unroll
                for (int qg = 0; qg < 2; ++qg) { const int qlo = 128 * qb + 64 * wsub + 32 * qg, klo = 128 * (qb - 1) + 64 * t, dmax = klo + 63 - qlo, dmin = klo - qlo - 31;
                    skip[qg] = dmin > 128 || dmax < -128; need_mask[qg] = dmax > 128 || dmin < -128; } }
            if (!(skip[0] && skip[1])) {
                bf16x8 kf[8];
    #pragma unroll
                for (int ks = 0; ks < 4; ++ks) { kf[2 * ks] = *(const LAS bf16x8*)(kbase + r32 * ATT_ROWB + (16 * ks + 8 * hi) * 2);
                    kf[2 * ks + 1] = *(const LAS bf16x8*)(kbase + (32 + r32) * ATT_ROWB + (16 * ks + 8 * hi) * 2); }
                bf16x8 pf[2][4];
    #pragma unroll
                for (int qg = 0; qg < 2; ++qg) {
                    if (!skip[qg]) {
                        f32x16 s0, s1; { const float nm = -m_run[qg];
    #pragma unroll
                            for (int r = 0; r < 16; ++r) { s0[r] = nm; s1[r] = nm; } }
    #pragma unroll
                        for (int ks = 0; ks < 4; ++ks) { s0 = mfma32(kf[2 * ks], qf[qg][ks], s0); s1 = mfma32(kf[2 * ks + 1], qf[qg][ks], s1); }
                        if (need_mask[qg]) {
                            const int qp = 128 * qb + 64 * wsub + 32 * qg + r32, kb = 128 * (qb - 1) + 64 * t + 4 * hi;
    #pragma unroll
                            for (int r = 0; r < 16; ++r) { const int dk = kb + (r & 3) + 8 * (r >> 2) - qp;
                                if (dk > 128 || dk < -128) s0[r] = -INFINITY;
                                if (dk + 32 > 128 || dk + 32 < -128) s1[r] = -INFINITY; }
                        }
                        f32x16 e0, e1; float st;
                        { float sm[4] = {0.f, 0.f, 0.f, 0.f};
    #pragma unroll
                          for (int r = 0; r < 16; ++r) { e0[r] = __builtin_amdgcn_exp2f(s0[r]); e1[r] = __builtin_amdgcn_exp2f(s1[r]); float t2 = e0[r] + e1[r]; asm("" : "+v"(t2)); sm[r & 3] = r < 4 ? t2 : sm[r & 3] + t2; asm("" : "+v"(sm[r & 3])); }
                          st = (sm[0] + sm[1]) + (sm[2] + sm[3]); }
                        if (__any(!(st <= ATT_SUMMAX))) {
                            float mxa[8];
    #pragma unroll
                            for (int i = 0; i < 8; ++i) mxa[i] = fmaxf(fmaxf(s0[i], s0[i + 8]), fmaxf(s1[i], s1[i + 8]));
                            float mx = fmaxf(fmaxf(fmaxf(mxa[0], mxa[1]), fmaxf(mxa[2], mxa[3])), fmaxf(fmaxf(mxa[4], mxa[5]), fmaxf(mxa[6], mxa[7])));
                            mx = fmaxf(mx, __shfl_xor(mx, 32));
                            const float dl = fmaxf(mx, 0.f), alpha = __builtin_amdgcn_exp2f(-dl);
                            m_run[qg] += dl; l_run[qg] *= alpha;
    #pragma unroll
                            for (int dt = 0; dt < 2; ++dt)
    #pragma unroll
                                for (int r = 0; r < 16; ++r) o[qg][dt][r] *= alpha;
                            float sm[4] = {0.f, 0.f, 0.f, 0.f};
    #pragma unroll
                            for (int r = 0; r < 16; ++r) { e0[r] = __builtin_amdgcn_exp2f(s0[r] - dl); e1[r] = __builtin_amdgcn_exp2f(s1[r] - dl); sm[r & 3] += e0[r] + e1[r]; }
                            st = (sm[0] + sm[1]) + (sm[2] + sm[3]);
                        }
                        l_run[qg] += st;
    #pragma unroll
                        for (int s2 = 0; s2 < 2; ++s2) {
                            v4u pw; pw.x = pk2(e0[8 * s2 + 0], e0[8 * s2 + 1]); pw.y = pk2(e0[8 * s2 + 2], e0[8 * s2 + 3]); pw.z = pk2(e0[8 * s2 + 4], e0[8 * s2 + 5]); pw.w = pk2(e0[8 * s2 + 6], e0[8 * s2 + 7]);
                            pf[qg][s2] = __builtin_bit_cast(bf16x8, pw);
                            v4u pv; pv.x = pk2(e1[8 * s2 + 0], e1[8 * s2 + 1]); pv.y = pk2(e1[8 * s2 + 2], e1[8 * s2 + 3]); pv.z = pk2(e1[8 * s2 + 4], e1[8 * s2 + 5]); pv.w = pk2(e1[8 * s2 + 6], e1[8 * s2 + 7]);
                            pf[qg][2 + s2] = __builtin_bit_cast(bf16x8, pv); }
                    } else {
    #pragma unroll
                        for (int i = 0; i < 4; ++i) pf[qg][i] = (bf16x8){0, 0, 0, 0, 0, 0, 0, 0};
                    }
                }
                bf16x8 vf[2][4];
    #pragma unroll
                for (int dt = 0; dt < 2; ++dt)
    #pragma unroll
                    for (int ks4 = 0; ks4 < 4; ++ks4) {
                        LAS unsigned char* vp = vbase + (16 * ks4) * ATT_ROWB + 64 * dt + vlane_off;
                        const v4i16_t lo = __builtin_amdgcn_ds_read_tr16_b64_v4i16((LAS v4i16_t*)vp);
                        const v4i16_t h8 = __builtin_amdgcn_ds_read_tr16_b64_v4i16((LAS v4i16_t*)(vp + 8 * ATT_ROWB));
                        vf[dt][ks4] = (bf16x8){lo[0], lo[1], lo[2], lo[3], h8[0], h8[1], h8[2], h8[3]}; }
    #pragma unroll
                for (int ks4 = 0; ks4 < 4; ++ks4)
    #pragma unroll
                    for (int dt = 0; dt < 2; ++dt)
    #pragma unroll
                        for (int qg = 0; qg < 2; ++qg) o[qg][dt] = mfma32(vf[dt][ks4], pf[qg][ks4], o[qg][dt]);
            }
        }
        LDS_WAIT(); __syncthreads();
        p = pn; pn = pnn; cur ^= 1;
    }
#undef ATT_LOAD
#undef ATT_STORE
#pragma unroll
    for (int qg = 0; qg < 2; ++qg) {
        const float lt = l_run[qg] + __shfl_xor(l_run[qg], 32), il = 1.0f / lt;
        GAS bf16* orow = mix + (size_t)(qrow0 + 32 * qg) * D + 64 * hq + 4 * hi;
#pragma unroll
        for (int dt = 0; dt < 2; ++dt)
#pragma unroll
            for (int rr = 0; rr < 4; ++rr) { u32x2 w; w.x = pk2(o[qg][dt][4 * rr] * il, o[qg][dt][4 * rr + 1] * il); w.y = pk2(o[qg][dt][4 * rr + 2] * il, o[qg][dt][4 * rr + 3] * il);
                *(GAS u32x2*)(orow + 32 * dt + 8 * rr) = w; }
    }
}

constexpr int SGU_ROWB = 528;
__device__ __forceinline__ void sgu_unit(const Ctx& c_, int l, int chunk) { Ctx c = c_; asm volatile("" : "+s"(c.ws), "+s"(c.inp), "+s"(c.out), "+v"(c.tid)); c.lane = c.tid & 63; asm volatile("" : "+s"(l));
    const bf16* P = (const bf16*)(c.ws + WS_R2); bf16* mix = (bf16*)(c.ws + WS_R1);
    const bf16* Ws = (const bf16*)(c.ws + WS_WSGU) + (size_t)l * 4 * 128 * 128;
    const int r0 = chunk * 128, fr = c.lane & 15, fq = c.lane >> 4;
    __syncthreads();
    { const f32x4 gn = *(const GAS f32x4*)(c.inp[I_SGUNG] + l * 256 + 4 * c.lane);
#pragma unroll 1
      for (int r4 = 0; r4 < 16; r4 += 4) {
        u32x2 w[4]; float v[4][4], ss[4];
#pragma unroll
        for (int q = 0; q < 4; ++q) w[q] = *(const GAS u32x2*)(P + (size_t)(r0 + c.wave * 16 + r4 + q) * INW + 1280 + 4 * c.lane);
#pragma unroll
        for (int q = 0; q < 4; ++q) { v[q][0] = gelu_tanh(bf2f(w[q].x & 0xffffu)); v[q][1] = gelu_tanh(bf2f(w[q].x >> 16)); v[q][2] = gelu_tanh(bf2f(w[q].y & 0xffffu)); v[q][3] = gelu_tanh(bf2f(w[q].y >> 16));
            ss[q] = (v[q][0] * v[q][0] + v[q][1] * v[q][1]) + (v[q][2] * v[q][2] + v[q][3] * v[q][3]); }
#pragma unroll
        for (int o = 1; o < 64; o <<= 1) {
#pragma unroll
            for (int q = 0; q < 4; ++q) ss[q] += __shfl_xor(ss[q], o); }
#pragma unroll
        for (int q = 0; q < 4; ++q) { const int s = c.wave * 16 + r4 + q; const float rstd = 1.0f / sqrtf(ss[q] * (1.0f / 256.0f) + EPS);
            u32x2 ow; ow.x = pk2(v[q][0] * rstd * gn.x, v[q][1] * rstd * gn.y); ow.y = pk2(v[q][2] * rstd * gn.z, v[q][3] * rstd * gn.w);
            *(LAS u32x2*)(c.lds + s * SGU_ROWB + 8 * c.lane) = ow; } } }
    LDS_WAIT(); __syncthreads();
    const int gg = c.wave >> 1, th = c.wave & 1;
    bf16x8 a[4][4];
#pragma unroll
    for (int mt = 0; mt < 4; ++mt)
#pragma unroll
        for (int ks = 0; ks < 4; ++ks) a[mt][ks] = *(const GAS bf16x8*)(Ws + ((size_t)gg * 128 + 64 * th + 16 * mt + fr) * 128 + 32 * ks + 8 * fq);
    u32x2 uw[4][4]; float bsv[4];
#pragma unroll
    for (int mt = 0; mt < 4; ++mt) { const int t = 64 * th + 16 * mt + fr; bsv[mt] = c.inp[I_SGUB][(l * 4 + gg) * 128 + t];
#pragma unroll
        for (int nt = 0; nt < 4; ++nt) uw[nt][mt] = *(const GAS u32x2*)(P + (size_t)(r0 + t) * INW + 1024 + 64 * gg + 16 * nt + 4 * fq); }
#pragma unroll
    for (int nt = 0; nt < 4; ++nt) {
        f32x4 acc[4];
#pragma unroll
        for (int mt = 0; mt < 4; ++mt) acc[mt] = (f32x4){0.f, 0.f, 0.f, 0.f};
#pragma unroll
        for (int ks = 0; ks < 4; ++ks) {
            LAS unsigned char* vp = c.lds + (32 * ks + 8 * fq + (fr >> 2)) * SGU_ROWB + (64 * gg + 16 * nt + 4 * (fr & 3)) * 2;
            const v4i16_t lo = __builtin_amdgcn_ds_read_tr16_b64_v4i16((LAS v4i16_t*)vp);
            const v4i16_t h8 = __builtin_amdgcn_ds_read_tr16_b64_v4i16((LAS v4i16_t*)(vp + 4 * SGU_ROWB));
            const bf16x8 bfr = (bf16x8){lo[0], lo[1], lo[2], lo[3], h8[0], h8[1], h8[2], h8[3]};
#pragma unroll
            for (int mt = 0; mt < 4; ++mt) acc[mt] = mfma16(bfr, a[mt][ks], acc[mt]); }
#pragma unroll
        for (int mt = 0; mt < 4; ++mt) { const int t = 64 * th + 16 * mt + fr, ch = 64 * gg + 16 * nt + 4 * fq;
            const float bs = bsv[mt]; const u32x2 w = uw[nt][mt];
            const float u0 = gelu_tanh(bf2f(w.x & 0xffffu)), u1 = gelu_tanh(bf2f(w.x >> 16)), u2 = gelu_tanh(bf2f(w.y & 0xffffu)), u3 = gelu_tanh(bf2f(w.y >> 16));
            u32x2 ow; ow.x = pk2(u0 * (acc[mt][0] + bs), u1 * (acc[mt][1] + bs)); ow.y = pk2(u2 * (acc[mt][2] + bs), u3 * (acc[mt][3] + bs));
            *(GAS u32x2*)(mix + (size_t)(r0 + t) * D + 768 + ch) = ow; }
    }
}

constexpr int RW_PITCH = 1040;
__device__ __forceinline__ void ffn_prep(const Ctx& c_, int l, int nrows) { Ctx c = c_; asm volatile("" : "+s"(c.ws), "+s"(c.inp), "+s"(c.out), "+v"(c.tid)); c.lane = c.tid & 63; asm volatile("" : "+s"(l));
    const int gw = c.vcu * NWAVES + c.wave, NGW = c.G * NWAVES;
    const GAS float* modv = (const GAS float*)(c.ws + WS_MODV); bf16* F = (bf16*)(c.ws + WS_R3 + 66 * MiB);
    float* probsL = (float*)(c.ws + WS_PROBS); float* probsC = probsL + 2 * 16 * 16384;
    const GAS float* hctx = (const GAS float*)(c.ws + WS_HCTX); const GAS float* rw = c.inp[I_ROUTW] + (size_t)l * D * NE;
    __syncthreads();
    { f32x4 rv[8];
#pragma unroll
      for (int r = 0; r < 8; ++r) rv[r] = *(const GAS f32x4*)(rw + 4 * (c.tid + 512 * r));
#pragma unroll
      for (int r = 0; r < 8; ++r) { const int idx = 4 * (c.tid + 512 * r), k = idx >> 4, e = idx & 15, L = (k & 255) >> 2, j = k >> 8, i = k & 3;
        *(LAS f32x4*)(c.lds + L * RW_PITCH + ((j * 4 + i) * 16 + e) * 4) = rv[r]; } }
    LDS_WAIT(); __syncthreads();
    const GAS float* gn = c.inp[I_NFFNG] + l * D;
    const int myexp = ((c.lane & 1) << 3) | (((c.lane >> 1) & 1) << 2) | (((c.lane >> 2) & 1) << 1) | ((c.lane >> 3) & 1);
#define FFN_LOAD_RAW(BLK, DST) do { _Pragma("unroll") for (int q = 0; q < 4; ++q) { const GAS bf16* hb_ = (const GAS bf16*)c.out + (size_t)((BLK) * 4 + q) * 2048; \
            _Pragma("unroll") for (int j = 0; j < 4; ++j) DST[q][j] = *(const GAS u32x2*)(hb_ + 4 * c.lane + 256 * j); } } while (0)
    u32x2 wn[4][4];
    if (gw < nrows / 4 && gw * 4 < MLAT) FFN_LOAD_RAW(gw, wn);
    for (int blk = gw; blk < nrows / 4; blk += NGW) {
        const int m0 = blk * 4; const bool isctx = m0 >= MLAT; const int b = isctx ? ((m0 - MLAT) >> 8) : (m0 >> 14), mb = isctx ? 2 : b;
        const GAS float* mo = modv + (size_t)(l * 3 + mb) * 6144;
        f32x4 gsc[4], sh[4];
#pragma unroll
        for (int j = 0; j < 4; ++j) { const int col = 4 * c.lane + 256 * j; gsc[j] = *(const GAS f32x4*)(gn + col) * (*(const GAS f32x4*)(mo + 4 * 1024 + col) + 1.0f); sh[j] = *(const GAS f32x4*)(mo + 3 * 1024 + col); }
#pragma unroll 1
        for (int r4 = 0; r4 < 4; r4 += 4) { asm volatile("" ::: "memory");
            f32x4 v[4][4]; float rstd[4];
#pragma unroll
            for (int q = 0; q < 4; ++q) { const int m = m0 + r4 + q;
                if (isctx) { const GAS float* src = hctx + (size_t)(m - MLAT) * D;
#pragma unroll
                    for (int j = 0; j < 4; ++j) v[q][j] = *(const GAS f32x4*)(src + 4 * c.lane + 256 * j); }
                else {
#pragma unroll
                    for (int j = 0; j < 4; ++j) { const u32x2 w = wn[q][j]; v[q][j] = (f32x4){bf2f(w.x & 0xffffu), bf2f(w.x >> 16), bf2f(w.y & 0xffffu), bf2f(w.y >> 16)}; } } }
            if (blk + NGW < nrows / 4 && (blk + NGW) * 4 < MLAT) FFN_LOAD_RAW(blk + NGW, wn);
#pragma unroll
            for (int q = 0; q < 4; ++q) { float ss = 0.f;
#pragma unroll
                for (int j = 0; j < 4; ++j) ss += (v[q][j].x * v[q][j].x + v[q][j].y * v[q][j].y) + (v[q][j].z * v[q][j].z + v[q][j].w * v[q][j].w);
                rstd[q] = ss; }
#pragma unroll
            for (int o = 1; o < 64; o <<= 1) {
#pragma unroll
                for (int q = 0; q < 4; ++q) rstd[q] += __shfl_xor(rstd[q], o); }
#pragma unroll
            for (int q = 0; q < 4; ++q) rstd[q] = 1.0f / sqrtf(rstd[q] * (1.0f / D) + EPS);
            float lg[4][16];
#pragma unroll
            for (int q = 0; q < 4; ++q)
#pragma unroll
                for (int e = 0; e < 16; ++e) lg[q][e] = 0.f;
#pragma unroll
            for (int j = 0; j < 4; ++j) {
#pragma unroll
                for (int q = 0; q < 4; ++q) { v[q][j] = v[q][j] * rstd[q] * gsc[j] + sh[j];
                    u32x2 w; w.x = pk2(v[q][j].x, v[q][j].y); w.y = pk2(v[q][j].z, v[q][j].w); *(GAS u32x2*)(F + (size_t)(m0 + r4 + q) * D + 4 * c.lane + 256 * j) = w; }
#pragma unroll
                for (int i = 0; i < 4; ++i) { const LAS f32x4* rp = (const LAS f32x4*)(c.lds + c.lane * RW_PITCH + (j * 4 + i) * 64);
#pragma unroll
                    for (int k4 = 0; k4 < 4; ++k4) { const f32x4 w4 = rp[k4];
#pragma unroll
                        for (int q = 0; q < 4; ++q) { const float ai = v[q][j][i]; lg[q][4 * k4] += ai * w4.x; lg[q][4 * k4 + 1] += ai * w4.y; lg[q][4 * k4 + 2] += ai * w4.z; lg[q][4 * k4 + 3] += ai * w4.w; } } } }
            float lgt[4];
#pragma unroll
            for (int q = 0; q < 4; ++q) {
                float r8[8];
#pragma unroll
                for (int i = 0; i < 8; ++i) { const bool up = c.lane & 1; const float keep = up ? lg[q][i + 8] : lg[q][i], send = up ? lg[q][i] : lg[q][i + 8]; r8[i] = keep + __shfl_xor(send, 1); }
                float r4v[4];
#pragma unroll
                for (int i = 0; i < 4; ++i) { const bool up = c.lane & 2; const float keep = up ? r8[i + 4] : r8[i], send = up ? r8[i] : r8[i + 4]; r4v[i] = keep + __shfl_xor(send, 2); }
                float r2[2];
#pragma unroll
                for (int i = 0; i < 2; ++i) { const bool up = c.lane & 4; const float keep = up ? r4v[i + 2] : r4v[i], send = up ? r4v[i] : r4v[i + 2]; r2[i] = keep + __shfl_xor(send, 4); }
                { const bool up = c.lane & 8; const float keep = up ? r2[1] : r2[0], send = up ? r2[0] : r2[1]; lgt[q] = keep + __shfl_xor(send, 8); }
            }
#pragma unroll
            for (int o = 16; o < 64; o <<= 1) {
#pragma unroll
                for (int q = 0; q < 4; ++q) lgt[q] += __shfl_xor(lgt[q], o); }
            float mx[4], ex[4], den[4];
#pragma unroll
            for (int q = 0; q < 4; ++q) mx[q] = lgt[q];
#pragma unroll
            for (int o = 1; o < 16; o <<= 1) {
#pragma unroll
                for (int q = 0; q < 4; ++q) mx[q] = fmaxf(mx[q], __shfl_xor(mx[q], o)); }
#pragma unroll
            for (int q = 0; q < 4; ++q) { ex[q] = expf(lgt[q] - mx[q]); den[q] = ex[q]; }
#pragma unroll
            for (int o = 1; o < 16; o <<= 1) {
#pragma unroll
                for (int q = 0; q < 4; ++q) den[q] += __shfl_xor(den[q], o); }
            if (c.lane < 16) {
#pragma unroll
                for (int q = 0; q < 4; ++q) { const int m = m0 + r4 + q; const int t = isctx ? ((m - MLAT) & 255) : (m & 16383); const float pr = ex[q] / den[q];
                    if (isctx) probsC[(b * 16 + myexp) * 256 + t] = pr; else probsL[(b * 16 + myexp) * 16384 + t] = pr; } }
        }
    }
}

#undef FFN_LOAD_RAW
__device__ __forceinline__ int block_excl_scan(const Ctx& c, int v, volatile LAS int* tmp, int& total) {
    int inc = v;
#pragma unroll
    for (int o = 1; o < 64; o <<= 1) { const int y = __shfl_up(inc, o); if (c.lane >= o) inc += y; }
    __syncthreads();
    if (c.lane == 63) tmp[c.wave] = inc;
    __syncthreads();
    int base = 0, tot = 0;
#pragma unroll
    for (int w = 0; w < 8; ++w) { const int x = tmp[w]; if (w < c.wave) base += x; tot += x; }
    total = tot;
    return base + inc - v;
}
__device__ __forceinline__ void select_unit(const Ctx& c_, int unit) { Ctx c = c_; asm volatile("" : "+s"(c.ws), "+s"(c.inp), "+s"(c.out), "+v"(c.tid)); c.lane = c.tid & 63;
    const bool isctx = unit >= 32; const int be = isctx ? unit - 32 : unit, b = be >> 4, e = be & 15;
    const int N = isctx ? 256 : 16384, cap = isctx ? CAPC : CAPL;
    const GAS float* probs = (const GAS float*)(c.ws + WS_PROBS) + (isctx ? 2 * 16 * 16384 + be * 256 : be * 16384);
    int* smap = (int*)(c.ws + WS_SMAP) + (isctx ? 2 * 16 * 16384 + be * 256 : be * 16384);
    int* idx = (int*)(c.ws + WS_IDX); float* gate = (float*)(c.ws + WS_GATE);
    const int rowbase = isctx ? (XLAT + e * 256 + b * 32) : be * CAPL;
    const int tokbase = isctx ? (MLAT + b * LC) : b * SEQ;
    LAS unsigned* keys = (LAS unsigned*)(c.lds + RING_OFF);
    volatile LAS unsigned* hist = (volatile LAS unsigned*)(c.lds + RING_OFF + 65536);
    volatile LAS int* tmp = (volatile LAS int*)(c.lds + RING_OFF + 65536 + 16384);
    __syncthreads();
    unsigned kreg[32];
    const int R = isctx ? 1 : N / 512; const bool act = !isctx || c.tid < 256;
    if (!isctx) {
#pragma unroll
        for (int r = 0; r < 32; ++r) kreg[r] = __float_as_uint(probs[c.tid + 512 * r]);
#pragma unroll
        for (int r = 0; r < 32; ++r) keys[c.tid + 512 * r] = kreg[r]; }
    else {
#pragma unroll
        for (int r = 0; r < 32; ++r) kreg[r] = 0u;
        if (c.tid < 256) { kreg[0] = __float_as_uint(probs[c.tid]); keys[c.tid] = kreg[0]; } }
    unsigned prefix = 0; int remaining = cap;
#pragma unroll 1
    for (int pass = 0; pass < 3; ++pass) {
        const int shift = pass == 0 ? 19 : pass == 1 ? 9 : 0, width = pass == 0 ? 12 : pass == 1 ? 10 : 9, B = 1 << width, nb = B >> 6;
        for (int i = c.tid; i < B; i += 512) hist[i] = 0u;
        __syncthreads();
        if (act) {
#pragma unroll
            for (int r = 0; r < 32; ++r) { const unsigned k = kreg[r];
                if (r < R && (pass == 0 || (k >> (shift + width)) == (prefix >> (shift + width)))) __hip_atomic_fetch_add((LAS unsigned*)&hist[(k >> shift) & (unsigned)(B - 1)], 1u, __ATOMIC_RELAXED, __HIP_MEMORY_SCOPE_WORKGROUP); } }
        __syncthreads();
        if (c.wave == 0) {
            const int d0 = B - 1 - c.lane * nb; int cl = 0;
            for (int q = 0; q < nb; ++q) cl += (int)hist[d0 - ((q + c.lane) & (nb - 1))];
            int inc = cl;
#pragma unroll
            for (int o = 1; o < 64; o <<= 1) { const int y = __shfl_up(inc, o); if (c.lane >= o) inc += y; }
            const int before = inc - cl;
            const unsigned long long own = __ballot(before < remaining && remaining <= inc);
            const int ol = __builtin_ctzll(own);
            const int obefore = __shfl(before, ol), od0 = B - 1 - ol * nb;
            const int hb = c.lane < nb ? (int)hist[od0 - c.lane] : 0; int hinc = hb;
#pragma unroll
            for (int o = 1; o < 64; o <<= 1) { const int y = __shfl_up(hinc, o); if (c.lane >= o) hinc += y; }
            const int hbefore = obefore + hinc - hb;
            if (c.lane < nb && hbefore < remaining && remaining <= hbefore + hb) { tmp[16] = od0 - c.lane; tmp[17] = remaining - hbefore; }
        }
        __syncthreads();
        prefix |= ((unsigned)tmp[16]) << shift; remaining = tmp[17];
        __syncthreads();
    }
    int cnt2 = 0;
    if (act) {
#pragma unroll
        for (int r = 0; r < 32; ++r) { const unsigned k = kreg[r]; if (r < R) cnt2 += (k >= prefix ? 1 : 0) + (k == prefix ? 65536 : 0); } }
    int tot2; int base2 = block_excl_scan(c, cnt2, tmp, tot2);
    const int toteq = tot2 >> 16;
    int cutoff = N;
    int slot = base2 & 0xffff;
    if (toteq != remaining) {
        if (c.wave == 0) { int cum = 0;
            for (int base = 0; base < N; base += 64) { const unsigned long long m = __ballot(keys[base + c.lane] == prefix); const int pc = __popcll(m);
                if (cum + pc >= remaining) { unsigned long long mm = m; for (int q = cum + 1; q < remaining; ++q) mm &= mm - 1; if (c.lane == 0) tmp[18] = base + __builtin_ctzll(mm); break; }
                cum += pc; } }
        __syncthreads();
        cutoff = tmp[18];
        __syncthreads();
        int nsel = 0;
        if (act) {
#pragma unroll
            for (int r = 0; r < 32; ++r) { const int i = c.tid + 512 * r; const unsigned k = kreg[r]; if (r < R) nsel += (k > prefix || (k == prefix && i <= cutoff)) ? 1 : 0; } }
        int tot; slot = block_excl_scan(c, nsel, tmp, tot);
    }
    if (act) {
#pragma unroll
        for (int r = 0; r < 32; ++r) { if (r < R) { const int i = c.tid + 512 * r; const unsigned k = kreg[r]; const bool sel = (k > prefix || (k == prefix && i <= cutoff)) && slot < cap;
            if (sel) { smap[i] = slot; idx[rowbase + slot] = tokbase + i; gate[rowbase + slot] = __uint_as_float(k); ++slot; } else smap[i] = -1; } } }
}


__device__ __forceinline__ void sg_stage_a(const Ctx& c, const GAS bf16* const (&srow)[16]) {
    __syncthreads();
    v4u v[16];
#pragma unroll
    for (int i = 0; i < 16; ++i) { const int p = c.tid + 512 * i; v[i] = *(const GAS v4u*)(srow[i] + (p & 127) * 8); }
#pragma unroll
    for (int i = 0; i < 16; ++i) { const int p = c.tid + 512 * i, row = p >> 7, ch = p & 127; *(LAS v4u*)(c.lds + RING_OFF + row * 2048 + ((ch ^ (row & 15)) << 4)) = v[i]; }
    LDS_WAIT(); __syncthreads();
}
template <int NB> __device__ __forceinline__ void sg_mainloop(const Ctx& c, const GAS bf16* const (&brow)[NB], int fr, int fq, f32x4 (&acc)[NB][4]) {
#pragma unroll
    for (int nb = 0; nb < NB; ++nb)
#pragma unroll
        for (int mt = 0; mt < 4; ++mt) acc[nb][mt] = (f32x4){0.f, 0.f, 0.f, 0.f};
    bf16x8 b0[NB][8], b1[NB][8];
#pragma unroll
    for (int nb = 0; nb < NB; ++nb)
#pragma unroll
        for (int k = 0; k < 8; ++k) b0[nb][k] = *(const GAS bf16x8*)(brow[nb] + 32 * k + 8 * fq);
#pragma unroll
    for (int kb = 0; kb < 4; ++kb) {
        if (kb < 3) {
#pragma unroll
            for (int nb = 0; nb < NB; ++nb)
#pragma unroll
                for (int k = 0; k < 8; ++k) { const bf16x8 t = *(const GAS bf16x8*)(brow[nb] + 32 * (8 * (kb + 1) + k) + 8 * fq); if (kb & 1) b0[nb][k] = t; else b1[nb][k] = t; }
        }
#pragma unroll
        for (int k = 0; k < 8; ++k) { const int ch = 4 * (8 * kb + k) + fq;
            bf16x8 a[4];
#pragma unroll
            for (int mt = 0; mt < 4; ++mt) { const int row = 16 * mt + fr; a[mt] = *(const LAS bf16x8*)(c.lds + RING_OFF + row * 2048 + ((ch ^ (row & 15)) << 4)); }
#pragma unroll
            for (int nb = 0; nb < NB; ++nb) { const bf16x8 bb = (kb & 1) ? b1[nb][k] : b0[nb][k];
#pragma unroll
                for (int mt = 0; mt < 4; ++mt) acc[nb][mt] = mfma16(bb, a[mt], acc[nb][mt]); } }
    }
}
__device__ __forceinline__ void ctx_inproj_item(const Ctx& c_, int l, int item, int nb_lo, int nb_cnt) { Ctx c = c_; asm volatile("" : "+s"(c.ws), "+s"(c.inp), "+s"(c.out), "+v"(c.tid)); c.lane = c.tid & 63; asm volatile("" : "+s"(l));
    const int fr = c.lane & 15, fq = c.lane >> 4; const int mblk = item / nb_cnt, nbk = nb_lo + item % nb_cnt;
    const GAS bf16* A1 = (const GAS bf16*)(c.ws + WS_R1); const GAS bf16* W = (const GAS bf16*)(c.ws + WS_WIN) + (size_t)l * INW * 1024;
    GAS bf16* P = (GAS bf16*)(c.ws + WS_R2); GAS bf16* Amat = (GAS bf16*)(c.ws + WS_R1 + OFF_AMAT); GAS bf16* U2 = (GAS bf16*)(c.ws + WS_R3);
    const int row0 = MLAT + 64 * mblk, col0 = 128 * nbk + 16 * c.wave;
    const GAS bf16* srow[16]; const GAS bf16* brow[1];
#pragma unroll
    for (int i = 0; i < 16; ++i) srow[i] = A1 + (size_t)(row0 + ((c.tid + 512 * i) >> 7)) * 1024;
    brow[0] = W + (size_t)(col0 + fr) * 1024;
    sg_stage_a(c, srow);
    f32x4 acc[1][4]; sg_mainloop<1>(c, brow, fr, fq, acc);
#pragma unroll
    for (int mt = 0; mt < 4; ++mt) { const int row = row0 + 16 * mt + fr, col = col0 + 4 * fq; u32x2 w; w.x = pk2(acc[0][mt][0], acc[0][mt][1]); w.y = pk2(acc[0][mt][2], acc[0][mt][3]);
        if (col >= 768 && col < 1024) { const int cl = col - 768; const size_t r = (size_t)(cl >> 4) * 2304 + (row >> 4); const int k = (row & 15) * 16 + (cl & 15); *(GAS u32x2*)(Amat + r * 512 + k) = w; *(GAS u32x2*)(U2 + r * 256 + k) = w; }
        else *(GAS u32x2*)(P + (size_t)row * INW + col) = w; }
}
__device__ __forceinline__ void ctx_outproj_item(const Ctx& c_, int l, int item) { Ctx c = c_; asm volatile("" : "+s"(c.ws), "+s"(c.inp), "+s"(c.out), "+v"(c.tid)); c.lane = c.tid & 63; asm volatile("" : "+s"(l));
    const int fr = c.lane & 15, fq = c.lane >> 4; const int mblk = item >> 3, nbk = item & 7;
    const GAS bf16* mixn = (const GAS bf16*)(c.ws + WS_R3); const GAS bf16* W = (const GAS bf16*)(c.ws + WS_WOUT) + (size_t)l * 1024 * 1024;
    const GAS float* gate = (const GAS float*)(c.ws + WS_MODV) + (size_t)(l * 3 + 2) * 6144 + 2 * 1024; GAS float* hctx = (GAS float*)(c.ws + WS_HCTX);
    const int r0 = 64 * mblk, col0 = 128 * nbk + 16 * c.wave;
    const GAS bf16* srow[16]; const GAS bf16* brow[1];
#pragma unroll
    for (int i = 0; i < 16; ++i) srow[i] = mixn + (size_t)(MLAT + r0 + ((c.tid + 512 * i) >> 7)) * 1024;
    brow[0] = W + (size_t)(col0 + fr) * 1024;
    sg_stage_a(c, srow);
    f32x4 acc[1][4]; sg_mainloop<1>(c, brow, fr, fq, acc);
    const f32x4 gv = *(const GAS f32x4*)(gate + col0 + 4 * fq);
#pragma unroll
    for (int mt = 0; mt < 4; ++mt) { const size_t off = (size_t)(r0 + 16 * mt + fr) * 1024 + col0 + 4 * fq;
        const f32x4 h = *(const GAS f32x4*)(c.inp[I_CTX] + off); *(GAS f32x4*)(hctx + off) = h + gv * acc[0][mt]; }
}
__device__ __forceinline__ void ctx_moe1_item(const Ctx& c_, int item) { Ctx c = c_; asm volatile("" : "+s"(c.ws), "+s"(c.inp), "+s"(c.out), "+v"(c.tid)); c.lane = c.tid & 63;
    const int fr = c.lane & 15, fq = c.lane >> 4; const int e = item >> 3, fb = item & 7;
    const GAS bf16* F = (const GAS bf16*)(c.ws + WS_R3 + 66 * MiB); const GAS int* idx = (const GAS int*)(c.ws + WS_IDX);
    const GAS bf16* W = (const GAS bf16*)(c.ws + WS_WGU) + (size_t)e * 2048 * 1024; GAS bf16* hid = (GAS bf16*)(c.ws + WS_R2);
    const int xr0 = XLAT + 256 * e;
    const GAS bf16* srow[16]; const GAS bf16* brow[2];
#pragma unroll
    for (int i = 0; i < 16; ++i) srow[i] = F + (size_t)idx[xr0 + ((c.tid + 512 * i) >> 7)] * 1024;
    brow[0] = W + (size_t)(256 * fb + 16 * c.wave + fr) * 1024; brow[1] = brow[0] + (size_t)128 * 1024;
    sg_stage_a(c, srow);
    f32x4 acc[2][4]; sg_mainloop<2>(c, brow, fr, fq, acc);
#pragma unroll
    for (int mt = 0; mt < 4; ++mt) { float hv[4];
#pragma unroll
        for (int i = 0; i < 4; ++i) { const float g = acc[0][mt][i]; hv[i] = g * __builtin_amdgcn_rcpf(1.0f + __builtin_amdgcn_exp2f(-g * LOG2E)) * acc[1][mt][i]; }
        u32x2 w; w.x = pk2(hv[0], hv[1]); w.y = pk2(hv[2], hv[3]);
        *(GAS u32x2*)(hid + (size_t)(xr0 + 16 * mt + fr) * 1024 + 128 * fb + 16 * c.wave + 4 * fq) = w; }
}
__device__ __forceinline__ void ctx_moe2_item(const Ctx& c_, int item) { Ctx c = c_; asm volatile("" : "+s"(c.ws), "+s"(c.inp), "+s"(c.out), "+v"(c.tid)); c.lane = c.tid & 63;
    const int fr = c.lane & 15, fq = c.lane >> 4; const int e = item >> 3, nbk = item & 7;
    const GAS bf16* hid = (const GAS bf16*)(c.ws + WS_R2); const GAS bf16* W = (const GAS bf16*)(c.ws + WS_WD) + (size_t)e * 1024 * 1024;
    GAS bf16* Y = (GAS bf16*)(c.ws + WS_R3); const GAS float* gate = (const GAS float*)(c.ws + WS_GATE);
    const int xr0 = XLAT + 256 * e, col0 = 128 * nbk + 16 * c.wave;
    const GAS bf16* srow[16]; const GAS bf16* brow[1];
#pragma unroll
    for (int i = 0; i < 16; ++i) srow[i] = hid + (size_t)(xr0 + ((c.tid + 512 * i) >> 7)) * 1024;
    brow[0] = W + (size_t)(col0 + fr) * 1024;
    sg_stage_a(c, srow);
    f32x4 acc[1][4]; sg_mainloop<1>(c, brow, fr, fq, acc);
#pragma unroll
    for (int mt = 0; mt < 4; ++mt) { const int row = xr0 + 16 * mt + fr; const float gt = gate[row];
        u32x2 w; w.x = pk2(acc[0][mt][0] * gt, acc[0][mt][1] * gt); w.y = pk2(acc[0][mt][2] * gt, acc[0][mt][3] * gt);
        *(GAS u32x2*)(Y + (size_t)row * 1024 + col0 + 4 * fq) = w; }
}

__device__ __forceinline__ void norm_unit(const Ctx& c_, int l, int unit) { Ctx c = c_; asm volatile("" : "+s"(c.ws), "+s"(c.inp), "+s"(c.out), "+v"(c.tid)); c.lane = c.tid & 63; asm volatile("" : "+s"(l));
    const int lane = c.lane; const bool sg = lane >= 32;
    const GAS bf16* mix = (const GAS bf16*)(c.ws + WS_R1); GAS bf16* mixn = (GAS bf16*)(c.ws + WS_R3); const GAS float* ong = c.inp[I_ONG] + l * D;
    const f32x4 ga0 = *(const GAS f32x4*)(ong + 8 * lane), gb0 = *(const GAS f32x4*)(ong + 8 * lane + 4), ga1 = *(const GAS f32x4*)(ong + 512 + 8 * lane), gb1 = *(const GAS f32x4*)(ong + 512 + 8 * lane + 4);
    const int row0 = unit * 64 + c.wave * 8;
    float x[8][2][8]; float sa[8], sh[8];
#pragma unroll
    for (int q = 0; q < 8; ++q)
#pragma unroll
        for (int j = 0; j < 2; ++j) { v4u w = (v4u){0u, 0u, 0u, 0u}; if (j == 0 || sg) w = *(const GAS v4u*)(mix + (size_t)(row0 + q) * 1024 + 8 * lane + 512 * j);
            x[q][j][0] = __uint_as_float(w.x << 16); x[q][j][1] = __uint_as_float(w.x & 0xffff0000u); x[q][j][2] = __uint_as_float(w.y << 16); x[q][j][3] = __uint_as_float(w.y & 0xffff0000u);
            x[q][j][4] = __uint_as_float(w.z << 16); x[q][j][5] = __uint_as_float(w.z & 0xffff0000u); x[q][j][6] = __uint_as_float(w.w << 16); x[q][j][7] = __uint_as_float(w.w & 0xffff0000u); }
#pragma unroll
    for (int q = 0; q < 8; ++q) { float s0 = 0.f, s1 = 0.f;
#pragma unroll
        for (int i = 0; i < 8; ++i) { s0 += x[q][0][i] * x[q][0][i]; s1 += x[q][1][i] * x[q][1][i]; }
        sa[q] = s0; sh[q] = s1; }
#pragma unroll
    for (int o = 1; o < 64; o <<= 1) {
#pragma unroll
        for (int q = 0; q < 8; ++q) { sa[q] += __shfl_xor(sa[q], o); sh[q] += __shfl_xor(sh[q], o); } }
#pragma unroll
    for (int q = 0; q < 8; ++q) {
        const float r_att = 1.0f / sqrtf(sa[q] * (1.0f / 512.0f) + EPS), r_b = 1.0f / sqrtf(sh[q] * (1.0f / 256.0f) + EPS);
#pragma unroll
        for (int j = 0; j < 2; ++j) { if (j == 0 || sg) { const float r = j == 0 ? r_att : r_b; const f32x4 ga = j == 0 ? ga0 : ga1, gb = j == 0 ? gb0 : gb1;
            v4u w; w.x = pk2(x[q][j][0] * r * ga[0], x[q][j][1] * r * ga[1]); w.y = pk2(x[q][j][2] * r * ga[2], x[q][j][3] * r * ga[3]);
            w.z = pk2(x[q][j][4] * r * gb[0], x[q][j][5] * r * gb[1]); w.w = pk2(x[q][j][6] * r * gb[2], x[q][j][7] * r * gb[3]);
            *(GAS v4u*)(mixn + (size_t)(row0 + q) * 1024 + 8 * lane + 512 * j) = w; } } }
}

#ifndef MK_N_LAUNCHES
#define MK_N_LAUNCHES 1
#endif
constexpr int N_PHASES = 24;
constexpr int N_LAUNCHES = MK_N_LAUNCHES;
static_assert(N_LAUNCHES == 1 || N_LAUNCHES == N_PHASES, "MK_N_LAUNCHES is 1 or 24");

typedef const __attribute__((address_space(4))) unsigned char* kargp_t;
__device__ __forceinline__ Ctx make_ctx(LAS unsigned char* lds) {
    Ctx c; kargp_t kp = (kargp_t)__builtin_amdgcn_kernarg_segment_ptr(); asm volatile("" : "+s"(kp));
    c.inp = (kfptr*)kp;
    c.out = *(GAS float* const __attribute__((address_space(4)))*)(kp + 248); c.ws = *(GAS unsigned char* const __attribute__((address_space(4)))*)(kp + 256);
    c.ctl = (gu32*)(c.ws + WS_CTL);
    c.lds = lds; c.MISC = (volatile LAS unsigned*)(lds + MISC_OFF);
    int t = threadIdx.x; asm volatile("" : "+v"(t)); c.tid = t; c.lane = t & 63; c.wave = __builtin_amdgcn_readfirstlane(t >> 6);
    int G = gridDim.x, bx = blockIdx.x; asm volatile("" : "+s"(G), "+s"(bx)); c.G = G; c.vcu = (G % 8 == 0) ? (bx % 8) * (G / 8) + bx / 8 : bx;
    return c;
}
static_assert(offsetof(Args, out) == 248 && offsetof(Args, ws) == 256 && offsetof(Args, ph_lo) == 264, "Args layout");
__device__ __forceinline__ void grid_bar(const Ctx& c) {
    XcdBarrier bar; bar.bar = (unsigned*)(c.ctl + CW_BAR); bar.x = xb_xcc_id(); bar.st = c.MISC + 8;
    xcd_barrier(bar);
}

__global__ void __launch_bounds__(NWAVES * 64, 2) mega_fwd(Args args) {
    extern __shared__ __attribute__((aligned(16))) unsigned char lds[];
    {
        Ctx c = make_ctx((LAS unsigned char*)lds);
        for (int u = c.tid; u < (LDS_BYTES - LDSCTL_OFF) / 4; u += NWAVES * 64) ((LAS unsigned*)(c.lds + LDSCTL_OFF))[u] = 0u;
        __syncthreads();
        if (N_LAUNCHES == 1) (void)xcd_barrier_post((unsigned*)(c.ctl + CW_BAR), c.MISC + 8);
    }
    const int lo = args.ph_lo, hi = args.ph_hi;
#ifndef KIND_MASK
#define KIND_MASK 0x1fff
#endif
#define KIND_OF(k) ((k) < 2 ? (k) : 2 + ((k) - 2) % 11)
#define IN(k) (((KIND_MASK >> KIND_OF(k)) & 1) && lo <= (k) && (k) < hi)
#ifndef TPROBE
#define TPROBE -1
#endif
#ifndef TPROBE_UNIT
#define TPROBE_UNIT 0
#endif
#define STAMP(i) do { if ((TPROBE >= 0) && blockIdx.x == 0 && c.tid == 0) __hip_atomic_store(c.ctl + CW_TS + (i), (unsigned)__builtin_amdgcn_s_memrealtime(), RLX_AGENT); } while (0)
#define SEAM(k) do { if (IN((k) + 1)) grid_bar(c); STAMP((k) + 1); } while (0)
#ifndef REPEAT_MASK
#define REPEAT_MASK 0
#endif
#ifndef D_REP_MASK
#define D_REP_MASK 7
#endif
#define NREP(k) ((((REPEAT_MASK) >> KIND_OF(k)) & 1) ? 2 : 1)
#define REPEAT(k) for (int rep = 0; rep < NREP(k); ++rep)
#define LAUNDER() Ctx c = make_ctx((LAS unsigned char*)lds)
#define A1 ((bf16*)(c.ws + WS_R1))
#define Pb ((bf16*)(c.ws + WS_R2))
#define mixn ((bf16*)(c.ws + WS_R3))
#define xin ((bf16*)(c.ws + WS_R1))
#define hid ((bf16*)(c.ws + WS_R2))
#define Yb ((bf16*)(c.ws + WS_R3))
#define hctx ((float*)(c.ws + WS_HCTX))
#define AMAT ((bf16*)(c.ws + WS_R1 + OFF_AMAT))
#define U2M ((bf16*)(c.ws + WS_R3))
#define GS ((bf16*)(c.ws + WS_R1 + OFF_GS))
#define MIX ((bf16*)(c.ws + WS_R1))

    { Ctx c = make_ctx((LAS unsigned char*)lds); STAMP(0); }
    if (IN(0)) { REPEAT(0) { LAUNDER(); if (rep) grid_bar(c); p0a(c); } LAUNDER(); SEAM(0); }
    if (IN(1)) { REPEAT(1) { LAUNDER(); if (rep) grid_bar(c); p0b_tables(c); row_prep(c, 0, 0); } LAUNDER(); SEAM(1); }
#pragma unroll 1
    for (int l = 0; l < 2; ++l) {
        const int pb = 2 + 11 * l;
#define PH_BEGIN(k) if (IN(pb + (k))) { for (int rep = 0; rep < NREP(pb + (k)); ++rep) { LAUNDER(); if (rep) grid_bar(c);
#define PH_END(k) } LAUNDER(); SEAM(pb + (k)); }
        PH_BEGIN(0)
            pg8::Gemm g{A1, (const bf16*)(c.ws + WS_WIN) + (size_t)l * INW * 1024, MLAT, INW, 1024, 1024, nullptr}; pg8::StaticOrder S; S.init(MLAT, INW, c.G, (int)blockIdx.x);
            pg8::EpiInProj E{Pb, AMAT, U2M};
            pg8::gemm_phase<pg8::EpiInProj, pg8::StaticOrder, true, true>(c.lds + RING_OFF, g, S, E);
            { const int nb_lo = l == 0 ? 0 : 4, nb_cnt = l == 0 ? 12 : 4;
              for (int it = (int)blockIdx.x; it < 8 * nb_cnt; it += c.G) ctx_inproj_item(c, l, it, nb_lo, nb_cnt); }
        PH_END(0)
        PH_BEGIN(1)
            if (l == 0 && rep == 0) tg_assemble(c);
            { pg8::Gemm g{U2M, (const bf16*)(c.ws + WS_EB) + (size_t)l * 16 * 256 * 256, 144 * 256, 256, 256, 256, nullptr}; pg8::StaticOrder S; S.init(144 * 256, 256, c.G, (int)blockIdx.x, 2);
              pg8::EpiF32x256 E{(float*)(c.ws + WS_R2 + OFF_E)};
              pg8::gemm_phase<pg8::EpiF32x256, pg8::StaticOrder, false, true>(c.lds + RING_OFF, g, S, E); }
            if (rep == 0) qk_prep_rows(c, l);
        PH_END(1)
        PH_BEGIN(2)
            const int natt = l == 0 ? 520 : 512, nsgu = l == 0 ? 260 : 256;
            for (;;) { const int u = q_next(c, pb + 2 + 32 * rep); if (u >= 64 + natt + nsgu) break;
                const int ukind = u < 64 ? 3 : u < 64 + natt ? 1 : 2;
                unsigned long long t0_ = 0; if (TPROBE_UNIT == ukind) t0_ = __builtin_amdgcn_s_memrealtime();
                if (u < 64) { if (rep == 0 || (D_REP_MASK & 1)) s5_scan_unit(c, l, u); }
                else if (u < 64 + natt) { if (rep == 0 || (D_REP_MASK & 2)) attn_unit(c, l, u - 64); }
                else { if (rep == 0 || (D_REP_MASK & 4)) sgu_unit(c, l, u - 64 - natt); }
                if (TPROBE_UNIT == ukind && l == 0) { WG_SYNC(); if (blockIdx.x == 0 && c.tid == 0) { const unsigned dt_ = (unsigned)(__builtin_amdgcn_s_memrealtime() - t0_);
                    __hip_atomic_fetch_add(c.ctl + CW_TS + 40, dt_, RLX_AGENT); __hip_atomic_fetch_add(c.ctl + CW_TS + 41, 1u, RLX_AGENT); } } }
        PH_END(2)
        PH_BEGIN(3)
            pg8::Gemm g{AMAT, (const bf16*)(c.ws + WS_TG) + (size_t)l * 16 * 256 * 512, 144 * 256, 256, 512, 512, nullptr}; pg8::StaticOrder S; S.init(144 * 256, 256, c.G, (int)blockIdx.x, 2);
            pg8::EpiS5Out E{GS, NSC};
            pg8::gemm_phase<pg8::EpiS5Out, pg8::StaticOrder, true, true>(c.lds + RING_OFF, g, S, E);
            if (rep == 0) for (;;) { const int u = q_next(c, pb + 3); if (u >= (l == 0 ? MT : MLAT) / 64) break; norm_unit(c, l, u); }
        PH_END(3)
        PH_BEGIN(4)
            const int M = l == 0 ? MT : MLAT;
            pg8::Gemm g{GS, (const bf16*)(c.ws + WS_WGLU) + (size_t)l * 256 * 256, M, 256, 256, 256, nullptr}; pg8::StaticOrder S; S.init(M, 256, c.G, (int)blockIdx.x);
            pg8::EpiGluNorm E{GS, MIX, mixn, (const float*)(c.inp[I_GLUB] + l * 256), (const float*)(c.inp[I_ONG] + l * D), EPS};
            pg8::gemm_phase<pg8::EpiGluNorm, pg8::StaticOrder, false, true>(c.lds + RING_OFF, g, S, E);
        PH_END(4)
        if (IN(pb + 5)) { for (int rep = 0; rep < (l == 0 ? NREP(pb + 5) : 1); ++rep) { LAUNDER(); if (rep) grid_bar(c);
            const int M = MLAT;
            pg8::Gemm g{mixn, (const bf16*)(c.ws + WS_WOUT) + (size_t)l * 1024 * 1024, M, 1024, 1024, 1024, nullptr}; pg8::StaticOrder S; S.init(M, 1024, c.G, (int)blockIdx.x);
            pg8::EpiResidBf E{l == 0 ? (const float*)c.inp[I_X] : nullptr, (bf16*)c.out, (const float*)(c.ws + WS_MODV) + (size_t)l * 3 * 6144, 2 * 1024};
            pg8::gemm_phase<pg8::EpiResidBf, pg8::StaticOrder, true, true>(c.lds + RING_OFF, g, S, E);
            if (l == 0) for (int it = (int)blockIdx.x; it < 64; it += c.G) ctx_outproj_item(c, l, it);
        PH_END(5)
        PH_BEGIN(6) ffn_prep(c, l, l == 0 ? MT : MLAT); PH_END(6)
        PH_BEGIN(7) const int nu = l == 0 ? 64 : 32; for (int u = (int)blockIdx.x; u < nu; u += c.G) select_unit(c, u);
            if (l == 0 && rep == 0 && c.G > 128) convert_experts(c, 1, 2, 3, 64);
        PH_END(7)
        PH_BEGIN(8)
            const int M = XLAT;
            pg8::Gemm g{(const bf16*)(c.ws + WS_R3 + 66 * MiB), (const bf16*)(c.ws + WS_WGU), M, 2048, 1024, 1024, (const int*)(c.ws + WS_IDX)};   pg8::StaticOrder S; S.init(M, 2048, c.G, (int)blockIdx.x, 1);
            pg8::EpiSwiGLU E{hid};
            pg8::gemm_phase<pg8::EpiSwiGLU, pg8::StaticOrder, true, true, true>(c.lds + RING_OFF, g, S, E);
            if (l == 0) for (int it = (int)blockIdx.x; it < 128; it += c.G) ctx_moe1_item(c, it);
        PH_END(8)
        PH_BEGIN(9)
            const int M = XLAT;
            pg8::Gemm g{hid, (const bf16*)(c.ws + (l == 0 ? WS_WD : WS_WD1)), M, 1024, 1024, 1024, nullptr}; pg8::StaticOrder S; S.init(M, 1024, c.G, (int)blockIdx.x, 1);
            pg8::EpiGateY E{Yb, (const float*)(c.ws + WS_GATE)};
            pg8::gemm_phase<pg8::EpiGateY, pg8::StaticOrder, true, true>(c.lds + RING_OFF, g, S, E);
            if (l == 0) for (int it = (int)blockIdx.x; it < 128; it += c.G) ctx_moe2_item(c, it);
        PH_END(9)
        if (IN(pb + 10)) { LAUNDER();
            if (l == 0) { row_prep(c, 1, 1); if (c.G > 128) convert_experts(c, 1, 0, 2, 0); else convert_experts(c, 1, 0, 3, 0); SEAM(pb + 10); }
            else row_prep(c, 2, 1);
        }
    }
#undef PH_BEGIN
#undef PH_END
#undef AMAT
#undef U2M
#undef GS
#undef MIX
#undef IN
#undef SEAM
#undef A1
#undef Pb
#undef mixn
#undef xin
#undef hid
#undef Yb
#undef hctx
}

extern "C" void kernel_launch(void* const* d_in, const int* in_sizes, int n_in, void* d_out, int out_size, void* d_ws, size_t ws_size, hipStream_t stream) {
    static int grid = 0;
    if (grid == 0) {
        if (n_in != 31 || in_sizes[0] != MLAT * D || out_size != MLAT * D || ws_size < WS_END) {
            fprintf(stderr, "kernel_launch: unexpected shapes (n_in %d, in0 %d, out %d, ws %zu < %zu); nothing launched\n", n_in, n_in > 0 ? in_sizes[0] : -1, out_size, ws_size, (size_t)WS_END); grid = -1; return; }
        int dev = 0, cus = 0, per_cu = 0;
        if (hipGetDevice(&dev) != hipSuccess || hipDeviceGetAttribute(&cus, hipDeviceAttributeMultiprocessorCount, dev) != hipSuccess) { grid = -1; return; }
        if (hipFuncSetAttribute((const void*)mega_fwd, hipFuncAttributeMaxDynamicSharedMemorySize, LDS_BYTES) != hipSuccess) { fprintf(stderr, "kernel_launch: hipFuncSetAttribute failed\n"); grid = -1; return; }
        if (hipOccupancyMaxActiveBlocksPerMultiprocessor(&per_cu, (const void*)mega_fwd, NWAVES * 64, LDS_BYTES) != hipSuccess || per_cu < 1)
            fprintf(stderr, "kernel_launch: note: occupancy query reports %d workgroups per CU\n", per_cu);
        (void)hipGetLastError();
        grid = cus;
    }
    if (grid < 0) return;
    if (hipMemsetAsync((char*)d_ws + WS_CTL, 0, CTL_ZERO_BYTES, stream) != hipSuccess) { fprintf(stderr, "kernel_launch: hipMemsetAsync failed\n"); return; }
    Args a{};
    for (int i = 0; i < 31; ++i) a.in[i] = (const float*)d_in[i];
    a.out = (float*)d_out; a.ws = (unsigned char*)d_ws;
    for (int li = 0; li < N_LAUNCHES; ++li) {
        a.ph_lo = (N_LAUNCHES == 1) ? 0 : li; a.ph_hi = (N_LAUNCHES == 1) ? N_PHASES : li + 1;
        hipLaunchKernelGGL(mega_fwd, dim3(grid), dim3(NWAVES * 64), LDS_BYTES, stream, a);
        const hipError_t le = hipPeekAtLastError();
        if (le != hipSuccess) { fprintf(stderr, "kernel_launch: launch %d failed: %s\n", li, hipGetErrorName(le)); break; }
    }
}
```

```cpp
#include <hip/hip_runtime.h>
#include <cstdio>
#include <cstdint>
#include <cmath>

constexpr int D = 1024, NBATCH = 2, SEQ = 16384, LC = 256;
constexpr int MLAT = NBATCH * SEQ, MCTX = NBATCH * LC, MT = MLAT + MCTX;
constexpr int INW = 1536;
constexpr int NE = 16, CAPL = 2048, CAPC = 32;
constexpr int XLAT = NBATCH * NE * CAPL;
constexpr int XROWS = XLAT + NE * 256;
constexpr float EPS = 1e-6f;
constexpr float LOG2E = 1.4426950408889634f;
constexpr int NTILE = MT / 256;
constexpr int NSC = MT / 16;

namespace pg8 {
#define PG8_LAS __attribute__((address_space(3)))
typedef unsigned short bf16_t;
typedef short bf16x8 __attribute__((ext_vector_type(8)));
typedef float f32x4 __attribute__((ext_vector_type(4)));
typedef unsigned u32x4 __attribute__((ext_vector_type(4)));
constexpr int BM = 256, BK = 64, HALF = 128, HTB = HALF * BK * 2  , STAGE_BYTES = 8 * HTB, NXCD = 8, WGM = 8;

__host__ __device__ __forceinline__ int lds_byte(int r, int c) { const int st = (r >> 4) * 2 + (c >> 5), rr = r & 15, cc = c & 31, ob = rr * 64 + cc * 2; return st * 1024 + (ob ^ (((ob >> 9) & 1) << 5)); }
__host__ __device__ __forceinline__ void stage_rc(int b, int& R, int& C) { const int st = b / 1024, sb = b % 1024, swz = sb ^ (((sb >> 9) & 1) << 5); R = (st >> 1) * 16 + swz / 64; C = (st & 1) * 32 + (swz % 64) / 2; }
__host__ __device__ __forceinline__ int perm32(int rho) { const int n = rho >> 4, i = rho & 15; return 8 * (i >> 2) + 4 * n + (i & 3); }

struct Unit { int pm, pn, pb; };
struct Gemm { const bf16_t* A; const bf16_t* Bt; int M, N, K, lda; const int* rowidx; };

struct StaticOrder {
    int nM, nN, nwg, G, c, moe;
    __host__ __device__ void init(int M, int N, int G_, int c_, int moe_ = 0) { nM = M / BM; nN = N / BM; nwg = nM * nN; G = G_; c = c_; moe = moe_; }
    __host__ __device__ bool next(int i, Unit& u) const {
        const long L = (long)i * G + c; if (L >= nwg) return false;
        int wgid = (int)L; { const int q = nwg / NXCD, r = nwg % NXCD, xcd = wgid % NXCD, off = wgid / NXCD; wgid = (xcd < r ? xcd * (q + 1) : r * (q + 1) + (xcd - r) * q) + off; }
        const int nig = WGM * nN, gid = wgid / nig, fm = gid * WGM, gsz = (nM - fm) < WGM ? (nM - fm) : WGM;
        u.pm = fm + ((wgid % nig) % gsz); u.pn = (wgid % nig) / gsz;
        u.pb = moe == 1 ? ((u.pm < 256 ? ((u.pm >> 3) & 15) : (u.pm - 256)) * nN + u.pn) : moe == 2 ? u.pm / 9 : u.pn; return true;
    }
    __device__ __forceinline__ void a_ready(const Unit&) const {}
    __device__ __forceinline__ void done(const Unit&) const {}
};

__device__ __forceinline__ unsigned cvt_pk_bf16(float lo, float hi) { unsigned r; asm volatile("v_cvt_pk_bf16_f32 %0, %1, %2" : "=v"(r) : "v"(lo), "v"(hi)); return r; }

struct EpiResid {
    static constexpr bool PERM = false, AFTER_DRAIN = false;
    const float* src_lat; float* dst_lat; const float* src_ctx; float* dst_ctx; const float* gate3;
    int mlat, gate_off;
    __device__ __forceinline__ void operator()(const f32x4 (&acc)[2][2][4][2], const Unit& u, int wr, int wc, int fr, int fq) const {
        const int r0 = u.pm * BM; const bool isctx = r0 >= mlat; const int mb = isctx ? 2 : (r0 >> 14);
        const float* src = isctx ? src_ctx : src_lat; float* dst = isctx ? dst_ctx : dst_lat;
        const int rb = (isctx ? r0 - mlat : r0) + wr * 64 + fr, col0 = u.pn * BM + wc * 32 + 4 * fq;
        const float* gate = gate3 + mb * 6144 + gate_off;
        f32x4 gv[2][2];
#pragma unroll
        for (int bj = 0; bj < 2; ++bj)
#pragma unroll
            for (int n = 0; n < 2; ++n) gv[bj][n] = *(const f32x4*)(gate + col0 + bj * HALF + n * 16);
#pragma unroll
        for (int ai = 0; ai < 2; ++ai)
#pragma unroll
            for (int m = 0; m < 4; ++m) { const size_t off = (size_t)(rb + ai * HALF + m * 16) * 1024 + col0;
#pragma unroll
                for (int bj = 0; bj < 2; ++bj)
#pragma unroll
                    for (int n = 0; n < 2; ++n) { const f32x4 h = *(const f32x4*)(src + off + bj * HALF + n * 16); *(f32x4*)(dst + off + bj * HALF + n * 16) = h + gv[bj][n] * acc[ai][bj][m][n]; }
                if (m & 1) asm volatile("" ::: "memory"); }
    }
};
struct EpiResidBf {
    static constexpr bool PERM = true, AFTER_DRAIN = false;
    const float* src_f32; bf16_t* hb; const float* gate3; int gate_off;
    __device__ __forceinline__ void operator()(const f32x4 (&acc)[2][2][4][2], const Unit& u, int wr, int wc, int fr, int fq) const {
        const int r0 = u.pm * BM, mb = r0 >> 14, row0 = r0 + wr * 64 + fr, col0 = u.pn * BM + wc * 32 + 8 * fq;
        const float* gate = gate3 + mb * 6144 + gate_off;
        f32x4 gv[2][2];
#pragma unroll
        for (int bj = 0; bj < 2; ++bj)
#pragma unroll
            for (int n = 0; n < 2; ++n) gv[bj][n] = *(const f32x4*)(gate + col0 + bj * HALF + 4 * n);
#pragma unroll
        for (int ai = 0; ai < 2; ++ai)
#pragma unroll
            for (int m = 0; m < 4; ++m) { const int row = row0 + ai * HALF + m * 16;
#pragma unroll
                for (int bj = 0; bj < 2; ++bj) { const int col = col0 + bj * HALF; f32x4 h0, h1;
                    if (src_f32) { h0 = *(const f32x4*)(src_f32 + (size_t)row * 1024 + col); h1 = *(const f32x4*)(src_f32 + (size_t)row * 1024 + col + 4); }
                    else { const u32x4 w = *(const u32x4*)(hb + (size_t)row * 2048 + col);
                        h0 = (f32x4){__uint_as_float(w.x << 16), __uint_as_float(w.x & 0xffff0000u), __uint_as_float(w.y << 16), __uint_as_float(w.y & 0xffff0000u)};
                        h1 = (f32x4){__uint_as_float(w.z << 16), __uint_as_float(w.z & 0xffff0000u), __uint_as_float(w.w << 16), __uint_as_float(w.w & 0xffff0000u)}; }
                    const f32x4 o0 = h0 + gv[bj][0] * acc[ai][bj][m][0], o1 = h1 + gv[bj][1] * acc[ai][bj][m][1];
                    u32x4 ow; ow.x = cvt_pk_bf16(o0[0], o0[1]); ow.y = cvt_pk_bf16(o0[2], o0[3]); ow.z = cvt_pk_bf16(o1[0], o1[1]); ow.w = cvt_pk_bf16(o1[2], o1[3]);
                    *(u32x4*)(hb + (size_t)row * 2048 + col) = ow; }
                if (m & 1) asm volatile("" ::: "memory"); }
    }
};
struct EpiSwiGLU {
    static constexpr bool PERM = true, AFTER_DRAIN = false;
    bf16_t* O;
    __device__ __forceinline__ void operator()(const f32x4 (&acc)[2][2][4][2], const Unit& u, int wr, int wc, int fr, int fq) const {
        const int row0 = u.pm * BM + wr * 64 + fr, col0 = u.pn * HALF + wc * 32 + 8 * fq;
#pragma unroll
        for (int ai = 0; ai < 2; ++ai)
#pragma unroll
            for (int m = 0; m < 4; ++m) { bf16_t* rowp = O + (size_t)(row0 + ai * HALF + m * 16) * 1024 + col0;
                float hv[8];
#pragma unroll
                for (int n = 0; n < 2; ++n)
#pragma unroll
                    for (int i = 0; i < 4; ++i) { const float g = acc[ai][0][m][n][i], up = acc[ai][1][m][n][i];
                        const float sg = g * __builtin_amdgcn_rcpf(1.0f + __builtin_amdgcn_exp2f(-g * 1.4426950408889634f)); hv[n * 4 + i] = sg * up; }
                u32x4 w; w.x = cvt_pk_bf16(hv[0], hv[1]); w.y = cvt_pk_bf16(hv[2], hv[3]); w.z = cvt_pk_bf16(hv[4], hv[5]); w.w = cvt_pk_bf16(hv[6], hv[7]);
                *(u32x4*)rowp = w; }
    }
};
struct EpiGateY {
    static constexpr bool PERM = true, AFTER_DRAIN = false;
    bf16_t* O; const float* gate;
    __device__ __forceinline__ void operator()(const f32x4 (&acc)[2][2][4][2], const Unit& u, int wr, int wc, int fr, int fq) const {
        const int row0 = u.pm * BM + wr * 64 + fr, col0 = u.pn * BM + wc * 32 + 8 * fq;
        float gts[2][4];
#pragma unroll
        for (int ai = 0; ai < 2; ++ai)
#pragma unroll
            for (int m = 0; m < 4; ++m) gts[ai][m] = gate[row0 + ai * HALF + m * 16];
#pragma unroll
        for (int ai = 0; ai < 2; ++ai)
#pragma unroll
            for (int m = 0; m < 4; ++m) { const int row = row0 + ai * HALF + m * 16; const float gt = gts[ai][m]; bf16_t* rowp = O + (size_t)row * 1024 + col0;
#pragma unroll
                for (int bj = 0; bj < 2; ++bj) { const f32x4 v0 = acc[ai][bj][m][0] * gt, v1 = acc[ai][bj][m][1] * gt;
                    u32x4 w; w.x = cvt_pk_bf16(v0[0], v0[1]); w.y = cvt_pk_bf16(v0[2], v0[3]); w.z = cvt_pk_bf16(v1[0], v1[1]); w.w = cvt_pk_bf16(v1[2], v1[3]);
                    *(u32x4*)(rowp + bj * HALF) = w; } }
    }
};

struct EpiInProj {
    static constexpr bool PERM = true, AFTER_DRAIN = false;
    bf16_t* O; bf16_t* Amat; bf16_t* U2;
    __device__ __forceinline__ void operator()(const f32x4 (&acc)[2][2][4][2], const Unit& u, int wr, int wc, int fr, int fq) const {
        const int row0 = u.pm * BM + wr * 64 + fr, cw = wc * 32 + 8 * fq;
#pragma unroll
        for (int ai = 0; ai < 2; ++ai)
#pragma unroll
            for (int m = 0; m < 4; ++m) { const int row = row0 + ai * HALF + m * 16;
#pragma unroll
                for (int bj = 0; bj < 2; ++bj) { const f32x4 v0 = acc[ai][bj][m][0], v1 = acc[ai][bj][m][1];
                    u32x4 w; w.x = cvt_pk_bf16(v0[0], v0[1]); w.y = cvt_pk_bf16(v0[2], v0[3]); w.z = cvt_pk_bf16(v1[0], v1[1]); w.w = cvt_pk_bf16(v1[2], v1[3]);
                    const int cl = cw + bj * HALF;
                    if (u.pn == 3) { const size_t r = (size_t)(cl >> 4) * 2304 + (row >> 4); const int k = (row & 15) * 16 + (cl & 15); *(u32x4*)(Amat + r * 512 + k) = w; *(u32x4*)(U2 + r * 256 + k) = w; }
                    else *(u32x4*)(O + (size_t)row * 1536 + u.pn * BM + cl) = w; } }
    }
};
struct EpiF32x256 {
    static constexpr bool PERM = false, AFTER_DRAIN = false;
    float* C;
    __device__ __forceinline__ void operator()(const f32x4 (&acc)[2][2][4][2], const Unit& u, int wr, int wc, int fr, int fq) const {
        const int row0 = u.pm * BM + wr * 64 + fr, col0 = wc * 32 + 4 * fq;
#pragma unroll
        for (int ai = 0; ai < 2; ++ai)
#pragma unroll
            for (int m = 0; m < 4; ++m) { float* rowp = C + (size_t)(row0 + ai * HALF + m * 16) * 256 + col0;
#pragma unroll
                for (int bj = 0; bj < 2; ++bj)
#pragma unroll
                    for (int n = 0; n < 2; ++n) *(f32x4*)(rowp + bj * HALF + n * 16) = acc[ai][bj][m][n];
                asm volatile("" ::: "memory"); }
    }
};
__device__ __forceinline__ float gelu_t(float x) { const float z2 = 1.5957691216057308f * (x + 0.044715f * x * x * x); return x * __builtin_amdgcn_rcpf(1.0f + __builtin_amdgcn_exp2f(-z2 * 1.4426950408889634f)); }
struct EpiS5Out {
    static constexpr bool PERM = false, AFTER_DRAIN = false;
    bf16_t* Gs; int nsc;
    __device__ __forceinline__ void operator()(const f32x4 (&acc)[2][2][4][2], const Unit& u, int wr, int wc, int fr, int fq) const {
        const int g = u.pm / 9, sc0 = (u.pm % 9) * BM + wr * 64 + fr;
#pragma unroll
        for (int ai = 0; ai < 2; ++ai)
#pragma unroll
            for (int m = 0; m < 4; ++m) { const int sc = sc0 + ai * HALF + m * 16;
                if (sc < nsc) {
#pragma unroll
                    for (int bj = 0; bj < 2; ++bj)
#pragma unroll
                        for (int n = 0; n < 2; ++n) { const int tau = 8 * bj + 2 * wc + n; const f32x4 v = acc[ai][bj][m][n];
                            unsigned lo = cvt_pk_bf16(gelu_t(v[0]), gelu_t(v[1])), hi = cvt_pk_bf16(gelu_t(v[2]), gelu_t(v[3]));
                            *(unsigned long long*)(Gs + (size_t)(16 * sc + tau) * 256 + 16 * g + 4 * fq) = ((unsigned long long)hi << 32) | lo; } } }
    }
};
struct EpiGluNorm {
    static constexpr bool PERM = true, AFTER_DRAIN = true;
    const bf16_t* Gs; bf16_t* mix; bf16_t* mixn; const float* glu_b; const float* ong; float eps;
    __device__ __forceinline__ void fused(f32x4 (&acc)[2][2][4][2], const Unit& u, int wr, int wc, int fr, int fq, PG8_LAS unsigned char* lds, int wid, int lane) const {
        const int row0 = u.pm * BM + wr * 64 + fr, col0 = wc * 32 + 8 * fq;
        f32x4 bv[2][2];
#pragma unroll
        for (int bj = 0; bj < 2; ++bj)
#pragma unroll
            for (int n = 0; n < 2; ++n) bv[bj][n] = *(const f32x4*)(glu_b + col0 + bj * HALF + 4 * n);
        PG8_LAS float* Pq = (PG8_LAS float*)lds;
#pragma unroll
        for (int ai = 0; ai < 2; ++ai)
#pragma unroll
            for (int m = 0; m < 4; ++m) { const int row = row0 + ai * HALF + m * 16; float ss = 0.f;
#pragma unroll
                for (int bj = 0; bj < 2; ++bj) { const int col = col0 + bj * HALF;
                    const u32x4 gw = *(const u32x4*)(Gs + (size_t)row * 256 + col);
                    const unsigned gws[4] = {gw.x, gw.y, gw.z, gw.w};
#pragma unroll
                    for (int i = 0; i < 8; ++i) { const float gv = __uint_as_float((i & 1) ? (gws[i >> 1] & 0xffff0000u) : (gws[i >> 1] << 16));
                        const float z = acc[ai][bj][m][i >> 2][i & 3] + bv[bj][i >> 2][i & 3];
                        const float o = gv * __builtin_amdgcn_rcpf(1.0f + __builtin_amdgcn_exp2f(-z * 1.4426950408889634f));
                        acc[ai][bj][m][i >> 2][i & 3] = o; ss += o * o; } }
                ss += __shfl_xor(ss, 16); ss += __shfl_xor(ss, 32);
                if (fq == 0) Pq[(ai * HALF + wr * 64 + m * 16 + fr) * 4 + wc] = ss; }
        asm volatile("s_waitcnt lgkmcnt(0)" ::: "memory"); __syncthreads();
        f32x4 gv4[2][2];
#pragma unroll
        for (int bj = 0; bj < 2; ++bj)
#pragma unroll
            for (int n = 0; n < 2; ++n) gv4[bj][n] = *(const f32x4*)(ong + 512 + col0 + bj * HALF + 4 * n);
#pragma unroll
        for (int ai = 0; ai < 2; ++ai)
#pragma unroll
            for (int m = 0; m < 4; ++m) { const int rl = ai * HALF + wr * 64 + m * 16 + fr, row = u.pm * BM + rl;
                const f32x4 p4 = *(const PG8_LAS f32x4*)(Pq + rl * 4);
                const float r = 1.0f / sqrtf(((p4[0] + p4[1]) + (p4[2] + p4[3])) * (1.0f / 256.0f) + eps);
#pragma unroll
                for (int bj = 0; bj < 2; ++bj) { const f32x4 v0 = acc[ai][bj][m][0] * r * gv4[bj][0], v1 = acc[ai][bj][m][1] * r * gv4[bj][1];
                    u32x4 w; w.x = cvt_pk_bf16(v0[0], v0[1]); w.y = cvt_pk_bf16(v0[2], v0[3]); w.z = cvt_pk_bf16(v1[0], v1[1]); w.w = cvt_pk_bf16(v1[2], v1[3]);
                    *(u32x4*)(mixn + (size_t)row * 1024 + 512 + col0 + bj * HALF) = w; } }
        asm volatile("s_waitcnt lgkmcnt(0)" ::: "memory"); __syncthreads();
    }
};

template <class Epi, class Sched, bool ALIGN_EPI = false, bool SP2 = false, bool GATHER = false>
__device__ __forceinline__ void gemm_phase(PG8_LAS unsigned char* lds, const Gemm g, const Sched& S, const Epi& E) {
    int tid_ = threadIdx.x; asm volatile("" : "+v"(tid_));
    const int tid = tid_, wid = __builtin_amdgcn_readfirstlane(tid >> 6), lane = tid & 63, wr = wid >> 2, wc = wid & 3, fr = lane & 15, fq = lane >> 4;
    const int K = g.K, nt = K / BK, lda = g.lda;
    unsigned voffA[2], voffB[2];
#pragma unroll
    for (int i = 0; i < 2; ++i) { int R, C; stage_rc(tid * 16 + i * 8192, R, C); const int Rb = Epi::PERM ? ((R & ~31) + perm32(R & 31)) : R;
        voffA[i] = (unsigned)(R * lda + C) * 2u; voffB[i] = (unsigned)(Rb * K + C) * 2u; }
    const size_t kstep = (size_t)(BK * 2);
    const size_t hstepB = (size_t)HALF * K * 2, hstepA = (size_t)HALF * lda * 2;
    const size_t tstepB = 2 * hstepB, tstepA = 2 * hstepA;
    const unsigned ldsw = (unsigned)wid * 1024u;
    const int aoff = lds_byte(wr * 64 + fr, fq * 8), boff = lds_byte(wc * 32 + fr, fq * 8);
#define PG8_SA(b, h) (((b) * 2 + (h)) * HTB)
#define PG8_SB(b, h) ((4 + (b) * 2 + (h)) * HTB)
#define PG8_STAGE(bufoff, gbase, voff) do { _Pragma("unroll") for (int _i = 0; _i < 2; ++_i) \
        __builtin_amdgcn_global_load_lds((const unsigned*)((const char*)(gbase) + (voff)[_i]), (PG8_LAS unsigned*)(lds + (bufoff) + ldsw + _i * 8192), 16, 0, 0); } while (0)
#define PG8_STAGE_A(bufoff, gbase, h, nx) do { if constexpr (GATHER) { _Pragma("unroll") for (int _i = 0; _i < 2; ++_i) \
        __builtin_amdgcn_global_load_lds((const unsigned*)((const char*)(gbase) + ((nx) ? vAn[h][_i] : vAc[h][_i])), (PG8_LAS unsigned*)(lds + (bufoff) + ldsw + _i * 8192), 16, 0, 0); } \
        else { PG8_STAGE(bufoff, (gbase) + ((h) ? hstepA : 0), voffA); } } while (0)
#define PG8_LDA(dst, b, h) do { _Pragma("unroll") for (int m = 0; m < 4; ++m) _Pragma("unroll") for (int k = 0; k < 2; ++k) dst[m][k] = *(const PG8_LAS bf16x8*)(lds + PG8_SA(b, h) + aoff + m * 2048 + k * 1024); } while (0)
#define PG8_LDB(dst, b, h) do { _Pragma("unroll") for (int n = 0; n < 2; ++n) _Pragma("unroll") for (int k = 0; k < 2; ++k) dst[n][k] = *(const PG8_LAS bf16x8*)(lds + PG8_SB(b, h) + boff + n * 2048 + k * 1024); } while (0)
#define PG8_MMA(ai, bj, At, Bt) do { __builtin_amdgcn_s_setprio(1); _Pragma("unroll") for (int m = 0; m < 4; ++m) _Pragma("unroll") for (int n = 0; n < 2; ++n) _Pragma("unroll") for (int k = 0; k < 2; ++k) \
        acc[ai][bj][m][n] = __builtin_amdgcn_mfma_f32_16x16x32_bf16(Bt[n][k], At[m][k], acc[ai][bj][m][n], 0, 0, 0); __builtin_amdgcn_s_setprio(0); } while (0)
#define PG8_WAIT_V(n) asm volatile("s_waitcnt vmcnt(" #n ")" ::: "memory")
#define PG8_WAIT_L(n) asm volatile("s_waitcnt lgkmcnt(" #n ")" ::: "memory")
#define PG8_BAR __builtin_amdgcn_s_barrier()
#define PG8_SCHED __builtin_amdgcn_sched_barrier(0)
    Unit cur, nxt; int ui = 0;
    if (!S.next(0, cur)) return;
    unsigned vAc[2][2] = {{0u, 0u}, {0u, 0u}}, vAn[2][2] = {{0u, 0u}, {0u, 0u}}; int RA[2], CA[2];
#pragma unroll
    for (int i = 0; i < 2; ++i) stage_rc(tid * 16 + i * 8192, RA[i], CA[i]);
    PG8_LAS int* const ridx = (PG8_LAS int*)(lds + STAGE_BYTES + 1024);
    if constexpr (GATHER) {
        Unit tu; for (int k = 0; k < 15 && S.next(k, tu); ++k) if (tid < 256) ridx[k * 256 + tid] = g.rowidx[tu.pm * BM + tid];
        asm volatile("s_waitcnt vmcnt(0) lgkmcnt(0)" ::: "memory"); __builtin_amdgcn_s_barrier(); asm volatile("" ::: "memory");
#pragma unroll
        for (int h = 0; h < 2; ++h)
#pragma unroll
            for (int i = 0; i < 2; ++i) vAc[h][i] = (unsigned)(ridx[h * HALF + RA[i]] * lda + CA[i]) * 2u;
    }
    f32x4 acc[2][2][4][2];
#pragma unroll
    for (int a = 0; a < 2; ++a)
#pragma unroll
        for (int b = 0; b < 2; ++b)
#pragma unroll
            for (int m = 0; m < 4; ++m)
#pragma unroll
                for (int n = 0; n < 2; ++n) acc[a][b][m][n] = (f32x4){0.f, 0.f, 0.f, 0.f};
    bf16x8 At[4][2], B0[2][2], B1[2][2];
    const char* cA = (const char*)g.A + (GATHER ? (size_t)0 : (size_t)cur.pm * tstepA); const char* cB = (const char*)g.Bt + (size_t)cur.pb * tstepB;
    S.a_ready(cur);
    if constexpr (SP2) {
        PG8_STAGE(PG8_SB(0, 0), cB, voffB); PG8_STAGE(PG8_SB(0, 1), cB + hstepB, voffB); PG8_STAGE_A(PG8_SA(0, 0), cA, 0, false); PG8_STAGE_A(PG8_SA(0, 1), cA, 1, false);
        if (wr == 1) PG8_BAR;
        PG8_WAIT_V(2); PG8_BAR;
        PG8_STAGE(PG8_SB(1, 0), cB + kstep, voffB); PG8_STAGE_A(PG8_SA(1, 0), cA + kstep, 0, false); PG8_STAGE(PG8_SB(1, 1), cB + hstepB + kstep, voffB);
        PG8_WAIT_V(6); PG8_BAR;
    } else {
        PG8_STAGE(PG8_SB(0, 0), cB, voffB); PG8_STAGE_A(PG8_SA(0, 0), cA, 0, false); PG8_STAGE(PG8_SB(0, 1), cB + hstepB, voffB); PG8_STAGE_A(PG8_SA(0, 1), cA, 1, false);
        if (wr == 1) PG8_BAR;
        PG8_WAIT_V(4); PG8_BAR;
        PG8_STAGE(PG8_SB(1, 0), cB + kstep, voffB); PG8_STAGE_A(PG8_SA(1, 0), cA + kstep, 0, false); PG8_STAGE(PG8_SB(1, 1), cB + hstepB + kstep, voffB);
        PG8_WAIT_V(6); PG8_BAR;
    }
    for (;;) {
        const bool has_next = S.next(ui + 1, nxt);
        const char* nA = GATHER ? (const char*)g.A : (has_next ? (const char*)g.A + (size_t)nxt.pm * tstepA : cA);
        if constexpr (GATHER) {
#pragma unroll
            for (int h = 0; h < 2; ++h)
#pragma unroll
                for (int i = 0; i < 2; ++i) vAn[h][i] = has_next ? (unsigned)(ridx[(ui + 1) * 256 + h * HALF + RA[i]] * lda + CA[i]) * 2u : vAc[h][i]; } const char* nB = has_next ? (const char*)g.Bt + (size_t)nxt.pb * tstepB : cB;
        for (int t = 0; t < nt; t += 2) {
            const bool last = (t == nt - 2);
            const char* a1 = cA + (size_t)(t + 1) * kstep;
            const char* a2 = last ? nA : cA + (size_t)(t + 2) * kstep; const char* b2 = last ? nB : cB + (size_t)(t + 2) * kstep;
            const char* a3 = a2 + kstep; const char* b3 = b2 + kstep;
            if (last && has_next) S.a_ready(nxt);
            if constexpr (SP2) {
            PG8_LDB(B0, 0, 0); PG8_LDB(B1, 0, 1); PG8_SCHED; PG8_LDA(At, 0, 0); PG8_STAGE_A(PG8_SA(1, 1), a1, 1, false);
            PG8_WAIT_V(8); PG8_WAIT_L(0); PG8_BAR; PG8_MMA(0, 0, At, B0); PG8_MMA(0, 1, At, B1); PG8_BAR; PG8_SCHED;
            PG8_LDA(At, 0, 1); PG8_STAGE(PG8_SB(0, 0), b2, voffB); PG8_STAGE(PG8_SB(0, 1), b2 + hstepB, voffB); PG8_STAGE_A(PG8_SA(0, 0), a2, 0, last);
            PG8_WAIT_V(8); PG8_WAIT_L(0); PG8_BAR; PG8_MMA(1, 0, At, B0); PG8_MMA(1, 1, At, B1); PG8_BAR; PG8_SCHED;
            PG8_LDB(B0, 1, 0); PG8_LDB(B1, 1, 1); PG8_SCHED; PG8_LDA(At, 1, 0); PG8_STAGE_A(PG8_SA(0, 1), a2, 1, last);
            PG8_WAIT_V(8); PG8_WAIT_L(0); PG8_BAR; PG8_MMA(0, 0, At, B0); PG8_MMA(0, 1, At, B1); PG8_BAR; PG8_SCHED;
            PG8_LDA(At, 1, 1); PG8_STAGE(PG8_SB(1, 0), b3, voffB); PG8_STAGE(PG8_SB(1, 1), b3 + hstepB, voffB); PG8_STAGE_A(PG8_SA(1, 0), a3, 0, last);
            PG8_WAIT_V(8); PG8_WAIT_L(0); PG8_BAR; PG8_MMA(1, 0, At, B0); PG8_MMA(1, 1, At, B1); PG8_BAR; PG8_SCHED;
            } else {
            PG8_LDB(B0, 0, 0); PG8_SCHED; PG8_LDA(At, 0, 0); PG8_STAGE_A(PG8_SA(1, 1), a1, 1, false);
            PG8_WAIT_L(8); PG8_BAR; PG8_WAIT_L(0); PG8_MMA(0, 0, At, B0); PG8_BAR; PG8_SCHED;
            PG8_LDB(B1, 0, 1); PG8_STAGE(PG8_SB(0, 0), b2, voffB);
            PG8_BAR; PG8_WAIT_L(0); PG8_MMA(0, 1, At, B1); PG8_BAR;
            PG8_LDA(At, 0, 1); PG8_STAGE_A(PG8_SA(0, 0), a2, 0, last);
            PG8_BAR; PG8_WAIT_L(0); PG8_MMA(1, 0, At, B0); PG8_BAR; PG8_SCHED;
            PG8_STAGE(PG8_SB(0, 1), b2 + hstepB, voffB);
            PG8_WAIT_V(6); PG8_BAR; PG8_MMA(1, 1, At, B1); PG8_BAR;
            PG8_LDB(B0, 1, 0); PG8_SCHED; PG8_LDA(At, 1, 0); PG8_STAGE_A(PG8_SA(0, 1), a2, 1, last);
            PG8_WAIT_L(8); PG8_BAR; PG8_WAIT_L(0); PG8_MMA(0, 0, At, B0); PG8_BAR; PG8_SCHED;
            PG8_LDB(B1, 1, 1); PG8_STAGE(PG8_SB(1, 0), b3, voffB);
            PG8_BAR; PG8_WAIT_L(0); PG8_MMA(0, 1, At, B1); PG8_BAR;
            PG8_LDA(At, 1, 1); PG8_STAGE_A(PG8_SA(1, 0), a3, 0, last);
            PG8_BAR; PG8_WAIT_L(0); PG8_MMA(1, 0, At, B0); PG8_BAR; PG8_SCHED;
            PG8_STAGE(PG8_SB(1, 1), b3 + hstepB, voffB);
            PG8_WAIT_V(6); PG8_BAR; PG8_MMA(1, 1, At, B1); PG8_BAR;
            }
        }
        if constexpr (ALIGN_EPI) { if (wr == 0) PG8_BAR; }
        if constexpr (!Epi::AFTER_DRAIN) { E(acc, cur, wr, wc, fr, fq); S.done(cur); }
        if (!has_next) break;
#pragma unroll
        for (int a = 0; a < 2; ++a)
#pragma unroll
            for (int b = 0; b < 2; ++b)
#pragma unroll
                for (int m = 0; m < 4; ++m)
#pragma unroll
                    for (int n = 0; n < 2; ++n) acc[a][b][m][n] = (f32x4){0.f, 0.f, 0.f, 0.f};
        cur = nxt; cA = nA; cB = nB; ++ui;
        if constexpr (GATHER) {
#pragma unroll
            for (int h = 0; h < 2; ++h)
#pragma unroll
                for (int i = 0; i < 2; ++i) vAc[h][i] = vAn[h][i]; }
        if constexpr (ALIGN_EPI) { if (wr == 1) PG8_BAR; }
    }
    PG8_WAIT_V(0);
    if constexpr (!ALIGN_EPI) { if (wr == 0) PG8_BAR; }
    PG8_BAR;
    if constexpr (Epi::AFTER_DRAIN) { E.fused(acc, cur, wr, wc, fr, fq, lds, wid, lane); S.done(cur); }
#undef PG8_SA
#undef PG8_SB
#undef PG8_STAGE
#undef PG8_LDA
#undef PG8_LDB
#undef PG8_MMA
#undef PG8_WAIT_V
#undef PG8_WAIT_L
#undef PG8_BAR
#undef PG8_SCHED
}
}
#define GAS __attribute__((address_space(1)))
#define LAS __attribute__((address_space(3)))
typedef unsigned short bf16;
typedef unsigned v4u __attribute__((ext_vector_type(4)));
typedef float f32x4 __attribute__((ext_vector_type(4)));
typedef short bf16x8 __attribute__((ext_vector_type(8)));
typedef GAS unsigned gu32;
typedef GAS unsigned long long gu64;
#define RLX_AGENT __ATOMIC_RELAXED, __HIP_MEMORY_SCOPE_AGENT
#define LDS_WAIT() asm volatile("s_waitcnt lgkmcnt(0)" ::: "memory")
#define VM_WAIT() asm volatile("s_waitcnt vmcnt(0)" ::: "memory")
__device__ __forceinline__ unsigned long long rt() { return __builtin_amdgcn_s_memrealtime(); }
__device__ __forceinline__ unsigned f2bf(float f) { unsigned u = __builtin_bit_cast(unsigned, f); return (u + 0x7fffu + ((u >> 16) & 1u)) >> 16; }
typedef float pk_f32x2 __attribute__((ext_vector_type(2))); typedef __bf16 pk_bf16x2 __attribute__((ext_vector_type(2)));
__device__ __forceinline__ unsigned pk2(float lo, float hi) { pk_f32x2 v = {lo, hi}; pk_bf16x2 b = __builtin_convertvector(v, pk_bf16x2); return __builtin_bit_cast(unsigned, b); }

#define XB_TMO      128
#define XB_XCNT(j)  (256  + 64 * (j))
#define XB_XSUB(j)  (1280 + 64 * (j))
#define XB_XGEN(j)  (2304 + 64 * (j))
#define XB_TOP      3328
#define XB_TOPGEN   3392
#define XCD_BAR_WORDS 3456
#define XB_SPIN_CAP (1u << 18)

__device__ __forceinline__ unsigned xb_ld(unsigned* p)              { return __hip_atomic_load(p, __ATOMIC_RELAXED, __HIP_MEMORY_SCOPE_AGENT); }
__device__ __forceinline__ unsigned xb_add(unsigned* p, unsigned v) { return __hip_atomic_fetch_add(p, v, __ATOMIC_RELAXED, __HIP_MEMORY_SCOPE_AGENT); }
__device__ __forceinline__ unsigned xb_xcc_id() { return (unsigned)__builtin_amdgcn_s_getreg((3 << 11) | 20) & 0xFu; }
#define XB_SPIN(cond, bar) do { unsigned _sp = 0; while (cond) { __builtin_amdgcn_s_sleep(1); \
    if ((++_sp & 255u) == 0u) { if (xb_ld(&(bar)[XB_TMO])) break; if (_sp > XB_SPIN_CAP) { atomicAdd(&(bar)[XB_TMO], 1u); break; } } } } while (0)

struct XcdBarrier {
    unsigned* bar; unsigned x;
    volatile LAS unsigned* st;
};

__device__ __forceinline__ XcdBarrier xcd_barrier_post(unsigned* bar, volatile LAS unsigned* st) {
    XcdBarrier b; b.bar = bar; b.x = xb_xcc_id(); b.st = st;
    if (threadIdx.x == 0) (void)xb_add(&bar[XB_XCNT(b.x)], 1u);
    return b;
}
__device__ __forceinline__ void xcd_barrier_complete(unsigned* bar, unsigned x, unsigned& nloc, unsigned& nx) {
    const unsigned G = gridDim.x * gridDim.y * gridDim.z;
    unsigned sum, cnt, mine, sp = 0u;
    for (;;) {
        sum = 0u; cnt = 0u; mine = 0u;
#pragma unroll
        for (unsigned j = 0; j < 16; ++j) { const unsigned c = xb_ld(&bar[XB_XCNT(j)]); sum += c; cnt += (c > 0u) ? 1u : 0u; mine = (j == x) ? c : mine; }
        if (sum == G) break;
        __builtin_amdgcn_s_sleep(1);
        if ((++sp & 255u) == 0u) { if (xb_ld(&bar[XB_TMO])) break; if (sp > XB_SPIN_CAP) { atomicAdd(&bar[XB_TMO], 1u); break; } }
    }
    nloc = mine > 0u ? mine : 1u; nx = cnt > 0u ? cnt : 1u;
}

__device__ __forceinline__ void xcd_barrier(const XcdBarrier& b) {
    asm volatile("s_waitcnt vmcnt(0)" ::: "memory");
    __syncthreads();
    if (threadIdx.x == 0) {
        unsigned* bar = b.bar;
        __builtin_amdgcn_s_waitcnt(0);
        unsigned nloc = b.st[0], nx = b.st[1];
        if (nloc == 0u) { xcd_barrier_complete(bar, b.x, nloc, nx); b.st[0] = nloc; b.st[1] = nx; }
        const unsigned old = xb_add(&bar[XB_XSUB(b.x)], 1u);
        const unsigned gen = old / nloc;
        if (old + 1u == (gen + 1u) * nloc) {
            __builtin_amdgcn_fence(__ATOMIC_RELEASE, "agent");
            asm volatile("s_waitcnt vmcnt(0)" ::: "memory");
            const unsigned og = xb_add(&bar[XB_TOP], 1u);
            const unsigned tg = og / nx;
            if (og + 1u == (tg + 1u) * nx) xb_add(&bar[XB_TOPGEN], 1u);
            else XB_SPIN(xb_ld(&bar[XB_TOPGEN]) == tg, bar);
            __builtin_amdgcn_fence(__ATOMIC_ACQUIRE, "agent");
            xb_add(&bar[XB_XGEN(b.x)], 1u);
            asm volatile("s_waitcnt vmcnt(0)" ::: "memory");
        } else {
            XB_SPIN(xb_ld(&bar[XB_XGEN(b.x)]) == gen, bar);
            __builtin_amdgcn_fence(__ATOMIC_ACQUIRE, "agent");
            asm volatile("s_waitcnt vmcnt(0)" ::: "memory");
        }
    }
    __syncthreads();
}

typedef float f32x2 __attribute__((ext_vector_type(2)));
typedef float f32x16 __attribute__((ext_vector_type(16)));
typedef unsigned u32x2 __attribute__((ext_vector_type(2)));
typedef short v4i16_t __attribute__((ext_vector_type(4)));

constexpr size_t MiB = 1u << 20;
constexpr size_t WS_CTL = 0, CTL_ZERO_BYTES = 1 * MiB;
constexpr size_t WS_MODV = 1 * MiB;
constexpr size_t WS_POW  = 1 * MiB + 256 * 1024;
constexpr size_t WS_BBAR = 2 * MiB;
constexpr size_t WS_WGLU = 2 * MiB + 512 * 1024;
constexpr size_t WS_WSGU = 2 * MiB + 768 * 1024;
constexpr size_t WS_HCTX = 3 * MiB;
constexpr size_t WS_EB   = 5 * MiB;
constexpr size_t WS_TG   = 9 * MiB;
constexpr size_t WS_ROPE = 17 * MiB;
constexpr size_t WS_KTAB = 19 * MiB + 512 * 1024;
constexpr size_t WS_PROBS = 22 * MiB;
constexpr size_t WS_SMAP = 24 * MiB + 256 * 1024;
constexpr size_t WS_IDX  = 26 * MiB + 512 * 1024;
constexpr size_t WS_GATE = 27 * MiB;
constexpr size_t WS_WIN  = 28 * MiB;
constexpr size_t WS_WOUT = 34 * MiB;
constexpr size_t WS_WGU  = 38 * MiB;
constexpr size_t WS_WD   = 102 * MiB;
constexpr size_t WS_R1   = 134 * MiB;
constexpr size_t WS_R2   = 270 * MiB;
constexpr size_t WS_R3   = 406 * MiB;
constexpr size_t WS_WD1  = 542 * MiB;
constexpr size_t WS_END  = 574 * MiB;
constexpr size_t OFF_GS = 66 * MiB, OFF_AMAT = 84 * MiB;
constexpr size_t OFF_E = 98 * MiB;
constexpr int POWS = 20;
static_assert((size_t)XROWS * 2048 == 136 * MiB, "MoE row buffers are 136 MiB");
constexpr int CW_TMO = 0, CW_CODE = 1;
constexpr int CW_BAR = 4096;
constexpr int CW_TS = 8192;
constexpr int CW_Q = 16384;
constexpr int RING_OFF = 0, RING_BYTES = 131072;
constexpr int LDSCTL_OFF = RING_BYTES, MISC_OFF = LDSCTL_OFF + 320;
constexpr int LDS_BYTES = 147456;
constexpr int NWAVES = 8;


struct Args { const float* in[31]; float* out; unsigned char* ws; int ph_lo, ph_hi; };
typedef const GAS float* fptr_t;
typedef const __attribute__((address_space(4))) fptr_t kfptr;
struct Ctx {
    LAS unsigned char* lds; volatile LAS unsigned* MISC; gu32* ctl;
    int tid, lane, wave, vcu, G;
    kfptr* inp; GAS float* out; GAS unsigned char* ws;
};
enum InIdx { I_X = 0, I_C, I_CTX, I_CCTX, I_ADAW, I_ADAB, I_NMIXG, I_NFFNG, I_WIN, I_QNG, I_KNG, I_SINK, I_LRE, I_LIM, I_LOGDT, I_BRE, I_BIM, I_CRE, I_CIM,
             I_S5D, I_GLUW, I_GLUB, I_SGUNG, I_SGUW, I_SGUB, I_ONG, I_WOUT, I_ROUTW, I_WG, I_WU, I_WDN };

__device__ __forceinline__ float bf2f(unsigned h) { return __uint_as_float(h << 16); }
__device__ __forceinline__ float wave_sum(float v) {
#pragma unroll
    for (int o = 1; o < 64; o <<= 1) v += __shfl_xor(v, o);
    return v;
}
__device__ __forceinline__ float gelu_tanh(float x) {
    const float z2 = 1.5957691216057308f * (x + 0.044715f * x * x * x);
    return x * __builtin_amdgcn_rcpf(1.0f + __builtin_amdgcn_exp2f(-z2 * LOG2E));
}
__device__ __forceinline__ float silu_f(float x) { return x / (1.0f + __expf(-x)); }
#define WG_SYNC() do { asm volatile("s_waitcnt vmcnt(0) lgkmcnt(0)" ::: "memory"); __syncthreads(); } while (0)

__device__ __forceinline__ int q_next(const Ctx& c, int qi) {
    LDS_WAIT(); __syncthreads();
    if (c.tid == 0) c.MISC[16] = __hip_atomic_fetch_add(c.ctl + CW_Q + 64 * qi, 1u, RLX_AGENT);
    __syncthreads();
    const int u = (int)c.MISC[16];
    return __builtin_amdgcn_readfirstlane(u);
}

__device__ __forceinline__ void transpose_item(const GAS float* W, int K, int N, bf16* WT, int ilv, LAS float* scr, int item, int lane) {
    const int nblk = N / 32, kb = item / nblk, nb = item % nblk, k0 = 64 * kb, n0 = 32 * nb;
    const int row_off = ilv ? ((n0 >> 7) * 128 + (ilv == 2 ? 128 : 0)) : 0;
    { const int n4 = (lane & 7) * 4; f32x4 v[8];
#pragma unroll
      for (int i = 0; i < 8; ++i) v[i] = *(const GAS f32x4*)(W + (size_t)(k0 + (lane >> 3) + 8 * i) * N + n0 + n4);
#pragma unroll
      for (int i = 0; i < 8; ++i) { LAS float* d = scr + ((lane >> 3) + 8 * i) * 33 + n4; d[0] = v[i][0]; d[1] = v[i][1]; d[2] = v[i][2]; d[3] = v[i][3]; } }
    LDS_WAIT(); asm volatile("" ::: "memory");
    const int cc = lane & 7;
#pragma unroll
    for (int j = 0; j < 4; ++j) { const int n = (lane >> 3) + 8 * j; const LAS float* s = scr + (8 * cc) * 33 + n;
        v4u o; o.x = pk2(s[0 * 33], s[1 * 33]); o.y = pk2(s[2 * 33], s[3 * 33]); o.z = pk2(s[4 * 33], s[5 * 33]); o.w = pk2(s[6 * 33], s[7 * 33]);
        *(GAS v4u*)(WT + (size_t)(row_off + n0 + n) * K + k0 + 8 * cc) = o; }
    LDS_WAIT(); asm volatile("" ::: "memory");
}
__device__ __forceinline__ void convert_experts(const Ctx& c_, int l, int w_lo, int w_hi, int blk_lo) { Ctx c = c_; asm volatile("" : "+s"(c.ws), "+s"(c.inp), "+s"(c.out), "+v"(c.tid)); c.lane = c.tid & 63; asm volatile("" : "+s"(l));
    LAS float* scr = (LAS float*)(c.lds + RING_OFF + c.wave * 16384);
    const int gw = (blk_lo ? (int)blockIdx.x - blk_lo : c.vcu) * NWAVES + c.wave, NGW = (c.G - blk_lo) * NWAVES;
    bf16* WGU = (bf16*)(c.ws + WS_WGU); bf16* WD = (bf16*)(c.ws + (l == 0 ? WS_WD : WS_WD1));
    if (gw < 0) return;
    for (int it = w_lo * 16 * 512 + gw; it < w_hi * 16 * 512; it += NGW) {
        const int which = it / (16 * 512), r = it % (16 * 512), e = r / 512, item = r % 512;
        const size_t wofs = ((size_t)l * 16 + e) * 1024 * 1024;
        if (which == 0) transpose_item(c.inp[I_WG] + wofs, 1024, 1024, WGU + (size_t)e * 2048 * 1024, 1, scr, item, c.lane);
        else if (which == 1) transpose_item(c.inp[I_WU] + wofs, 1024, 1024, WGU + (size_t)e * 2048 * 1024, 2, scr, item, c.lane);
        else transpose_item(c.inp[I_WDN] + wofs, 1024, 1024, WD + (size_t)e * 1024 * 1024, 0, scr, item, c.lane);
    }
}

__device__ __forceinline__ void p0a(const Ctx& c_) { Ctx c = c_; asm volatile("" : "+s"(c.ws), "+s"(c.inp), "+s"(c.out), "+v"(c.tid)); c.lane = c.tid & 63;
    {
        float* modv = (float*)(c.ws + WS_MODV); LAS float* red = (LAS float*)(c.lds + RING_OFF);
        for (int it = (int)blockIdx.x; it < 192; it += c.G) {
            const int l = it / 96, col = (it % 96) * 64 + c.lane;
            const GAS float* W = c.inp[I_ADAW] + (size_t)l * 1024 * 6144 + col;
            float a0 = 0.f, a1 = 0.f, a2 = 0.f;
            const int kb = c.wave * 128;
#pragma unroll 8
            for (int k = 0; k < 128; ++k) { const float w = W[(size_t)(kb + k) * 6144];
                a0 += silu_f(c.inp[I_C][kb + k]) * w; a1 += silu_f(c.inp[I_C][1024 + kb + k]) * w; a2 += silu_f(c.inp[I_CCTX][kb + k]) * w; }
            red[(c.wave * 3 + 0) * 64 + c.lane] = a0; red[(c.wave * 3 + 1) * 64 + c.lane] = a1; red[(c.wave * 3 + 2) * 64 + c.lane] = a2;
            WG_SYNC();
            if (c.wave < 3) { float s = 0.f;
#pragma unroll
                for (int w = 0; w < 8; ++w) s += red[(w * 3 + c.wave) * 64 + c.lane];
                modv[(size_t)(l * 3 + c.wave) * 6144 + col] = s + c.inp[I_ADAB][l * 6144 + col]; }
            WG_SYNC();
        }
    }
    {
        LAS float* scr = (LAS float*)(c.lds + RING_OFF + c.wave * 16384);
        const int gw = c.vcu * NWAVES + c.wave, NGW = c.G * NWAVES;
        constexpr int I_IN = 16 * 48, I_OUT = 16 * 32, I_GLU = 4 * 8;
        constexpr int NIT = 2 * (I_IN + I_OUT + I_GLU);
        for (int it = gw; it < NIT; it += NGW) {
            int r = it; const int l = r / (I_IN + I_OUT + I_GLU); r %= (I_IN + I_OUT + I_GLU);
            if (r < I_IN) { transpose_item(c.inp[I_WIN] + (size_t)l * 1024 * INW, 1024, INW, (bf16*)(c.ws + WS_WIN) + (size_t)l * INW * 1024, 0, scr, r, c.lane); continue; } r -= I_IN;
            if (r < I_OUT) { transpose_item(c.inp[I_WOUT] + (size_t)l * 1024 * 1024, 1024, 1024, (bf16*)(c.ws + WS_WOUT) + (size_t)l * 1024 * 1024, 0, scr, r, c.lane); continue; } r -= I_OUT;
            transpose_item(c.inp[I_GLUW] + (size_t)l * 256 * 256, 256, 256, (bf16*)(c.ws + WS_WGLU) + (size_t)l * 256 * 256, 0, scr, r, c.lane);
        }
        bf16* wsgu = (bf16*)(c.ws + WS_WSGU);
        for (int i = c.vcu * 512 + c.tid; i < 131072 / 8; i += c.G * 512) { const GAS float* s = c.inp[I_SGUW] + (size_t)i * 8;
            v4u o; o.x = pk2(s[0], s[1]); o.y = pk2(s[2], s[3]); o.z = pk2(s[4], s[5]); o.w = pk2(s[6], s[7]); *(GAS v4u*)(wsgu + (size_t)i * 8) = o; }
    }
    {
        f32x2* POW = (f32x2*)(c.ws + WS_POW); f32x2* BBAR = (f32x2*)(c.ws + WS_BBAR);
        for (int idx = c.vcu * 512 + c.tid; idx < 2 * 2 * 16 * 64; idx += c.G * 512) {
            const double lr = (double)c.inp[I_LRE][idx], li = (double)c.inp[I_LIM][idx], dt = exp((double)c.inp[I_LOGDT][idx >> 6]);
            for (int k = 0; k < 19; ++k) { const double kk = (k == 17) ? 256.0 : (k == 18) ? 2080.0 : (double)k; const double mag = exp(lr * dt * kk), ang = li * dt * kk;
                POW[(size_t)idx * POWS + k] = (f32x2){(float)(mag * cos(ang)), (float)(mag * sin(ang))}; }
            const double mag = exp(lr * dt), ang = li * dt; const double abr = mag * cos(ang), abi = mag * sin(ang);
            const double nr = abr - 1.0, ni = abi, den = lr * lr + li * li;
            const double cr = (nr * lr + ni * li) / den, ci = (ni * lr - nr * li) / den;
            for (int ch = 0; ch < 16; ++ch) { const double br = (double)c.inp[I_BRE][(size_t)idx * 16 + ch], bi = (double)c.inp[I_BIM][(size_t)idx * 16 + ch];
                BBAR[(size_t)idx * 16 + ch] = (f32x2){(float)(cr * br - ci * bi), (float)(cr * bi + ci * br)}; }
        }
    }
    { f32x2* ROPE = (f32x2*)(c.ws + WS_ROPE);
      for (int i = c.vcu * 512 + c.tid; i < 256 * 16; i += c.G * 512) { const int pos = i >> 4, f = i & 15;
          const double inv = exp2(-(double)(2 * f) * (13.287712379549449 / 32.0)), ang = (double)pos * inv; ROPE[i] = (f32x2){(float)cos(ang), (float)sin(ang)}; } }
    convert_experts(c, 0, 0, 3, 0);
}

__device__ __forceinline__ void p0b_tables(const Ctx& c_) { Ctx c = c_; asm volatile("" : "+s"(c.ws), "+s"(c.inp), "+s"(c.out), "+v"(c.tid)); c.lane = c.tid & 63;
    const GAS f32x2* POW = (const GAS f32x2*)(c.ws + WS_POW); const GAS f32x2* BBAR = (const GAS f32x2*)(c.ws + WS_BBAR);
    bf16* EB = (bf16*)(c.ws + WS_EB);
    const int gt = c.vcu * 512 + c.tid, NT = c.G * 512;
    for (int it = gt; it < 262144; it += NT) {
        const int k0 = (it & 31) * 8, n = (it >> 5) & 255, g = (it >> 13) & 15, l = it >> 17;
        const int d = n >> 7, p = (n & 127) >> 1, ri = n & 1, s = k0 >> 4, c0 = k0 & 15;
        const int cidx = ((l * 2 + d) * 16 + g) * 64 + p;
        const f32x2 pw = POW[(size_t)cidx * POWS + (d == 0 ? 15 - s : s)];
        float v[8];
#pragma unroll
        for (int j = 0; j < 8; ++j) { const f32x2 bb = BBAR[(size_t)cidx * 16 + c0 + j]; v[j] = ri ? (pw.x * bb.y + pw.y * bb.x) : (pw.x * bb.x - pw.y * bb.y); }
        v4u o; o.x = pk2(v[0], v[1]); o.y = pk2(v[2], v[3]); o.z = pk2(v[4], v[5]); o.w = pk2(v[6], v[7]);
        *(GAS v4u*)(EB + ((size_t)((l * 16 + g) * 256 + n)) * 256 + k0) = o;
    }
    float* KT = (float*)(c.ws + WS_KTAB);
    for (int it = gt; it < 32768; it += NT) {
        const int c0 = (it & 1) * 8, ch = (it >> 1) & 15, dl = (it >> 5) & 15, d = (it >> 9) & 1, g = (it >> 10) & 15, l = it >> 14;
        const int cb = ((l * 2 + d) * 16 + g) * 64; const size_t cofs = ((size_t)((l * 2 + d) * 16 + g) * 16 + ch) * 64;
        float v[8];
#pragma unroll
        for (int j = 0; j < 8; ++j) v[j] = 0.f;
        for (int p = 0; p < 64; ++p) {
            const float cre = c.inp[I_CRE][cofs + p], cim = c.inp[I_CIM][cofs + p];
            const f32x2 pw = POW[(size_t)(cb + p) * POWS + dl];
            const float wr = cre * pw.x - cim * pw.y, wi = cre * pw.y + cim * pw.x;
#pragma unroll
            for (int j = 0; j < 8; ++j) { const f32x2 bb = BBAR[(size_t)(cb + p) * 16 + c0 + j]; v[j] += wr * bb.x - wi * bb.y; }
        }
        float* dst = KT + ((size_t)(((l * 16 + g) * 2 + d) * 16 + dl) * 16 + ch) * 16 + c0;
        *(GAS f32x4*)dst = (f32x4){v[0], v[1], v[2], v[3]}; *(GAS f32x4*)(dst + 4) = (f32x4){v[4], v[5], v[6], v[7]};
    }
}
__device__ __forceinline__ void tg_assemble(const Ctx& c_) { Ctx c = c_; asm volatile("" : "+s"(c.ws), "+s"(c.inp), "+s"(c.out), "+v"(c.tid)); c.lane = c.tid & 63;
    const GAS f32x2* POW = (const GAS f32x2*)(c.ws + WS_POW); const GAS float* KT = (const GAS float*)(c.ws + WS_KTAB); bf16* TG = (bf16*)(c.ws + WS_TG);
    const int gt = c.vcu * 512 + c.tid, NT = c.G * 512;
    for (int it = gt; it < 524288; it += NT) {
        const int k0 = (it & 63) * 8, n = (it >> 6) & 255, g = (it >> 14) & 15, l = it >> 18;
        const int tau = n >> 4, ch = n & 15;
        float v[8];
        if (k0 < 256) {
            const int s = k0 >> 4, c0 = k0 & 15;
#pragma unroll
            for (int j = 0; j < 8; ++j) v[j] = (s == tau && (c0 + j) == ch) ? c.inp[I_S5D][l * 256 + g * 16 + ch] : 0.f;
#pragma unroll
            for (int d = 0; d < 2; ++d) { const int dl = d == 0 ? tau - s : s - tau;
                if (dl >= 0) { const GAS float* kp = KT + ((size_t)(((l * 16 + g) * 2 + d) * 16 + dl) * 16 + ch) * 16 + c0; const f32x4 k0v = *(const GAS f32x4*)kp, k1v = *(const GAS f32x4*)(kp + 4);
                    v[0] += k0v[0]; v[1] += k0v[1]; v[2] += k0v[2]; v[3] += k0v[3]; v[4] += k1v[0]; v[5] += k1v[1]; v[6] += k1v[2]; v[7] += k1v[3]; } }
        } else {
#pragma unroll
            for (int j = 0; j < 8; ++j) { const int kk = k0 - 256 + j, d = kk >> 7, p = (kk & 127) >> 1, ri = kk & 1;
                const int cidx = ((l * 2 + d) * 16 + g) * 64 + p;
                const float cre = c.inp[I_CRE][((size_t)((l * 2 + d) * 16 + g) * 16 + ch) * 64 + p], cim = c.inp[I_CIM][((size_t)((l * 2 + d) * 16 + g) * 16 + ch) * 64 + p];
                const f32x2 pw = POW[(size_t)cidx * POWS + (d == 0 ? tau + 1 : 16 - tau)];
                const float wr = cre * pw.x - cim * pw.y, wi = cre * pw.y + cim * pw.x;
                v[j] = ri ? -wi : wr; }
        }
        v4u o; o.x = pk2(v[0], v[1]); o.y = pk2(v[2], v[3]); o.z = pk2(v[4], v[5]); o.w = pk2(v[6], v[7]);
        *(GAS v4u*)(TG + ((size_t)((l * 16 + g) * 256 + n)) * 512 + k0) = o;
    }
}

__device__ __forceinline__ void row_prep(const Ctx& c_, int mode, int l) { Ctx c = c_; asm volatile("" : "+s"(c.ws), "+s"(c.inp), "+s"(c.out), "+v"(c.tid)); c.lane = c.tid & 63; asm volatile("" : "+s"(l));
    const int gw = c.vcu * NWAVES + c.wave, NGW = c.G * NWAVES;
    const GAS float* modv = (const GAS float*)(c.ws + WS_MODV);
    const GAS bf16* Y = (const GAS bf16*)(c.ws + WS_R3); GAS bf16* A1 = (GAS bf16*)(c.ws + WS_R1);
    const GAS int* smapL = (const GAS int*)(c.ws + WS_SMAP); const GAS int* smapC = smapL + 2 * 16 * 16384;
    GAS float* hctx = (GAS float*)(c.ws + WS_HCTX);
    const int nrows = (mode == 2) ? MLAT : MT;
    float dscale = 1.0f;
#if defined(TPROBE) || defined(TPROBE_UNIT)
    if (mode == 2) {
#if defined(TPROBE_UNIT)
        const unsigned su = __hip_atomic_load(c.ctl + CW_TS + 40, RLX_AGENT), cn = __hip_atomic_load(c.ctl + CW_TS + 41, RLX_AGENT);
        dscale = 1.0f + floorf((cn ? (float)su / (float)cn : 0.f) * (0.01f / TPQ) + 0.5f) * (TPQ / 1000.0f);
#else
        const unsigned ta = __hip_atomic_load(c.ctl + CW_TS + TPROBE, RLX_AGENT), tb = __hip_atomic_load(c.ctl + CW_TS + TPROBE + 1, RLX_AGENT);
        dscale = 1.0f + floorf((float)(tb - ta) * (0.01f / TPQ) + 0.5f) * (TPQ / 1000.0f);
#endif
    }
#endif
#define RP_LOAD_X(M0, DST) do { const int m0_ = (M0); const bool ic_ = m0_ >= MLAT; _Pragma("unroll") for (int q = 0; q < 4; ++q) { const int m_ = m0_ + q; \
        const GAS float* src_ = ic_ ? c.inp[I_CTX] + (size_t)(m_ - MLAT) * D : c.inp[I_X] + (size_t)m_ * D; \
        _Pragma("unroll") for (int j = 0; j < 4; ++j) DST[q][j] = *(const GAS f32x4*)(src_ + 4 * c.lane + 256 * j); } } while (0)
    f32x4 vnx[4][4];
    if (mode == 0 && gw * 4 < nrows) RP_LOAD_X(gw * 4, vnx);
    for (int m0 = gw * 4; m0 < nrows; m0 += NGW * 4) {
        const bool isctx = m0 >= MLAT; const int b = isctx ? ((m0 - MLAT) >> 8) : (m0 >> 14), mb = isctx ? 2 : b;
        f32x4 v[4][4];
        if (mode == 0) {
#pragma unroll
            for (int q = 0; q < 4; ++q)
#pragma unroll
                for (int j = 0; j < 4; ++j) v[q][j] = vnx[q][j];
            if (m0 + NGW * 4 < nrows) RP_LOAD_X(m0 + NGW * 4, vnx);
        } else
#pragma unroll
        for (int q = 0; q < 4; ++q) { const int m = m0 + q;
            if (mode != 0 && !isctx) { const GAS bf16* hb = (const GAS bf16*)c.out + (size_t)m * 2048;
#pragma unroll
                for (int j = 0; j < 4; ++j) { const u32x2 w = *(const GAS u32x2*)(hb + 4 * c.lane + 256 * j); v[q][j] = (f32x4){bf2f(w.x & 0xffffu), bf2f(w.x >> 16), bf2f(w.y & 0xffffu), bf2f(w.y >> 16)}; } }
            else { const GAS float* src = (mode == 0) ? (isctx ? c.inp[I_CTX] + (size_t)(m - MLAT) * D : c.inp[I_X] + (size_t)m * D) : hctx + (size_t)(m - MLAT) * D;
#pragma unroll
                for (int j = 0; j < 4; ++j) v[q][j] = *(const GAS f32x4*)(src + 4 * c.lane + 256 * j); } }
        if (mode != 0) {
            const GAS float* gff = modv + (size_t)((l - 1 + (mode == 2 ? 1 : 0)) * 3 + mb) * 6144 + 5 * 1024;
            f32x4 acc[4][4]; int myslot[4]; unsigned long long msk[4];
#pragma unroll
            for (int q = 0; q < 4; ++q) { const int m = m0 + q, t = isctx ? ((m - MLAT) & 255) : (m & 16383);
                myslot[q] = (c.lane < NE) ? (isctx ? smapC[(b * 16 + c.lane) * 256 + t] : smapL[(b * 16 + c.lane) * 16384 + t]) : -1;
#pragma unroll
                for (int j = 0; j < 4; ++j) acc[q][j] = (f32x4){0.f, 0.f, 0.f, 0.f}; }
#pragma unroll
            for (int q = 0; q < 4; ++q) msk[q] = __ballot(myslot[q] >= 0);
            while (msk[0] | msk[1] | msk[2] | msk[3]) {
                u32x2 w[4][4]; float f[4];
#pragma unroll
                for (int q = 0; q < 4; ++q) { const bool has = msk[q] != 0; const int e = has ? __builtin_ctzll(msk[q]) : 0; if (has) msk[q] &= msk[q] - 1;
                    const int sl = __shfl(myslot[q], e); f[q] = has ? 1.0f : 0.0f;
                    const size_t y = !has ? (size_t)0 : isctx ? (size_t)(XLAT + e * 256 + b * 32 + sl) : (size_t)((b * 16 + e) * CAPL + sl);
#pragma unroll
                    for (int j = 0; j < 4; ++j) w[q][j] = *(const GAS u32x2*)(Y + y * D + 4 * c.lane + 256 * j); }
#pragma unroll
                for (int q = 0; q < 4; ++q)
#pragma unroll
                    for (int j = 0; j < 4; ++j) acc[q][j] += (f32x4){bf2f(w[q][j].x & 0xffffu), bf2f(w[q][j].x >> 16), bf2f(w[q][j].y & 0xffffu), bf2f(w[q][j].y >> 16)} * f[q];
            }
#pragma unroll
            for (int q = 0; q < 4; ++q) { const int m = m0 + q;
#pragma unroll
                for (int j = 0; j < 4; ++j) { v[q][j] += *(const GAS f32x4*)(gff + 4 * c.lane + 256 * j) * acc[q][j];
                    if (mode == 2) *(GAS f32x4*)(c.out + (size_t)m * D + 4 * c.lane + 256 * j) = v[q][j] * dscale;
                    else if (isctx) *(GAS f32x4*)(hctx + (size_t)(m - MLAT) * D + 4 * c.lane + 256 * j) = v[q][j];
                    else { u32x2 w; w.x = pk2(v[q][j].x, v[q][j].y); w.y = pk2(v[q][j].z, v[q][j].w); *(GAS u32x2*)((GAS bf16*)c.out + (size_t)m * 2048 + 4 * c.lane + 256 * j) = w; } } }
        }
        if (mode == 2) continue;
        float rstd[4];
#pragma unroll
        for (int q = 0; q < 4; ++q) { float ss = 0.f;
#pragma unroll
            for (int j = 0; j < 4; ++j) ss += (v[q][j].x * v[q][j].x + v[q][j].y * v[q][j].y) + (v[q][j].z * v[q][j].z + v[q][j].w * v[q][j].w);
            rstd[q] = ss; }
#pragma unroll
        for (int o = 1; o < 64; o <<= 1) {
#pragma unroll
            for (int q = 0; q < 4; ++q) rstd[q] += __shfl_xor(rstd[q], o); }
#pragma unroll
        for (int q = 0; q < 4; ++q) rstd[q] = 1.0f / sqrtf(rstd[q] * (1.0f / D) + EPS);
        const GAS float* mo = modv + (size_t)(l * 3 + mb) * 6144; const GAS float* gn = c.inp[I_NMIXG] + l * D;
#pragma unroll
        for (int j = 0; j < 4; ++j) { const int col = 4 * c.lane + 256 * j;
            const f32x4 g = *(const GAS f32x4*)(gn + col), sh = *(const GAS f32x4*)(mo + col), sc = *(const GAS f32x4*)(mo + 1024 + col);
            const f32x4 gs = g * (sc + 1.0f);
#pragma unroll
            for (int q = 0; q < 4; ++q) { const f32x4 a = v[q][j] * rstd[q] * gs + sh;
                u32x2 w; w.x = pk2(a.x, a.y); w.y = pk2(a.z, a.w); *(GAS u32x2*)(A1 + (size_t)(m0 + q) * D + col) = w; } }
    }
}
#undef RP_LOAD_X

__device__ __forceinline__ f32x4 mfma16(bf16x8 a, bf16x8 b, f32x4 c) { return __builtin_amdgcn_mfma_f32_16x16x32_bf16(a, b, c, 0, 0, 0); }
__device__ __forceinline__ f32x16 mfma32(bf16x8 a, bf16x8 b, f32x16 c) { return __builtin_amdgcn_mfma_f32_32x32x16_bf16(a, b, c, 0, 0, 0); }

__device__ __forceinline__ void qk_prep_rows(const Ctx& c_, int l) { Ctx c = c_; asm volatile("" : "+s"(c.ws), "+s"(c.inp), "+s"(c.out), "+v"(c.tid)); c.lane = c.tid & 63; asm volatile("" : "+s"(l));
    bf16* P = (bf16*)(c.ws + WS_R2); const GAS f32x2* ROPE = (const GAS f32x2*)(c.ws + WS_ROPE);
    const int j = c.lane & 7, rsub = c.lane >> 4, chunk = c.lane & 15;
    const f32x4 kg0 = *(const GAS f32x4*)(c.inp[I_KNG] + l * 64 + 8 * j), kg1 = *(const GAS f32x4*)(c.inp[I_KNG] + l * 64 + 8 * j + 4);
    const float kgn[8] = {kg0[0], kg0[1], kg0[2], kg0[3], kg1[0], kg1[1], kg1[2], kg1[3]};
#pragma unroll 2
    for (int blk = c.vcu * NWAVES + c.wave; blk < MT / 4; blk += c.G * NWAVES) {
        const int m = blk * 4 + rsub;
        const bool isctx = m >= MLAT;
        bf16* kp = P + (size_t)m * INW + 512 + 8 * chunk;
        const v4u w = *(const GAS v4u*)kp; const unsigned ws4[4] = {w.x, w.y, w.z, w.w};
        float cs[8], sn[8];
        if (!isctx) { const int n = m & 16383, pos = (j < 4) ? (n >> 6) : (n & 63); const GAS f32x4* tp = (const GAS f32x4*)(ROPE + pos * 16 + 8 * (j & 1));
#pragma unroll
            for (int q = 0; q < 4; ++q) { const f32x4 t4 = tp[q]; cs[2 * q] = t4[0]; sn[2 * q] = t4[1]; cs[2 * q + 1] = t4[2]; sn[2 * q + 1] = t4[3]; } }
        else {
#pragma unroll
            for (int e = 0; e < 8; ++e) { cs[e] = 1.f; sn[e] = 0.f; } }
        float x[8]; float ss = 0.f;
#pragma unroll
        for (int e = 0; e < 8; ++e) { x[e] = __uint_as_float((e & 1) ? (ws4[e >> 1] & 0xffff0000u) : (ws4[e >> 1] << 16)); ss += x[e] * x[e]; }
        ss += __shfl_xor(ss, 1); ss += __shfl_xor(ss, 2); ss += __shfl_xor(ss, 4);
        const float rstd = 1.0f / sqrtf(ss * (1.0f / 64.0f) + EPS);
        float o[8];
#pragma unroll
        for (int e = 0; e < 8; ++e) { const float xn = x[e] * rstd * kgn[e]; const float pr = __shfl_xor(xn, 2);
            o[e] = (j & 2) ? (xn * cs[e] + pr * sn[e]) : (xn * cs[e] - pr * sn[e]); }
        v4u ow; ow.x = pk2(o[0], o[1]); ow.y = pk2(o[2], o[3]); ow.z = pk2(o[4], o[5]); ow.w = pk2(o[6], o[7]);
        *(GAS v4u*)kp = ow;
    }
}
__device__ __forceinline__ int s5_scan_sc(int q, int b, int d) { return q < 16 ? (2048 + 16 * b + (d ? 15 - q : q)) : (b * 1024 + (d ? 1039 - q : q - 16)); }
__device__ __forceinline__ void s5_scan_unit(const Ctx& c_, int l, int unit) { Ctx c = c_; asm volatile("" : "+s"(c.ws), "+s"(c.inp), "+s"(c.out), "+v"(c.tid)); c.lane = c.tid & 63; asm volatile("" : "+s"(l));
    const int g = unit & 15, d = (unit >> 4) & 1, b = unit >> 5;
    const GAS float* E = (const GAS float*)(c.ws + WS_R2 + OFF_E) + (size_t)g * 2304 * 256 + d * 128 + 2 * c.lane;
    bf16* Am = (bf16*)(c.ws + WS_R1 + OFF_AMAT) + (size_t)g * 2304 * 512 + 256 + d * 128 + 2 * c.lane;
    const GAS f32x2* POW = (const GAS f32x2*)(c.ws + WS_POW) + (size_t)(((l * 2 + d) * 16 + g) * 64 + c.lane) * POWS;
    const f32x2 a16 = POW[16], aseg = POW[18];
    LAS f32x2* X = (LAS f32x2*)(c.lds + RING_OFF);
    const int q0 = 130 * c.wave;
    float hr = 0.f, hi = 0.f;
#pragma unroll 1
    for (int s0 = 0; s0 < 130; s0 += 26) {
        f32x2 e[26];
#pragma unroll
        for (int j = 0; j < 26; ++j) e[j] = *(const GAS f32x2*)(E + (size_t)s5_scan_sc(q0 + s0 + j, b, d) * 256);
#pragma unroll
        for (int j = 0; j < 26; ++j) { const float nr = a16.x * hr - a16.y * hi + e[j].x, ni = a16.x * hi + a16.y * hr + e[j].y; hr = nr; hi = ni; }
    }
    __syncthreads();
    X[c.wave * 64 + c.lane] = (f32x2){hr, hi};
    LDS_WAIT(); __syncthreads();
    hr = 0.f; hi = 0.f;
    for (int w = 0; w < c.wave; ++w) { const f32x2 x = X[w * 64 + c.lane]; const float nr = aseg.x * hr - aseg.y * hi + x.x, ni = aseg.x * hi + aseg.y * hr + x.y; hr = nr; hi = ni; }
#pragma unroll 1
    for (int s0 = 0; s0 < 130; s0 += 26) {
        f32x2 e[26];
#pragma unroll
        for (int j = 0; j < 26; ++j) e[j] = *(const GAS f32x2*)(E + (size_t)s5_scan_sc(q0 + s0 + j, b, d) * 256);
#pragma unroll
        for (int j = 0; j < 26; ++j) { *(GAS unsigned*)(Am + (size_t)s5_scan_sc(q0 + s0 + j, b, d) * 512) = pk2(hr, hi);
            const float nr = a16.x * hr - a16.y * hi + e[j].x, ni = a16.x * hi + a16.y * hr + e[j].y; hr = nr; hi = ni; }
    }
}

constexpr int ATT_ROWB = 144;
constexpr int ATT_TILEB = 64 * ATT_ROWB, ATT_BUFB = 4 * ATT_TILEB;
constexpr float ATT_SUMMAX = 1099511627776.0f;
template <bool FAST> __device__ __forceinline__ bool attn_unit_t(const Ctx& c_, int l, int unit) { Ctx c = c_; asm volatile("" : "+s"(c.ws), "+s"(c.inp), "+s"(c.out), "+v"(c.tid)); c.lane = c.tid & 63; asm volatile("" : "+s"(l));
    const GAS bf16* P = (const GAS bf16*)(c.ws + WS_R2); GAS bf16* mix = (GAS bf16*)(c.ws + WS_R1);
    int b, kvh, qb; bool isctx;
    if (unit < 512) { b = unit >> 8; kvh = (unit >> 7) & 1; qb = unit & 127; isctx = false; }
    else { const int u2 = unit - 512; b = u2 >> 2; kvh = (u2 >> 1) & 1; qb = u2 & 1; isctx = true; }
    const int r32 = c.lane & 31, hi = c.lane >> 5, wsub = c.wave >> 2;
    const int hq = kvh * 4 + (c.wave & 3);
    const float sink2 = c.inp[I_SINK][l * 8 + hq] * LOG2E;
    const int q4 = (c.lane & 15) >> 2, p4 = c.lane & 3, d0 = 16 * ((c.lane >> 4) & 1);
    const int vlane_off = (4 * hi + q4) * ATT_ROWB + (d0 + 4 * p4) * 2;
    const int qrow0 = (isctx ? (MLAT + b * LC + qb * 128) : (b * SEQ + qb * 128)) + 64 * wsub + r32;
    const int key = c.tid >> 3, chk = c.tid & 7;
    int p = isctx ? 3 : 0;
    while (p < 3 && (128 * (qb - 1 + p) < 0 || 128 * (qb - 1 + p) >= SEQ)) ++p;
    int pn = p + 1;
    while (pn < 3 && (128 * (qb - 1 + pn) < 0 || 128 * (qb - 1 + pn) >= SEQ)) ++pn;
    v4u kv[2], vv[2];
#define ATT_LOAD(PP) do { const int krow_ = ((PP) < 3 ? b * SEQ + 128 * (qb - 1 + (PP)) : MLAT + b * LC + 128 * ((PP) - 3)) + key; const GAS bf16* src_ = P + (size_t)krow_ * INW + 64 * kvh + 8 * chk; \
        kv[0] = *(const GAS v4u*)(src_ + 512); vv[0] = *(const GAS v4u*)(src_ + 640); kv[1] = *(const GAS v4u*)(src_ + 64 * INW + 512); vv[1] = *(const GAS v4u*)(src_ + 64 * INW + 640); } while (0)
#define ATT_STORE(BUF) do { LAS unsigned char* d_ = c.lds + (BUF) * ATT_BUFB + key * ATT_ROWB + chk * 16; \
        *(LAS v4u*)(d_) = kv[0]; *(LAS v4u*)(d_ + ATT_TILEB) = kv[1]; *(LAS v4u*)(d_ + 2 * ATT_TILEB) = vv[0]; *(LAS v4u*)(d_ + 3 * ATT_TILEB) = vv[1]; } while (0)
    ATT_LOAD(p);
    bf16x8 qf[2][4];
#pragma unroll
    for (int qg = 0; qg < 2; ++qg)
#pragma unroll
        for (int ks = 0; ks < 4; ++ks) qf[qg][ks] = *(const GAS bf16x8*)(P + (size_t)(qrow0 + 32 * qg) * INW + 64 * hq + 16 * ks + 8 * hi);
    { const GAS f32x2* ROPE = (const GAS f32x2*)(c.ws + WS_ROPE);
      float qgn[4][8];
#pragma unroll
      for (int ks = 0; ks < 4; ++ks) { const f32x4 g0 = *(const GAS f32x4*)(c.inp[I_QNG] + l * 64 + 16 * ks + 8 * hi), g1 = *(const GAS f32x4*)(c.inp[I_QNG] + l * 64 + 16 * ks + 8 * hi + 4);
          qgn[ks][0] = g0[0]; qgn[ks][1] = g0[1]; qgn[ks][2] = g0[2]; qgn[ks][3] = g0[3]; qgn[ks][4] = g1[0]; qgn[ks][5] = g1[1]; qgn[ks][6] = g1[2]; qgn[ks][7] = g1[3]; }
#pragma unroll
      for (int qg = 0; qg < 2; ++qg) {
          float x[4][8]; float ss = 0.f;
#pragma unroll
          for (int ks = 0; ks < 4; ++ks) { const v4u w = __builtin_bit_cast(v4u, qf[qg][ks]); const unsigned ws4[4] = {w.x, w.y, w.z, w.w};
#pragma unroll
              for (int e = 0; e < 8; ++e) { x[ks][e] = __uint_as_float((e & 1) ? (ws4[e >> 1] & 0xffff0000u) : (ws4[e >> 1] << 16)); ss += x[ks][e] * x[ks][e]; } }
          ss += __shfl_xor(ss, 32);
          const float rstd = 1.0f / sqrtf(ss * (1.0f / 64.0f) + EPS) * (0.125f * LOG2E);
#pragma unroll
          for (int ks = 0; ks < 4; ++ks)
#pragma unroll
              for (int e = 0; e < 8; ++e) x[ks][e] *= rstd * qgn[ks][e];
          if (!isctx) { const int n = qb * 128 + 64 * wsub + 32 * qg + r32;
#pragma unroll
              for (int ax = 0; ax < 2; ++ax) { const int pos = ax == 0 ? (n >> 6) : (n & 63); const GAS f32x4* tp = (const GAS f32x4*)(ROPE + pos * 16 + 8 * hi);
#pragma unroll
                  for (int q = 0; q < 4; ++q) { const f32x4 t4 = tp[q];
#pragma unroll
                      for (int h2 = 0; h2 < 2; ++h2) { const int e = 2 * q + h2; const float cs = t4[2 * h2], sn = t4[2 * h2 + 1];
                          const float x1 = x[2 * ax][e], x2 = x[2 * ax + 1][e]; x[2 * ax][e] = x1 * cs - x2 * sn; x[2 * ax + 1][e] = x2 * cs + x1 * sn; } } } }
#pragma unroll
          for (int ks = 0; ks < 4; ++ks) { v4u w; w.x = pk2(x[ks][0], x[ks][1]); w.y = pk2(x[ks][2], x[ks][3]); w.z = pk2(x[ks][4], x[ks][5]); w.w = pk2(x[ks][6], x[ks][7]); qf[qg][ks] = __builtin_bit_cast(bf16x8, w); }
      } }
    float m_run[2], l_run[2]; f32x16 o[2][2];
    const float sinkp = __builtin_amdgcn_exp2f(sink2); bool bad = FAST && !(sinkp <= 3.0e38f);
#pragma unroll
    for (int qg = 0; qg < 2; ++qg) { m_run[qg] = FAST ? 0.f : sink2; l_run[qg] = hi == 0 ? (FAST ? sinkp : 1.0f) : 0.0f;
#pragma unroll
        for (int dt = 0; dt < 2; ++dt)
#pragma unroll
            for (int r = 0; r < 16; ++r) o[qg][dt][r] = 0.f; }
    if (FAST && c.tid == 0) c.MISC[24] = 0u;
    __syncthreads();
    ATT_STORE(0);
    if (pn < 5) ATT_LOAD(pn);
    LDS_WAIT(); __syncthreads();
    int cur = 0;
#pragma unroll 1
    while (p < 5) {
        int pnn = pn + 1;
        while (pnn < 3 && (128 * (qb - 1 + pnn) < 0 || 128 * (qb - 1 + pnn) >= SEQ)) ++pnn;
        if (pn < 5) { ATT_STORE(cur ^ 1); if (pnn < 5) ATT_LOAD(pnn); }
        const bool win = p < 3;
#pragma unroll (FAST ? 2 : 1)
        for (int sb = 0; sb < 2; ++sb) {
            const int t = 2 * p + sb;
            LAS unsigned char* kbase = c.lds + cur * ATT_BUFB + sb * ATT_TILEB; LAS unsigned char* vbase = kbase + 2 * ATT_TILEB;
            bool skip[2] = {false, false}, need_mask[2] = {false, false};
            if (win) {
    #pragma unroll
                for (int qg = 0; qg < 2; ++qg) { const int qlo = 128 * qb + 64 * wsub + 32 * qg, klo = 128 * (qb - 1) + 64 * t, dmax = klo + 63 - qlo, dmin = klo - qlo - 31;
                    skip[qg] = dmin > 128 || dmax < -128; need_mask[qg] = dmax > 128 || dmin < -128; } }
            if (!(skip[0] && skip[1])) {
                bf16x8 kf[8];
    #pragma unroll
                for (int ks = 0; ks < 4; ++ks) { kf[2 * ks] = *(const LAS bf16x8*)(kbase + r32 * ATT_ROWB + (16 * ks + 8 * hi) * 2);
                    kf[2 * ks + 1] = *(const LAS bf16x8*)(kbase + (32 + r32) * ATT_ROWB + (16 * ks + 8 * hi) * 2); }
                bf16x8 pf[2][4];
    #pragma unroll
                for (int qg = 0; qg < 2; ++qg) {
                    if (!skip[qg]) {
                        f32x16 s0, s1; { const float nm = FAST ? 0.f : -m_run[qg];
    #pragma unroll
                            for (int r = 0; r < 16; ++r) { s0[r] = nm; s1[r] = nm; } }
    #pragma unroll
                        for (int ks = 0; ks < 4; ++ks) { s0 = mfma32(kf[2 * ks], qf[qg][ks], s0); s1 = mfma32(kf[2 * ks + 1], qf[qg][ks], s1); }
                        if (need_mask[qg]) {
                            const int qp = 128 * qb + 64 * wsub + 32 * qg + r32, kb = 128 * (qb - 1) + 64 * t + 4 * hi;
    #pragma unroll
                            for (int r = 0; r < 16; ++r) { const int dk = kb + (r & 3) + 8 * (r >> 2) - qp;
                                if (dk > 128 || dk < -128) s0[r] = -INFINITY;
                                if (dk + 32 > 128 || dk + 32 < -128) s1[r] = -INFINITY; }
                        }
                        if constexpr (FAST) {
                            float sm[4] = {0.f, 0.f, 0.f, 0.f};
    #pragma unroll
                            for (int r = 0; r < 16; ++r) { s0[r] = __builtin_amdgcn_exp2f(s0[r]); s1[r] = __builtin_amdgcn_exp2f(s1[r]); float t2 = s0[r] + s1[r]; asm("" : "+v"(t2)); sm[r & 3] = r < 4 ? t2 : sm[r & 3] + t2; asm("" : "+v"(sm[r & 3])); }
                            const float st = (sm[0] + sm[1]) + (sm[2] + sm[3]);
                            bad = bad || !(st <= ATT_SUMMAX);
                            l_run[qg] += st;
    #pragma unroll
                            for (int s2 = 0; s2 < 2; ++s2) {
                                v4u pw; pw.x = pk2(s0[8 * s2 + 0], s0[8 * s2 + 1]); pw.y = pk2(s0[8 * s2 + 2], s0[8 * s2 + 3]); pw.z = pk2(s0[8 * s2 + 4], s0[8 * s2 + 5]); pw.w = pk2(s0[8 * s2 + 6], s0[8 * s2 + 7]);
                                pf[qg][s2] = __builtin_bit_cast(bf16x8, pw);
                                v4u pv; pv.x = pk2(s1[8 * s2 + 0], s1[8 * s2 + 1]); pv.y = pk2(s1[8 * s2 + 2], s1[8 * s2 + 3]); pv.z = pk2(s1[8 * s2 + 4], s1[8 * s2 + 5]); pv.w = pk2(s1[8 * s2 + 6], s1[8 * s2 + 7]);
                                pf[qg][2 + s2] = __builtin_bit_cast(bf16x8, pv); }
                        } else {
                        f32x16 e0, e1; float st;
                        { float sm[4] = {0.f, 0.f, 0.f, 0.f};
    #pragma unroll
                          for (int r = 0; r < 16; ++r) { e0[r] = __builtin_amdgcn_exp2f(s0[r]); e1[r] = __builtin_amdgcn_exp2f(s1[r]); float t2 = e0[r] + e1[r]; asm("" : "+v"(t2)); sm[r & 3] = r < 4 ? t2 : sm[r & 3] + t2; asm("" : "+v"(sm[r & 3])); }
                          st = (sm[0] + sm[1]) + (sm[2] + sm[3]); }
                        if (__any(!(st <= ATT_SUMMAX))) {
                            float mxa[8];
    #pragma unroll
                            for (int i = 0; i < 8; ++i) mxa[i] = fmaxf(fmaxf(s0[i], s0[i + 8]), fmaxf(s1[i], s1[i + 8]));
                            float mx = fmaxf(fmaxf(fmaxf(mxa[0], mxa[1]), fmaxf(mxa[2], mxa[3])), fmaxf(fmaxf(mxa[4], mxa[5]), fmaxf(mxa[6], mxa[7])));
                            mx = fmaxf(mx, __shfl_xor(mx, 32));
                            const float dl = fmaxf(mx, 0.f), alpha = __builtin_amdgcn_exp2f(-dl);
                            m_run[qg] += dl; l_run[qg] *= alpha;
    #pragma unroll
                            for (int dt = 0; dt < 2; ++dt)
    #pragma unroll
                                for (int r = 0; r < 16; ++r) o[qg][dt][r] *= alpha;
                            float sm[4] = {0.f, 0.f, 0.f, 0.f};
    #pragma unroll
                            for (int r = 0; r < 16; ++r) { e0[r] = __builtin_amdgcn_exp2f(s0[r] - dl); e1[r] = __builtin_amdgcn_exp2f(s1[r] - dl); sm[r & 3] += e0[r] + e1[r]; }
                            st = (sm[0] + sm[1]) + (sm[2] + sm[3]);
                        }
                        l_run[qg] += st;
    #pragma unroll
                        for (int s2 = 0; s2 < 2; ++s2) {
                            v4u pw; pw.x = pk2(e0[8 * s2 + 0], e0[8 * s2 + 1]); pw.y = pk2(e0[8 * s2 + 2], e0[8 * s2 + 3]); pw.z = pk2(e0[8 * s2 + 4], e0[8 * s2 + 5]); pw.w = pk2(e0[8 * s2 + 6], e0[8 * s2 + 7]);
                            pf[qg][s2] = __builtin_bit_cast(bf16x8, pw);
                            v4u pv; pv.x = pk2(e1[8 * s2 + 0], e1[8 * s2 + 1]); pv.y = pk2(e1[8 * s2 + 2], e1[8 * s2 + 3]); pv.z = pk2(e1[8 * s2 + 4], e1[8 * s2 + 5]); pv.w = pk2(e1[8 * s2 + 6], e1[8 * s2 + 7]);
                            pf[qg][2 + s2] = __builtin_bit_cast(bf16x8, pv); }
                        }
                    } else {
    #pragma unroll
                        for (int i = 0; i < 4; ++i) pf[qg][i] = (bf16x8){0, 0, 0, 0, 0, 0, 0, 0};
                    }
                }
                bf16x8 vf[2][4];
    #pragma unroll
                for (int dt = 0; dt < 2; ++dt)
    #pragma unroll
                    for (int ks4 = 0; ks4 < 4; ++ks4) {
                        LAS unsigned char* vp = vbase + (16 * ks4) * ATT_ROWB + 64 * dt + vlane_off;
                        const v4i16_t lo = __builtin_amdgcn_ds_read_tr16_b64_v4i16((LAS v4i16_t*)vp);
                        const v4i16_t h8 = __builtin_amdgcn_ds_read_tr16_b64_v4i16((LAS v4i16_t*)(vp + 8 * ATT_ROWB));
                        vf[dt][ks4] = (bf16x8){lo[0], lo[1], lo[2], lo[3], h8[0], h8[1], h8[2], h8[3]}; }
    #pragma unroll
                for (int ks4 = 0; ks4 < 4; ++ks4)
    #pragma unroll
                    for (int dt = 0; dt < 2; ++dt)
    #pragma unroll
                        for (int qg = 0; qg < 2; ++qg) o[qg][dt] = mfma32(vf[dt][ks4], pf[qg][ks4], o[qg][dt]);
            }
        }
        LDS_WAIT(); __syncthreads();
        p = pn; pn = pnn; cur ^= 1;
    }
#undef ATT_LOAD
#undef ATT_STORE
    if constexpr (FAST) {
        if (__any(bad) && c.lane == 0) c.MISC[24] = 1u;
        LDS_WAIT(); __syncthreads();
        if (c.MISC[24] != 0u) return true;
    }
#pragma unroll
    for (int qg = 0; qg < 2; ++qg) {
        const float lt = l_run[qg] + __shfl_xor(l_run[qg], 32), il = 1.0f / lt;
        GAS bf16* orow = mix + (size_t)(qrow0 + 32 * qg) * D + 64 * hq + 4 * hi;
#pragma unroll
        for (int dt = 0; dt < 2; ++dt)
#pragma unroll
            for (int rr = 0; rr < 4; ++rr) { u32x2 w; w.x = pk2(o[qg][dt][4 * rr] * il, o[qg][dt][4 * rr + 1] * il); w.y = pk2(o[qg][dt][4 * rr + 2] * il, o[qg][dt][4 * rr + 3] * il);
                *(GAS u32x2*)(orow + 32 * dt + 8 * rr) = w; }
    }
    return false;
}

constexpr int SGU_ROWB = 528;
__device__ __forceinline__ void sgu_unit(const Ctx& c_, int l, int chunk) { Ctx c = c_; asm volatile("" : "+s"(c.ws), "+s"(c.inp), "+s"(c.out), "+v"(c.tid)); c.lane = c.tid & 63; asm volatile("" : "+s"(l));
    const bf16* P = (const bf16*)(c.ws + WS_R2); bf16* mix = (bf16*)(c.ws + WS_R1);
    const bf16* Ws = (const bf16*)(c.ws + WS_WSGU) + (size_t)l * 4 * 128 * 128;
    const int r0 = chunk * 128, fr = c.lane & 15, fq = c.lane >> 4;
    __syncthreads();
    { const f32x4 gn = *(const GAS f32x4*)(c.inp[I_SGUNG] + l * 256 + 4 * c.lane);
#pragma unroll 1
      for (int r4 = 0; r4 < 16; r4 += 4) {
        u32x2 w[4]; float v[4][4], ss[4];
#pragma unroll
        for (int q = 0; q < 4; ++q) w[q] = *(const GAS u32x2*)(P + (size_t)(r0 + c.wave * 16 + r4 + q) * INW + 1280 + 4 * c.lane);
#pragma unroll
        for (int q = 0; q < 4; ++q) { v[q][0] = gelu_tanh(bf2f(w[q].x & 0xffffu)); v[q][1] = gelu_tanh(bf2f(w[q].x >> 16)); v[q][2] = gelu_tanh(bf2f(w[q].y & 0xffffu)); v[q][3] = gelu_tanh(bf2f(w[q].y >> 16));
            ss[q] = (v[q][0] * v[q][0] + v[q][1] * v[q][1]) + (v[q][2] * v[q][2] + v[q][3] * v[q][3]); }
#pragma unroll
        for (int o = 1; o < 64; o <<= 1) {
#pragma unroll
            for (int q = 0; q < 4; ++q) ss[q] += __shfl_xor(ss[q], o); }
#pragma unroll
        for (int q = 0; q < 4; ++q) { const int s = c.wave * 16 + r4 + q; const float rstd = 1.0f / sqrtf(ss[q] * (1.0f / 256.0f) + EPS);
            u32x2 ow; ow.x = pk2(v[q][0] * rstd * gn.x, v[q][1] * rstd * gn.y); ow.y = pk2(v[q][2] * rstd * gn.z, v[q][3] * rstd * gn.w);
            *(LAS u32x2*)(c.lds + s * SGU_ROWB + 8 * c.lane) = ow; } } }
    LDS_WAIT(); __syncthreads();
    const int gg = c.wave >> 1, th = c.wave & 1;
    bf16x8 a[4][4];
#pragma unroll
    for (int mt = 0; mt < 4; ++mt)
#pragma unroll
        for (int ks = 0; ks < 4; ++ks) a[mt][ks] = *(const GAS bf16x8*)(Ws + ((size_t)gg * 128 + 64 * th + 16 * mt + fr) * 128 + 32 * ks + 8 * fq);
    u32x2 uw[4][4]; float bsv[4];
#pragma unroll
    for (int mt = 0; mt < 4; ++mt) { const int t = 64 * th + 16 * mt + fr; bsv[mt] = c.inp[I_SGUB][(l * 4 + gg) * 128 + t];
#pragma unroll
        for (int nt = 0; nt < 4; ++nt) uw[nt][mt] = *(const GAS u32x2*)(P + (size_t)(r0 + t) * INW + 1024 + 64 * gg + 16 * nt + 4 * fq); }
#pragma unroll
    for (int nt = 0; nt < 4; ++nt) {
        f32x4 acc[4];
#pragma unroll
        for (int mt = 0; mt < 4; ++mt) acc[mt] = (f32x4){0.f, 0.f, 0.f, 0.f};
#pragma unroll
        for (int ks = 0; ks < 4; ++ks) {
            LAS unsigned char* vp = c.lds + (32 * ks + 8 * fq + (fr >> 2)) * SGU_ROWB + (64 * gg + 16 * nt + 4 * (fr & 3)) * 2;
            const v4i16_t lo = __builtin_amdgcn_ds_read_tr16_b64_v4i16((LAS v4i16_t*)vp);
            const v4i16_t h8 = __builtin_amdgcn_ds_read_tr16_b64_v4i16((LAS v4i16_t*)(vp + 4 * SGU_ROWB));
            const bf16x8 bfr = (bf16x8){lo[0], lo[1], lo[2], lo[3], h8[0], h8[1], h8[2], h8[3]};
#pragma unroll
            for (int mt = 0; mt < 4; ++mt) acc[mt] = mfma16(bfr, a[mt][ks], acc[mt]); }
#pragma unroll
        for (int mt = 0; mt < 4; ++mt) { const int t = 64 * th + 16 * mt + fr, ch = 64 * gg + 16 * nt + 4 * fq;
            const float bs = bsv[mt]; const u32x2 w = uw[nt][mt];
            const float u0 = gelu_tanh(bf2f(w.x & 0xffffu)), u1 = gelu_tanh(bf2f(w.x >> 16)), u2 = gelu_tanh(bf2f(w.y & 0xffffu)), u3 = gelu_tanh(bf2f(w.y >> 16));
            u32x2 ow; ow.x = pk2(u0 * (acc[mt][0] + bs), u1 * (acc[mt][1] + bs)); ow.y = pk2(u2 * (acc[mt][2] + bs), u3 * (acc[mt][3] + bs));
            *(GAS u32x2*)(mix + (size_t)(r0 + t) * D + 768 + ch) = ow; }
    }
}

constexpr int RW_PITCH = 1040;
__device__ __forceinline__ void ffn_prep(const Ctx& c_, int l, int nrows) { Ctx c = c_; asm volatile("" : "+s"(c.ws), "+s"(c.inp), "+s"(c.out), "+v"(c.tid)); c.lane = c.tid & 63; asm volatile("" : "+s"(l));
    const int gw = c.vcu * NWAVES + c.wave, NGW = c.G * NWAVES;
    const GAS float* modv = (const GAS float*)(c.ws + WS_MODV); bf16* F = (bf16*)(c.ws + WS_R3 + 66 * MiB);
    float* probsL = (float*)(c.ws + WS_PROBS); float* probsC = probsL + 2 * 16 * 16384;
    const GAS float* hctx = (const GAS float*)(c.ws + WS_HCTX); const GAS float* rw = c.inp[I_ROUTW] + (size_t)l * D * NE;
    __syncthreads();
    { f32x4 rv[8];
#pragma unroll
      for (int r = 0; r < 8; ++r) rv[r] = *(const GAS f32x4*)(rw + 4 * (c.tid + 512 * r));
#pragma unroll
      for (int r = 0; r < 8; ++r) { const int idx = 4 * (c.tid + 512 * r), k = idx >> 4, e = idx & 15, L = (k & 255) >> 2, j = k >> 8, i = k & 3;
        *(LAS f32x4*)(c.lds + L * RW_PITCH + ((j * 4 + i) * 16 + e) * 4) = rv[r]; } }
    LDS_WAIT(); __syncthreads();
    const GAS float* gn = c.inp[I_NFFNG] + l * D;
    const int myexp = ((c.lane & 1) << 3) | (((c.lane >> 1) & 1) << 2) | (((c.lane >> 2) & 1) << 1) | ((c.lane >> 3) & 1);
#define FFN_LOAD_RAW(BLK, DST) do { _Pragma("unroll") for (int q = 0; q < 4; ++q) { const GAS bf16* hb_ = (const GAS bf16*)c.out + (size_t)((BLK) * 4 + q) * 2048; \
            _Pragma("unroll") for (int j = 0; j < 4; ++j) DST[q][j] = *(const GAS u32x2*)(hb_ + 4 * c.lane + 256 * j); } } while (0)
    u32x2 wn[4][4];
    if (gw < nrows / 4 && gw * 4 < MLAT) FFN_LOAD_RAW(gw, wn);
    for (int blk = gw; blk < nrows / 4; blk += NGW) {
        const int m0 = blk * 4; const bool isctx = m0 >= MLAT; const int b = isctx ? ((m0 - MLAT) >> 8) : (m0 >> 14), mb = isctx ? 2 : b;
        const GAS float* mo = modv + (size_t)(l * 3 + mb) * 6144;
        f32x4 gsc[4], sh[4];
#pragma unroll
        for (int j = 0; j < 4; ++j) { const int col = 4 * c.lane + 256 * j; gsc[j] = *(const GAS f32x4*)(gn + col) * (*(const GAS f32x4*)(mo + 4 * 1024 + col) + 1.0f); sh[j] = *(const GAS f32x4*)(mo + 3 * 1024 + col); }
#pragma unroll 1
        for (int r4 = 0; r4 < 4; r4 += 4) { asm volatile("" ::: "memory");
            f32x4 v[4][4]; float rstd[4];
#pragma unroll
            for (int q = 0; q < 4; ++q) { const int m = m0 + r4 + q;
                if (isctx) { const GAS float* src = hctx + (size_t)(m - MLAT) * D;
#pragma unroll
                    for (int j = 0; j < 4; ++j) v[q][j] = *(const GAS f32x4*)(src + 4 * c.lane + 256 * j); }
                else {
#pragma unroll
                    for (int j = 0; j < 4; ++j) { const u32x2 w = wn[q][j]; v[q][j] = (f32x4){bf2f(w.x & 0xffffu), bf2f(w.x >> 16), bf2f(w.y & 0xffffu), bf2f(w.y >> 16)}; } } }
            if (blk + NGW < nrows / 4 && (blk + NGW) * 4 < MLAT) FFN_LOAD_RAW(blk + NGW, wn);
#pragma unroll
            for (int q = 0; q < 4; ++q) { float ss = 0.f;
#pragma unroll
                for (int j = 0; j < 4; ++j) ss += (v[q][j].x * v[q][j].x + v[q][j].y * v[q][j].y) + (v[q][j].z * v[q][j].z + v[q][j].w * v[q][j].w);
                rstd[q] = ss; }
#pragma unroll
            for (int o = 1; o < 64; o <<= 1) {
#pragma unroll
                for (int q = 0; q < 4; ++q) rstd[q] += __shfl_xor(rstd[q], o); }
#pragma unroll
            for (int q = 0; q < 4; ++q) rstd[q] = 1.0f / sqrtf(rstd[q] * (1.0f / D) + EPS);
            float lg[4][16];
#pragma unroll
            for (int q = 0; q < 4; ++q)
#pragma unroll
                for (int e = 0; e < 16; ++e) lg[q][e] = 0.f;
#pragma unroll
            for (int j = 0; j < 4; ++j) {
#pragma unroll
                for (int q = 0; q < 4; ++q) { v[q][j] = v[q][j] * rstd[q] * gsc[j] + sh[j];
                    u32x2 w; w.x = pk2(v[q][j].x, v[q][j].y); w.y = pk2(v[q][j].z, v[q][j].w); *(GAS u32x2*)(F + (size_t)(m0 + r4 + q) * D + 4 * c.lane + 256 * j) = w; }
#pragma unroll
                for (int i = 0; i < 4; ++i) { const LAS f32x4* rp = (const LAS f32x4*)(c.lds + c.lane * RW_PITCH + (j * 4 + i) * 64);
#pragma unroll
                    for (int k4 = 0; k4 < 4; ++k4) { const f32x4 w4 = rp[k4];
#pragma unroll
                        for (int q = 0; q < 4; ++q) { const float ai = v[q][j][i]; lg[q][4 * k4] += ai * w4.x; lg[q][4 * k4 + 1] += ai * w4.y; lg[q][4 * k4 + 2] += ai * w4.z; lg[q][4 * k4 + 3] += ai * w4.w; } } } }
            float lgt[4];
#pragma unroll
            for (int q = 0; q < 4; ++q) {
                float r8[8];
#pragma unroll
                for (int i = 0; i < 8; ++i) { const bool up = c.lane & 1; const float keep = up ? lg[q][i + 8] : lg[q][i], send = up ? lg[q][i] : lg[q][i + 8]; r8[i] = keep + __shfl_xor(send, 1); }
                float r4v[4];
#pragma unroll
                for (int i = 0; i < 4; ++i) { const bool up = c.lane & 2; const float keep = up ? r8[i + 4] : r8[i], send = up ? r8[i] : r8[i + 4]; r4v[i] = keep + __shfl_xor(send, 2); }
                float r2[2];
#pragma unroll
                for (int i = 0; i < 2; ++i) { const bool up = c.lane & 4; const float keep = up ? r4v[i + 2] : r4v[i], send = up ? r4v[i] : r4v[i + 2]; r2[i] = keep + __shfl_xor(send, 4); }
                { const bool up = c.lane & 8; const float keep = up ? r2[1] : r2[0], send = up ? r2[0] : r2[1]; lgt[q] = keep + __shfl_xor(send, 8); }
            }
#pragma unroll
            for (int o = 16; o < 64; o <<= 1) {
#pragma unroll
                for (int q = 0; q < 4; ++q) lgt[q] += __shfl_xor(lgt[q], o); }
            float mx[4], ex[4], den[4];
#pragma unroll
            for (int q = 0; q < 4; ++q) mx[q] = lgt[q];
#pragma unroll
            for (int o = 1; o < 16; o <<= 1) {
#pragma unroll
                for (int q = 0; q < 4; ++q) mx[q] = fmaxf(mx[q], __shfl_xor(mx[q], o)); }
#pragma unroll
            for (int q = 0; q < 4; ++q) { ex[q] = expf(lgt[q] - mx[q]); den[q] = ex[q]; }
#pragma unroll
            for (int o = 1; o < 16; o <<= 1) {
#pragma unroll
                for (int q = 0; q < 4; ++q) den[q] += __shfl_xor(den[q], o); }
            if (c.lane < 16) {
#pragma unroll
                for (int q = 0; q < 4; ++q) { const int m = m0 + r4 + q; const int t = isctx ? ((m - MLAT) & 255) : (m & 16383); const float pr = ex[q] / den[q];
                    if (isctx) probsC[(b * 16 + myexp) * 256 + t] = pr; else probsL[(b * 16 + myexp) * 16384 + t] = pr; } }
        }
    }
}

#undef FFN_LOAD_RAW
__device__ __forceinline__ int block_excl_scan(const Ctx& c, int v, volatile LAS int* tmp, int& total) {
    int inc = v;
#pragma unroll
    for (int o = 1; o < 64; o <<= 1) { const int y = __shfl_up(inc, o); if (c.lane >= o) inc += y; }
    __syncthreads();
    if (c.lane == 63) tmp[c.wave] = inc;
    __syncthreads();
    int base = 0, tot = 0;
#pragma unroll
    for (int w = 0; w < 8; ++w) { const int x = tmp[w]; if (w < c.wave) base += x; tot += x; }
    total = tot;
    return base + inc - v;
}
__device__ __forceinline__ void select_unit(const Ctx& c_, int unit) { Ctx c = c_; asm volatile("" : "+s"(c.ws), "+s"(c.inp), "+s"(c.out), "+v"(c.tid)); c.lane = c.tid & 63;
    const bool isctx = unit >= 32; const int be = isctx ? unit - 32 : unit, b = be >> 4, e = be & 15;
    const int N = isctx ? 256 : 16384, cap = isctx ? CAPC : CAPL;
    const GAS float* probs = (const GAS float*)(c.ws + WS_PROBS) + (isctx ? 2 * 16 * 16384 + be * 256 : be * 16384);
    int* smap = (int*)(c.ws + WS_SMAP) + (isctx ? 2 * 16 * 16384 + be * 256 : be * 16384);
    int* idx = (int*)(c.ws + WS_IDX); float* gate = (float*)(c.ws + WS_GATE);
    const int rowbase = isctx ? (XLAT + e * 256 + b * 32) : be * CAPL;
    const int tokbase = isctx ? (MLAT + b * LC) : b * SEQ;
    LAS unsigned* keys = (LAS unsigned*)(c.lds + RING_OFF);
    volatile LAS unsigned* hist = (volatile LAS unsigned*)(c.lds + RING_OFF + 65536);
    volatile LAS int* tmp = (volatile LAS int*)(c.lds + RING_OFF + 65536 + 16384);
    __syncthreads();
    unsigned kreg[32];
    const int R = isctx ? 1 : N / 512; const bool act = !isctx || c.tid < 256;
    if (!isctx) {
#pragma unroll
        for (int r = 0; r < 32; ++r) kreg[r] = __float_as_uint(probs[c.tid + 512 * r]);
#pragma unroll
        for (int r = 0; r < 32; ++r) keys[c.tid + 512 * r] = kreg[r]; }
    else {
#pragma unroll
        for (int r = 0; r < 32; ++r) kreg[r] = 0u;
        if (c.tid < 256) { kreg[0] = __float_as_uint(probs[c.tid]); keys[c.tid] = kreg[0]; } }
    unsigned prefix = 0; int remaining = cap;
#pragma unroll 1
    for (int pass = 0; pass < 3; ++pass) {
        const int shift = pass == 0 ? 19 : pass == 1 ? 9 : 0, width = pass == 0 ? 12 : pass == 1 ? 10 : 9, B = 1 << width, nb = B >> 6;
        for (int i = c.tid; i < B; i += 512) hist[i] = 0u;
        __syncthreads();
        if (act) {
#pragma unroll
            for (int r = 0; r < 32; ++r) { const unsigned k = kreg[r];
                if (r < R && (pass == 0 || (k >> (shift + width)) == (prefix >> (shift + width)))) __hip_atomic_fetch_add((LAS unsigned*)&hist[(k >> shift) & (unsigned)(B - 1)], 1u, __ATOMIC_RELAXED, __HIP_MEMORY_SCOPE_WORKGROUP); } }
        __syncthreads();
        if (c.wave == 0) {
            const int d0 = B - 1 - c.lane * nb; int cl = 0;
            for (int q = 0; q < nb; ++q) cl += (int)hist[d0 - ((q + c.lane) & (nb - 1))];
            int inc = cl;
#pragma unroll
            for (int o = 1; o < 64; o <<= 1) { const int y = __shfl_up(inc, o); if (c.lane >= o) inc += y; }
            const int before = inc - cl;
            const unsigned long long own = __ballot(before < remaining && remaining <= inc);
            const int ol = __builtin_ctzll(own);
            const int obefore = __shfl(before, ol), od0 = B - 1 - ol * nb;
            const int hb = c.lane < nb ? (int)hist[od0 - c.lane] : 0; int hinc = hb;
#pragma unroll
            for (int o = 1; o < 64; o <<= 1) { const int y = __shfl_up(hinc, o); if (c.lane >= o) hinc += y; }
            const int hbefore = obefore + hinc - hb;
            if (c.lane < nb && hbefore < remaining && remaining <= hbefore + hb) { tmp[16] = od0 - c.lane; tmp[17] = remaining - hbefore; }
        }
        __syncthreads();
        prefix |= ((unsigned)tmp[16]) << shift; remaining = tmp[17];
        __syncthreads();
    }
    int cnt2 = 0;
    if (act) {
#pragma unroll
        for (int r = 0; r < 32; ++r) { const unsigned k = kreg[r]; if (r < R) cnt2 += (k >= prefix ? 1 : 0) + (k == prefix ? 65536 : 0); } }
    int tot2; int base2 = block_excl_scan(c, cnt2, tmp, tot2);
    const int toteq = tot2 >> 16;
    int cutoff = N;
    int slot = base2 & 0xffff;
    if (toteq != remaining) {
        if (c.wave == 0) { int cum = 0;
            for (int base = 0; base < N; base += 64) { const unsigned long long m = __ballot(keys[base + c.lane] == prefix); const int pc = __popcll(m);
                if (cum + pc >= remaining) { unsigned long long mm = m; for (int q = cum + 1; q < remaining; ++q) mm &= mm - 1; if (c.lane == 0) tmp[18] = base + __builtin_ctzll(mm); break; }
                cum += pc; } }
        __syncthreads();
        cutoff = tmp[18];
        __syncthreads();
        int nsel = 0;
        if (act) {
#pragma unroll
            for (int r = 0; r < 32; ++r) { const int i = c.tid + 512 * r; const unsigned k = kreg[r]; if (r < R) nsel += (k > prefix || (k == prefix && i <= cutoff)) ? 1 : 0; } }
        int tot; slot = block_excl_scan(c, nsel, tmp, tot);
    }
    if (act) {
#pragma unroll
        for (int r = 0; r < 32; ++r) { if (r < R) { const int i = c.tid + 512 * r; const unsigned k = kreg[r]; const bool sel = (k > prefix || (k == prefix && i <= cutoff)) && slot < cap;
            if (sel) { smap[i] = slot; idx[rowbase + slot] = tokbase + i; gate[rowbase + slot] = __uint_as_float(k); ++slot; } else smap[i] = -1; } } }
}


__device__ __forceinline__ void sg_stage_a(const Ctx& c, const GAS bf16* const (&srow)[16]) {
    __syncthreads();
    v4u v[16];
#pragma unroll
    for (int i = 0; i < 16; ++i) { const int p = c.tid + 512 * i; v[i] = *(const GAS v4u*)(srow[i] + (p & 127) * 8); }
#pragma unroll
    for (int i = 0; i < 16; ++i) { const int p = c.tid + 512 * i, row = p >> 7, ch = p & 127; *(LAS v4u*)(c.lds + RING_OFF + row * 2048 + ((ch ^ (row & 15)) << 4)) = v[i]; }
    LDS_WAIT(); __syncthreads();
}
template <int NB> __device__ __forceinline__ void sg_mainloop(const Ctx& c, const GAS bf16* const (&brow)[NB], int fr, int fq, f32x4 (&acc)[NB][4]) {
#pragma unroll
    for (int nb = 0; nb < NB; ++nb)
#pragma unroll
        for (int mt = 0; mt < 4; ++mt) acc[nb][mt] = (f32x4){0.f, 0.f, 0.f, 0.f};
    bf16x8 b0[NB][8], b1[NB][8];
#pragma unroll
    for (int nb = 0; nb < NB; ++nb)
#pragma unroll
        for (int k = 0; k < 8; ++k) b0[nb][k] = *(const GAS bf16x8*)(brow[nb] + 32 * k + 8 * fq);
#pragma unroll
    for (int kb = 0; kb < 4; ++kb) {
        if (kb < 3) {
#pragma unroll
            for (int nb = 0; nb < NB; ++nb)
#pragma unroll
                for (int k = 0; k < 8; ++k) { const bf16x8 t = *(const GAS bf16x8*)(brow[nb] + 32 * (8 * (kb + 1) + k) + 8 * fq); if (kb & 1) b0[nb][k] = t; else b1[nb][k] = t; }
        }
#pragma unroll
        for (int k = 0; k < 8; ++k) { const int ch = 4 * (8 * kb + k) + fq;
            bf16x8 a[4];
#pragma unroll
            for (int mt = 0; mt < 4; ++mt) { const int row = 16 * mt + fr; a[mt] = *(const LAS bf16x8*)(c.lds + RING_OFF + row * 2048 + ((ch ^ (row & 15)) << 4)); }
#pragma unroll
            for (int nb = 0; nb < NB; ++nb) { const bf16x8 bb = (kb & 1) ? b1[nb][k] : b0[nb][k];
#pragma unroll
                for (int mt = 0; mt < 4; ++mt) acc[nb][mt] = mfma16(bb, a[mt], acc[nb][mt]); } }
    }
}
__device__ __forceinline__ void ctx_inproj_item(const Ctx& c_, int l, int item, int nb_lo, int nb_cnt) { Ctx c = c_; asm volatile("" : "+s"(c.ws), "+s"(c.inp), "+s"(c.out), "+v"(c.tid)); c.lane = c.tid & 63; asm volatile("" : "+s"(l));
    const int fr = c.lane & 15, fq = c.lane >> 4; const int mblk = item / nb_cnt, nbk = nb_lo + item % nb_cnt;
    const GAS bf16* A1 = (const GAS bf16*)(c.ws + WS_R1); const GAS bf16* W = (const GAS bf16*)(c.ws + WS_WIN) + (size_t)l * INW * 1024;
    GAS bf16* P = (GAS bf16*)(c.ws + WS_R2); GAS bf16* Amat = (GAS bf16*)(c.ws + WS_R1 + OFF_AMAT); GAS bf16* U2 = (GAS bf16*)(c.ws + WS_R3);
    const int row0 = MLAT + 64 * mblk, col0 = 128 * nbk + 16 * c.wave;
    const GAS bf16* srow[16]; const GAS bf16* brow[1];
#pragma unroll
    for (int i = 0; i < 16; ++i) srow[i] = A1 + (size_t)(row0 + ((c.tid + 512 * i) >> 7)) * 1024;
    brow[0] = W + (size_t)(col0 + fr) * 1024;
    sg_stage_a(c, srow);
    f32x4 acc[1][4]; sg_mainloop<1>(c, brow, fr, fq, acc);
#pragma unroll
    for (int mt = 0; mt < 4; ++mt) { const int row = row0 + 16 * mt + fr, col = col0 + 4 * fq; u32x2 w; w.x = pk2(acc[0][mt][0], acc[0][mt][1]); w.y = pk2(acc[0][mt][2], acc[0][mt][3]);
        if (col >= 768 && col < 1024) { const int cl = col - 768; const size_t r = (size_t)(cl >> 4) * 2304 + (row >> 4); const int k = (row & 15) * 16 + (cl & 15); *(GAS u32x2*)(Amat + r * 512 + k) = w; *(GAS u32x2*)(U2 + r * 256 + k) = w; }
        else *(GAS u32x2*)(P + (size_t)row * INW + col) = w; }
}
__device__ __forceinline__ void ctx_outproj_item(const Ctx& c_, int l, int item) { Ctx c = c_; asm volatile("" : "+s"(c.ws), "+s"(c.inp), "+s"(c.out), "+v"(c.tid)); c.lane = c.tid & 63; asm volatile("" : "+s"(l));
    const int fr = c.lane & 15, fq = c.lane >> 4; const int mblk = item >> 3, nbk = item & 7;
    const GAS bf16* mixn = (const GAS bf16*)(c.ws + WS_R3); const GAS bf16* W = (const GAS bf16*)(c.ws + WS_WOUT) + (size_t)l * 1024 * 1024;
    const GAS float* gate = (const GAS float*)(c.ws + WS_MODV) + (size_t)(l * 3 + 2) * 6144 + 2 * 1024; GAS float* hctx = (GAS float*)(c.ws + WS_HCTX);
    const int r0 = 64 * mblk, col0 = 128 * nbk + 16 * c.wave;
    const GAS bf16* srow[16]; const GAS bf16* brow[1];
#pragma unroll
    for (int i = 0; i < 16; ++i) srow[i] = mixn + (size_t)(MLAT + r0 + ((c.tid + 512 * i) >> 7)) * 1024;
    brow[0] = W + (size_t)(col0 + fr) * 1024;
    sg_stage_a(c, srow);
    f32x4 acc[1][4]; sg_mainloop<1>(c, brow, fr, fq, acc);
    const f32x4 gv = *(const GAS f32x4*)(gate + col0 + 4 * fq);
#pragma unroll
    for (int mt = 0; mt < 4; ++mt) { const size_t off = (size_t)(r0 + 16 * mt + fr) * 1024 + col0 + 4 * fq;
        const f32x4 h = *(const GAS f32x4*)(c.inp[I_CTX] + off); *(GAS f32x4*)(hctx + off) = h + gv * acc[0][mt]; }
}
__device__ __forceinline__ void ctx_moe1_item(const Ctx& c_, int item) { Ctx c = c_; asm volatile("" : "+s"(c.ws), "+s"(c.inp), "+s"(c.out), "+v"(c.tid)); c.lane = c.tid & 63;
    const int fr = c.lane & 15, fq = c.lane >> 4; const int e = item >> 3, fb = item & 7;
    const GAS bf16* F = (const GAS bf16*)(c.ws + WS_R3 + 66 * MiB); const GAS int* idx = (const GAS int*)(c.ws + WS_IDX);
    const GAS bf16* W = (const GAS bf16*)(c.ws + WS_WGU) + (size_t)e * 2048 * 1024; GAS bf16* hid = (GAS bf16*)(c.ws + WS_R2);
    const int xr0 = XLAT + 256 * e;
    const GAS bf16* srow[16]; const GAS bf16* brow[2];
#pragma unroll
    for (int i = 0; i < 16; ++i) srow[i] = F + (size_t)idx[xr0 + ((c.tid + 512 * i) >> 7)] * 1024;
    brow[0] = W + (size_t)(256 * fb + 16 * c.wave + fr) * 1024; brow[1] = brow[0] + (size_t)128 * 1024;
    sg_stage_a(c, srow);
    f32x4 acc[2][4]; sg_mainloop<2>(c, brow, fr, fq, acc);
#pragma unroll
    for (int mt = 0; mt < 4; ++mt) { float hv[4];
#pragma unroll
        for (int i = 0; i < 4; ++i) { const float g = acc[0][mt][i]; hv[i] = g * __builtin_amdgcn_rcpf(1.0f + __builtin_amdgcn_exp2f(-g * LOG2E)) * acc[1][mt][i]; }
        u32x2 w; w.x = pk2(hv[0], hv[1]); w.y = pk2(hv[2], hv[3]);
        *(GAS u32x2*)(hid + (size_t)(xr0 + 16 * mt + fr) * 1024 + 128 * fb + 16 * c.wave + 4 * fq) = w; }
}
__device__ __forceinline__ void ctx_moe2_item(const Ctx& c_, int item) { Ctx c = c_; asm volatile("" : "+s"(c.ws), "+s"(c.inp), "+s"(c.out), "+v"(c.tid)); c.lane = c.tid & 63;
    const int fr = c.lane & 15, fq = c.lane >> 4; const int e = item >> 3, nbk = item & 7;
    const GAS bf16* hid = (const GAS bf16*)(c.ws + WS_R2); const GAS bf16* W = (const GAS bf16*)(c.ws + WS_WD) + (size_t)e * 1024 * 1024;
    GAS bf16* Y = (GAS bf16*)(c.ws + WS_R3); const GAS float* gate = (const GAS float*)(c.ws + WS_GATE);
    const int xr0 = XLAT + 256 * e, col0 = 128 * nbk + 16 * c.wave;
    const GAS bf16* srow[16]; const GAS bf16* brow[1];
#pragma unroll
    for (int i = 0; i < 16; ++i) srow[i] = hid + (size_t)(xr0 + ((c.tid + 512 * i) >> 7)) * 1024;
    brow[0] = W + (size_t)(col0 + fr) * 1024;
    sg_stage_a(c, srow);
    f32x4 acc[1][4]; sg_mainloop<1>(c, brow, fr, fq, acc);
#pragma unroll
    for (int mt = 0; mt < 4; ++mt) { const int row = xr0 + 16 * mt + fr; const float gt = gate[row];
        u32x2 w; w.x = pk2(acc[0][mt][0] * gt, acc[0][mt][1] * gt); w.y = pk2(acc[0][mt][2] * gt, acc[0][mt][3] * gt);
        *(GAS u32x2*)(Y + (size_t)row * 1024 + col0 + 4 * fq) = w; }
}

__device__ __forceinline__ void norm_unit(const Ctx& c_, int l, int unit) { Ctx c = c_; asm volatile("" : "+s"(c.ws), "+s"(c.inp), "+s"(c.out), "+v"(c.tid)); c.lane = c.tid & 63; asm volatile("" : "+s"(l));
    const int lane = c.lane; const bool sg = lane >= 32;
    const GAS bf16* mix = (const GAS bf16*)(c.ws + WS_R1); GAS bf16* mixn = (GAS bf16*)(c.ws + WS_R3); const GAS float* ong = c.inp[I_ONG] + l * D;
    const f32x4 ga0 = *(const GAS f32x4*)(ong + 8 * lane), gb0 = *(const GAS f32x4*)(ong + 8 * lane + 4), ga1 = *(const GAS f32x4*)(ong + 512 + 8 * lane), gb1 = *(const GAS f32x4*)(ong + 512 + 8 * lane + 4);
    const int row0 = unit * 64 + c.wave * 8;
    float x[8][2][8]; float sa[8], sh[8];
#pragma unroll
    for (int q = 0; q < 8; ++q)
#pragma unroll
        for (int j = 0; j < 2; ++j) { v4u w = (v4u){0u, 0u, 0u, 0u}; if (j == 0 || sg) w = *(const GAS v4u*)(mix + (size_t)(row0 + q) * 1024 + 8 * lane + 512 * j);
            x[q][j][0] = __uint_as_float(w.x << 16); x[q][j][1] = __uint_as_float(w.x & 0xffff0000u); x[q][j][2] = __uint_as_float(w.y << 16); x[q][j][3] = __uint_as_float(w.y & 0xffff0000u);
            x[q][j][4] = __uint_as_float(w.z << 16); x[q][j][5] = __uint_as_float(w.z & 0xffff0000u); x[q][j][6] = __uint_as_float(w.w << 16); x[q][j][7] = __uint_as_float(w.w & 0xffff0000u); }
#pragma unroll
    for (int q = 0; q < 8; ++q) { float s0 = 0.f, s1 = 0.f;
#pragma unroll
        for (int i = 0; i < 8; ++i) { s0 += x[q][0][i] * x[q][0][i]; s1 += x[q][1][i] * x[q][1][i]; }
        sa[q] = s0; sh[q] = s1; }
#pragma unroll
    for (int o = 1; o < 64; o <<= 1) {
#pragma unroll
        for (int q = 0; q < 8; ++q) { sa[q] += __shfl_xor(sa[q], o); sh[q] += __shfl_xor(sh[q], o); } }
#pragma unroll
    for (int q = 0; q < 8; ++q) {
        const float r_att = 1.0f / sqrtf(sa[q] * (1.0f / 512.0f) + EPS), r_b = 1.0f / sqrtf(sh[q] * (1.0f / 256.0f) + EPS);
#pragma unroll
        for (int j = 0; j < 2; ++j) { if (j == 0 || sg) { const float r = j == 0 ? r_att : r_b; const f32x4 ga = j == 0 ? ga0 : ga1, gb = j == 0 ? gb0 : gb1;
            v4u w; w.x = pk2(x[q][j][0] * r * ga[0], x[q][j][1] * r * ga[1]); w.y = pk2(x[q][j][2] * r * ga[2], x[q][j][3] * r * ga[3]);
            w.z = pk2(x[q][j][4] * r * gb[0], x[q][j][5] * r * gb[1]); w.w = pk2(x[q][j][6] * r * gb[2], x[q][j][7] * r * gb[3]);
            *(GAS v4u*)(mixn + (size_t)(row0 + q) * 1024 + 8 * lane + 512 * j) = w; } } }
}

#ifndef MK_N_LAUNCHES
#define MK_N_LAUNCHES 1
#endif
constexpr int N_PHASES = 24;
constexpr int N_LAUNCHES = MK_N_LAUNCHES;
static_assert(N_LAUNCHES == 1 || N_LAUNCHES == N_PHASES, "MK_N_LAUNCHES is 1 or 24");

typedef const __attribute__((address_space(4))) unsigned char* kargp_t;
__device__ __forceinline__ Ctx make_ctx(LAS unsigned char* lds) {
    Ctx c; kargp_t kp = (kargp_t)__builtin_amdgcn_kernarg_segment_ptr(); asm volatile("" : "+s"(kp));
    c.inp = (kfptr*)kp;
    c.out = *(GAS float* const __attribute__((address_space(4)))*)(kp + 248); c.ws = *(GAS unsigned char* const __attribute__((address_space(4)))*)(kp + 256);
    c.ctl = (gu32*)(c.ws + WS_CTL);
    c.lds = lds; c.MISC = (volatile LAS unsigned*)(lds + MISC_OFF);
    int t = threadIdx.x; asm volatile("" : "+v"(t)); c.tid = t; c.lane = t & 63; c.wave = __builtin_amdgcn_readfirstlane(t >> 6);
    int G = gridDim.x, bx = blockIdx.x; asm volatile("" : "+s"(G), "+s"(bx)); c.G = G; c.vcu = (G % 8 == 0) ? (bx % 8) * (G / 8) + bx / 8 : bx;
    return c;
}
static_assert(offsetof(Args, out) == 248 && offsetof(Args, ws) == 256 && offsetof(Args, ph_lo) == 264, "Args layout");
__device__ __forceinline__ void grid_bar(const Ctx& c) {
    XcdBarrier bar; bar.bar = (unsigned*)(c.ctl + CW_BAR); bar.x = xb_xcc_id(); bar.st = c.MISC + 8;
    xcd_barrier(bar);
}

__global__ void __launch_bounds__(NWAVES * 64, 2) mega_fwd(Args args) {
    extern __shared__ __attribute__((aligned(16))) unsigned char lds[];
    {
        Ctx c = make_ctx((LAS unsigned char*)lds);
        for (int u = c.tid; u < (LDS_BYTES - LDSCTL_OFF) / 4; u += NWAVES * 64) ((LAS unsigned*)(c.lds + LDSCTL_OFF))[u] = 0u;
        __syncthreads();
        if (N_LAUNCHES == 1) (void)xcd_barrier_post((unsigned*)(c.ctl + CW_BAR), c.MISC + 8);
    }
    const int lo = args.ph_lo, hi = args.ph_hi;
#ifndef KIND_MASK
#define KIND_MASK 0x1fff
#endif
#define KIND_OF(k) ((k) < 2 ? (k) : 2 + ((k) - 2) % 11)
#define IN(k) (((KIND_MASK >> KIND_OF(k)) & 1) && lo <= (k) && (k) < hi)
#ifndef TPROBE
#define TPROBE -1
#endif
#ifndef TPROBE_UNIT
#define TPROBE_UNIT 0
#endif
#define STAMP(i) do { if ((TPROBE >= 0) && blockIdx.x == 0 && c.tid == 0) __hip_atomic_store(c.ctl + CW_TS + (i), (unsigned)__builtin_amdgcn_s_memrealtime(), RLX_AGENT); } while (0)
#define SEAM(k) do { if (IN((k) + 1)) grid_bar(c); STAMP((k) + 1); } while (0)
#ifndef REPEAT_MASK
#define REPEAT_MASK 0
#endif
#ifndef D_REP_MASK
#define D_REP_MASK 7
#endif
#define NREP(k) ((((REPEAT_MASK) >> KIND_OF(k)) & 1) ? 2 : 1)
#define REPEAT(k) for (int rep = 0; rep < NREP(k); ++rep)
#define LAUNDER() Ctx c = make_ctx((LAS unsigned char*)lds)
#define A1 ((bf16*)(c.ws + WS_R1))
#define Pb ((bf16*)(c.ws + WS_R2))
#define mixn ((bf16*)(c.ws + WS_R3))
#define xin ((bf16*)(c.ws + WS_R1))
#define hid ((bf16*)(c.ws + WS_R2))
#define Yb ((bf16*)(c.ws + WS_R3))
#define hctx ((float*)(c.ws + WS_HCTX))
#define AMAT ((bf16*)(c.ws + WS_R1 + OFF_AMAT))
#define U2M ((bf16*)(c.ws + WS_R3))
#define GS ((bf16*)(c.ws + WS_R1 + OFF_GS))
#define MIX ((bf16*)(c.ws + WS_R1))

    { Ctx c = make_ctx((LAS unsigned char*)lds); STAMP(0); }
    if (IN(0)) { REPEAT(0) { LAUNDER(); if (rep) grid_bar(c); p0a(c); } LAUNDER(); SEAM(0); }
    if (IN(1)) { REPEAT(1) { LAUNDER(); if (rep) grid_bar(c); p0b_tables(c); row_prep(c, 0, 0); } LAUNDER(); SEAM(1); }
#pragma unroll 1
    for (int l = 0; l < 2; ++l) {
        const int pb = 2 + 11 * l;
#define PH_BEGIN(k) if (IN(pb + (k))) { for (int rep = 0; rep < NREP(pb + (k)); ++rep) { LAUNDER(); if (rep) grid_bar(c);
#define PH_END(k) } LAUNDER(); SEAM(pb + (k)); }
        PH_BEGIN(0)
            pg8::Gemm g{A1, (const bf16*)(c.ws + WS_WIN) + (size_t)l * INW * 1024, MLAT, INW, 1024, 1024, nullptr}; pg8::StaticOrder S; S.init(MLAT, INW, c.G, (int)blockIdx.x);
            pg8::EpiInProj E{Pb, AMAT, U2M};
            pg8::gemm_phase<pg8::EpiInProj, pg8::StaticOrder, true, true>(c.lds + RING_OFF, g, S, E);
            { const int nb_lo = l == 0 ? 0 : 4, nb_cnt = l == 0 ? 12 : 4;
              for (int it = (int)blockIdx.x; it < 8 * nb_cnt; it += c.G) ctx_inproj_item(c, l, it, nb_lo, nb_cnt); }
        PH_END(0)
        PH_BEGIN(1)
            if (l == 0 && rep == 0) tg_assemble(c);
            { pg8::Gemm g{U2M, (const bf16*)(c.ws + WS_EB) + (size_t)l * 16 * 256 * 256, 144 * 256, 256, 256, 256, nullptr}; pg8::StaticOrder S; S.init(144 * 256, 256, c.G, (int)blockIdx.x, 2);
              pg8::EpiF32x256 E{(float*)(c.ws + WS_R2 + OFF_E)};
              pg8::gemm_phase<pg8::EpiF32x256, pg8::StaticOrder, false, true>(c.lds + RING_OFF, g, S, E); }
            if (rep == 0) qk_prep_rows(c, l);
        PH_END(1)
        PH_BEGIN(2)
            const int natt = l == 0 ? 520 : 512, nsgu = l == 0 ? 260 : 256;
            int nredo = 0;
            for (;;) { const int u = q_next(c, pb + 2 + 32 * rep); if (u >= 64 + natt + nsgu) break;
                const int ukind = u < 64 ? 3 : u < 64 + natt ? 1 : 2;
                unsigned long long t0_ = 0; if (TPROBE_UNIT == ukind) t0_ = __builtin_amdgcn_s_memrealtime();
                if (u < 64) { if (rep == 0 || (D_REP_MASK & 1)) s5_scan_unit(c, l, u); }
                else if (u < 64 + natt) { if (rep == 0 || (D_REP_MASK & 2)) { if (attn_unit_t<true>(c, l, u - 64)) { if (c.tid == 0) c.MISC[64 + nredo] = (unsigned)(u - 64); ++nredo; } } }
                else { if (rep == 0 || (D_REP_MASK & 4)) sgu_unit(c, l, u - 64 - natt); }
                if (TPROBE_UNIT == ukind && l == 0) { WG_SYNC(); if (blockIdx.x == 0 && c.tid == 0) { const unsigned dt_ = (unsigned)(__builtin_amdgcn_s_memrealtime() - t0_);
                    __hip_atomic_fetch_add(c.ctl + CW_TS + 40, dt_, RLX_AGENT); __hip_atomic_fetch_add(c.ctl + CW_TS + 41, 1u, RLX_AGENT); } } }
            for (int i = 0; i < nredo; ++i) { LDS_WAIT(); __syncthreads(); const int uu = (int)c.MISC[64 + i]; (void)attn_unit_t<false>(c, l, __builtin_amdgcn_readfirstlane(uu)); }
        PH_END(2)
        PH_BEGIN(3)
            pg8::Gemm g{AMAT, (const bf16*)(c.ws + WS_TG) + (size_t)l * 16 * 256 * 512, 144 * 256, 256, 512, 512, nullptr}; pg8::StaticOrder S; S.init(144 * 256, 256, c.G, (int)blockIdx.x, 2);
            pg8::EpiS5Out E{GS, NSC};
            pg8::gemm_phase<pg8::EpiS5Out, pg8::StaticOrder, true, true>(c.lds + RING_OFF, g, S, E);
            if (rep == 0) for (;;) { const int u = q_next(c, pb + 3); if (u >= (l == 0 ? MT : MLAT) / 64) break; norm_unit(c, l, u); }
        PH_END(3)
        PH_BEGIN(4)
            const int M = l == 0 ? MT : MLAT;
            pg8::Gemm g{GS, (const bf16*)(c.ws + WS_WGLU) + (size_t)l * 256 * 256, M, 256, 256, 256, nullptr}; pg8::StaticOrder S; S.init(M, 256, c.G, (int)blockIdx.x);
            pg8::EpiGluNorm E{GS, MIX, mixn, (const float*)(c.inp[I_GLUB] + l * 256), (const float*)(c.inp[I_ONG] + l * D), EPS};
            pg8::gemm_phase<pg8::EpiGluNorm, pg8::StaticOrder, false, true>(c.lds + RING_OFF, g, S, E);
        PH_END(4)
        if (IN(pb + 5)) { for (int rep = 0; rep < (l == 0 ? NREP(pb + 5) : 1); ++rep) { LAUNDER(); if (rep) grid_bar(c);
            const int M = MLAT;
            pg8::Gemm g{mixn, (const bf16*)(c.ws + WS_WOUT) + (size_t)l * 1024 * 1024, M, 1024, 1024, 1024, nullptr}; pg8::StaticOrder S; S.init(M, 1024, c.G, (int)blockIdx.x);
            pg8::EpiResidBf E{l == 0 ? (const float*)c.inp[I_X] : nullptr, (bf16*)c.out, (const float*)(c.ws + WS_MODV) + (size_t)l * 3 * 6144, 2 * 1024};
            pg8::gemm_phase<pg8::EpiResidBf, pg8::StaticOrder, true, true>(c.lds + RING_OFF, g, S, E);
            if (l == 0) for (int it = (int)blockIdx.x; it < 64; it += c.G) ctx_outproj_item(c, l, it);
        PH_END(5)
        PH_BEGIN(6) ffn_prep(c, l, l == 0 ? MT : MLAT); PH_END(6)
        PH_BEGIN(7) const int nu = l == 0 ? 64 : 32; for (int u = (int)blockIdx.x; u < nu; u += c.G) select_unit(c, u);
            if (l == 0 && rep == 0 && c.G > 128) convert_experts(c, 1, 2, 3, 64);
        PH_END(7)
        PH_BEGIN(8)
            const int M = XLAT;
            pg8::Gemm g{(const bf16*)(c.ws + WS_R3 + 66 * MiB), (const bf16*)(c.ws + WS_WGU), M, 2048, 1024, 1024, (const int*)(c.ws + WS_IDX)};   pg8::StaticOrder S; S.init(M, 2048, c.G, (int)blockIdx.x, 1);
            pg8::EpiSwiGLU E{hid};
            pg8::gemm_phase<pg8::EpiSwiGLU, pg8::StaticOrder, true, true, true>(c.lds + RING_OFF, g, S, E);
            if (l == 0) for (int it = (int)blockIdx.x; it < 128; it += c.G) ctx_moe1_item(c, it);
        PH_END(8)
        PH_BEGIN(9)
            const int M = XLAT;
            pg8::Gemm g{hid, (const bf16*)(c.ws + (l == 0 ? WS_WD : WS_WD1)), M, 1024, 1024, 1024, nullptr}; pg8::StaticOrder S; S.init(M, 1024, c.G, (int)blockIdx.x, 1);
            pg8::EpiGateY E{Yb, (const float*)(c.ws + WS_GATE)};
            pg8::gemm_phase<pg8::EpiGateY, pg8::StaticOrder, true, true>(c.lds + RING_OFF, g, S, E);
            if (l == 0) for (int it = (int)blockIdx.x; it < 128; it += c.G) ctx_moe2_item(c, it);
        PH_END(9)
        if (IN(pb + 10)) { LAUNDER();
            if (l == 0) { row_prep(c, 1, 1); if (c.G > 128) convert_experts(c, 1, 0, 2, 0); else convert_experts(c, 1, 0, 3, 0); SEAM(pb + 10); }
            else row_prep(c, 2, 1);
        }
    }
#undef PH_BEGIN
#undef PH_END
#undef AMAT
#undef U2M
#undef GS
#undef MIX
#undef IN
#undef SEAM
#undef A1
#undef Pb
#undef mixn
#undef xin
#undef hid
#undef Yb
#undef hctx
}

extern "C" void kernel_launch(void* const* d_in, const int* in_sizes, int n_in, void* d_out, int out_size, void* d_ws, size_t ws_size, hipStream_t stream) {
    static int grid = 0;
    if (grid == 0) {
        if (n_in != 31 || in_sizes[0] != MLAT * D || out_size != MLAT * D || ws_size < WS_END) {
            fprintf(stderr, "kernel_launch: unexpected shapes (n_in %d, in0 %d, out %d, ws %zu < %zu); nothing launched\n", n_in, n_in > 0 ? in_sizes[0] : -1, out_size, ws_size, (size_t)WS_END); grid = -1; return; }
        int dev = 0, cus = 0, per_cu = 0;
        if (hipGetDevice(&dev) != hipSuccess || hipDeviceGetAttribute(&cus, hipDeviceAttributeMultiprocessorCount, dev) != hipSuccess) { grid = -1; return; }
        if (hipFuncSetAttribute((const void*)mega_fwd, hipFuncAttributeMaxDynamicSharedMemorySize, LDS_BYTES) != hipSuccess) { fprintf(stderr, "kernel_launch: hipFuncSetAttribute failed\n"); grid = -1; return; }
        if (hipOccupancyMaxActiveBlocksPerMultiprocessor(&per_cu, (const void*)mega_fwd, NWAVES * 64, LDS_BYTES) != hipSuccess || per_cu < 1)
            fprintf(stderr, "kernel_launch: note: occupancy query reports %d workgroups per CU\n", per_cu);
        (void)hipGetLastError();
        grid = cus;
    }
    if (grid < 0) return;
    if (hipMemsetAsync((char*)d_ws + WS_CTL, 0, CTL_ZERO_BYTES, stream) != hipSuccess) { fprintf(stderr, "kernel_launch: hipMemsetAsync failed\n"); return; }
    Args a{};
    for (int i = 0; i < 31; ++i) a.in[i] = (const float*)d_in[i];
    a.out = (float*)d_out; a.ws = (unsigned char*)d_ws;
    for (int li = 0; li < N_LAUNCHES; ++li) {
        a.ph_lo = (N_LAUNCHES == 1) ? 0 : li; a.ph_hi = (N_LAUNCHES == 1) ? N_PHASES : li + 1;
        hipLaunchKernelGGL(mega_fwd, dim3(grid), dim3(NWAVES * 64), LDS_BYTES, stream, a);
        const hipError_t le = hipPeekAtLastError();
        if (le != hipSuccess) { fprintf(stderr, "kernel_launch: launch %d failed: %s\n", li, hipGetErrorName(le)); break; }
    }
}
```

```cpp
#include <hip/hip_runtime.h>
#include <cstdio>
#include <cstdint>
#include <cmath>

constexpr int D = 1024, NBATCH = 2, SEQ = 16384, LC = 256;
constexpr int MLAT = NBATCH * SEQ, MCTX = NBATCH * LC, MT = MLAT + MCTX;
constexpr int INW = 1536;
constexpr int NE = 16, CAPL = 2048, CAPC = 32;
constexpr int XLAT = NBATCH * NE * CAPL;
constexpr int XROWS = XLAT + NE * 256;
constexpr float EPS = 1e-6f;
constexpr float LOG2E = 1.4426950408889634f;
constexpr int NTILE = MT / 256;
constexpr int NSC = MT / 16;

namespace pg8 {
#define PG8_LAS __attribute__((address_space(3)))
typedef unsigned short bf16_t;
typedef short bf16x8 __attribute__((ext_vector_type(8)));
typedef float f32x4 __attribute__((ext_vector_type(4)));
typedef unsigned u32x4 __attribute__((ext_vector_type(4)));
constexpr int BM = 256, BK = 64, HALF = 128, HTB = HALF * BK * 2  , STAGE_BYTES = 8 * HTB, NXCD = 8, WGM = 8;

__host__ __device__ __forceinline__ int lds_byte(int r, int c) { const int st = (r >> 4) * 2 + (c >> 5), rr = r & 15, cc = c & 31, ob = rr * 64 + cc * 2; return st * 1024 + (ob ^ (((ob >> 9) & 1) << 5)); }
__host__ __device__ __forceinline__ void stage_rc(int b, int& R, int& C) { const int st = b / 1024, sb = b % 1024, swz = sb ^ (((sb >> 9) & 1) << 5); R = (st >> 1) * 16 + swz / 64; C = (st & 1) * 32 + (swz % 64) / 2; }
__host__ __device__ __forceinline__ int perm32(int rho) { const int n = rho >> 4, i = rho & 15; return 8 * (i >> 2) + 4 * n + (i & 3); }

struct Unit { int pm, pn, pb; };
struct Gemm { const bf16_t* A; const bf16_t* Bt; int M, N, K, lda; const int* rowidx; };

struct StaticOrder {
    int nM, nN, nwg, G, c, moe;
    __host__ __device__ void init(int M, int N, int G_, int c_, int moe_ = 0) { nM = M / BM; nN = N / BM; nwg = nM * nN; G = G_; c = c_; moe = moe_; }
    __host__ __device__ bool next(int i, Unit& u) const {
        const long L = (long)i * G + c; if (L >= nwg) return false;
        int wgid = (int)L; { const int q = nwg / NXCD, r = nwg % NXCD, xcd = wgid % NXCD, off = wgid / NXCD; wgid = (xcd < r ? xcd * (q + 1) : r * (q + 1) + (xcd - r) * q) + off; }
        const int nig = WGM * nN, gid = wgid / nig, fm = gid * WGM, gsz = (nM - fm) < WGM ? (nM - fm) : WGM;
        u.pm = fm + ((wgid % nig) % gsz); u.pn = (wgid % nig) / gsz;
        u.pb = moe == 1 ? ((u.pm < 256 ? ((u.pm >> 3) & 15) : (u.pm - 256)) * nN + u.pn) : moe == 2 ? u.pm / 9 : u.pn; return true;
    }
    __device__ __forceinline__ void a_ready(const Unit&) const {}
    __device__ __forceinline__ void done(const Unit&) const {}
};

__device__ __forceinline__ unsigned cvt_pk_bf16(float lo, float hi) { unsigned r; asm volatile("v_cvt_pk_bf16_f32 %0, %1, %2" : "=v"(r) : "v"(lo), "v"(hi)); return r; }

struct EpiResid {
    static constexpr bool PERM = false, AFTER_DRAIN = false;
    const float* src_lat; float* dst_lat; const float* src_ctx; float* dst_ctx; const float* gate3;
    int mlat, gate_off;
    __device__ __forceinline__ void operator()(const f32x4 (&acc)[2][2][4][2], const Unit& u, int wr, int wc, int fr, int fq) const {
        const int r0 = u.pm * BM; const bool isctx = r0 >= mlat; const int mb = isctx ? 2 : (r0 >> 14);
        const float* src = isctx ? src_ctx : src_lat; float* dst = isctx ? dst_ctx : dst_lat;
        const int rb = (isctx ? r0 - mlat : r0) + wr * 64 + fr, col0 = u.pn * BM + wc * 32 + 4 * fq;
        const float* gate = gate3 + mb * 6144 + gate_off;
        f32x4 gv[2][2];
#pragma unroll
        for (int bj = 0; bj < 2; ++bj)
#pragma unroll
            for (int n = 0; n < 2; ++n) gv[bj][n] = *(const f32x4*)(gate + col0 + bj * HALF + n * 16);
#pragma unroll
        for (int ai = 0; ai < 2; ++ai)
#pragma unroll
            for (int m = 0; m < 4; ++m) { const size_t off = (size_t)(rb + ai * HALF + m * 16) * 1024 + col0;
#pragma unroll
                for (int bj = 0; bj < 2; ++bj)
#pragma unroll
                    for (int n = 0; n < 2; ++n) { const f32x4 h = *(const f32x4*)(src + off + bj * HALF + n * 16); *(f32x4*)(dst + off + bj * HALF + n * 16) = h + gv[bj][n] * acc[ai][bj][m][n]; }
                if (m & 1) asm volatile("" ::: "memory"); }
    }
};
struct EpiResidBf {
    static constexpr bool PERM = true, AFTER_DRAIN = false;
    const float* src_f32; bf16_t* hb; const float* gate3; int gate_off;
    __device__ __forceinline__ void operator()(const f32x4 (&acc)[2][2][4][2], const Unit& u, int wr, int wc, int fr, int fq) const {
        const int r0 = u.pm * BM, mb = r0 >> 14, row0 = r0 + wr * 64 + fr, col0 = u.pn * BM + wc * 32 + 8 * fq;
        const float* gate = gate3 + mb * 6144 + gate_off;
        f32x4 gv[2][2];
#pragma unroll
        for (int bj = 0; bj < 2; ++bj)
#pragma unroll
            for (int n = 0; n < 2; ++n) gv[bj][n] = *(const f32x4*)(gate + col0 + bj * HALF + 4 * n);
#pragma unroll
        for (int ai = 0; ai < 2; ++ai)
#pragma unroll
            for (int m = 0; m < 4; ++m) { const int row = row0 + ai * HALF + m * 16;
#pragma unroll
                for (int bj = 0; bj < 2; ++bj) { const int col = col0 + bj * HALF; f32x4 h0, h1;
                    if (src_f32) { h0 = *(const f32x4*)(src_f32 + (size_t)row * 1024 + col); h1 = *(const f32x4*)(src_f32 + (size_t)row * 1024 + col + 4); }
                    else { const u32x4 w = *(const u32x4*)(hb + (size_t)row * 2048 + col);
                        h0 = (f32x4){__uint_as_float(w.x << 16), __uint_as_float(w.x & 0xffff0000u), __uint_as_float(w.y << 16), __uint_as_float(w.y & 0xffff0000u)};
                        h1 = (f32x4){__uint_as_float(w.z << 16), __uint_as_float(w.z & 0xffff0000u), __uint_as_float(w.w << 16), __uint_as_float(w.w & 0xffff0000u)}; }
                    const f32x4 o0 = h0 + gv[bj][0] * acc[ai][bj][m][0], o1 = h1 + gv[bj][1] * acc[ai][bj][m][1];
                    u32x4 ow; ow.x = cvt_pk_bf16(o0[0], o0[1]); ow.y = cvt_pk_bf16(o0[2], o0[3]); ow.z = cvt_pk_bf16(o1[0], o1[1]); ow.w = cvt_pk_bf16(o1[2], o1[3]);
                    *(u32x4*)(hb + (size_t)row * 2048 + col) = ow; }
                if (m & 1) asm volatile("" ::: "memory"); }
    }
};
struct EpiSwiGLU {
    static constexpr bool PERM = true, AFTER_DRAIN = false;
    bf16_t* O;
    __device__ __forceinline__ void operator()(const f32x4 (&acc)[2][2][4][2], const Unit& u, int wr, int wc, int fr, int fq) const {
        const int row0 = u.pm * BM + wr * 64 + fr, col0 = u.pn * HALF + wc * 32 + 8 * fq;
#pragma unroll
        for (int ai = 0; ai < 2; ++ai)
#pragma unroll
            for (int m = 0; m < 4; ++m) { bf16_t* rowp = O + (size_t)(row0 + ai * HALF + m * 16) * 1024 + col0;
                float hv[8];
#pragma unroll
                for (int n = 0; n < 2; ++n)
#pragma unroll
                    for (int i = 0; i < 4; ++i) { const float g = acc[ai][0][m][n][i], up = acc[ai][1][m][n][i];
                        const float sg = g * __builtin_amdgcn_rcpf(1.0f + __builtin_amdgcn_exp2f(-g * 1.4426950408889634f)); hv[n * 4 + i] = sg * up; }
                u32x4 w; w.x = cvt_pk_bf16(hv[0], hv[1]); w.y = cvt_pk_bf16(hv[2], hv[3]); w.z = cvt_pk_bf16(hv[4], hv[5]); w.w = cvt_pk_bf16(hv[6], hv[7]);
                *(u32x4*)rowp = w; }
    }
};
struct EpiGateY {
    static constexpr bool PERM = true, AFTER_DRAIN = false;
    bf16_t* O; const float* gate;
    __device__ __forceinline__ void operator()(const f32x4 (&acc)[2][2][4][2], const Unit& u, int wr, int wc, int fr, int fq) const {
        const int row0 = u.pm * BM + wr * 64 + fr, col0 = u.pn * BM + wc * 32 + 8 * fq;
        float gts[2][4];
#pragma unroll
        for (int ai = 0; ai < 2; ++ai)
#pragma unroll
            for (int m = 0; m < 4; ++m) gts[ai][m] = gate[row0 + ai * HALF + m * 16];
#pragma unroll
        for (int ai = 0; ai < 2; ++ai)
#pragma unroll
            for (int m = 0; m < 4; ++m) { const int row = row0 + ai * HALF + m * 16; const float gt = gts[ai][m]; bf16_t* rowp = O + (size_t)row * 1024 + col0;
#pragma unroll
                for (int bj = 0; bj < 2; ++bj) { const f32x4 v0 = acc[ai][bj][m][0] * gt, v1 = acc[ai][bj][m][1] * gt;
                    u32x4 w; w.x = cvt_pk_bf16(v0[0], v0[1]); w.y = cvt_pk_bf16(v0[2], v0[3]); w.z = cvt_pk_bf16(v1[0], v1[1]); w.w = cvt_pk_bf16(v1[2], v1[3]);
                    *(u32x4*)(rowp + bj * HALF) = w; } }
    }
};

struct EpiInProj {
    static constexpr bool PERM = true, AFTER_DRAIN = false;
    bf16_t* O; bf16_t* Amat; bf16_t* U2;
    __device__ __forceinline__ void operator()(const f32x4 (&acc)[2][2][4][2], const Unit& u, int wr, int wc, int fr, int fq) const {
        const int row0 = u.pm * BM + wr * 64 + fr, cw = wc * 32 + 8 * fq;
#pragma unroll
        for (int ai = 0; ai < 2; ++ai)
#pragma unroll
            for (int m = 0; m < 4; ++m) { const int row = row0 + ai * HALF + m * 16;
#pragma unroll
                for (int bj = 0; bj < 2; ++bj) { const f32x4 v0 = acc[ai][bj][m][0], v1 = acc[ai][bj][m][1];
                    u32x4 w; w.x = cvt_pk_bf16(v0[0], v0[1]); w.y = cvt_pk_bf16(v0[2], v0[3]); w.z = cvt_pk_bf16(v1[0], v1[1]); w.w = cvt_pk_bf16(v1[2], v1[3]);
                    const int cl = cw + bj * HALF;
                    if (u.pn == 3) { const size_t r = (size_t)(cl >> 4) * 2304 + (row >> 4); const int k = (row & 15) * 16 + (cl & 15); *(u32x4*)(Amat + r * 512 + k) = w; *(u32x4*)(U2 + r * 256 + k) = w; }
                    else *(u32x4*)(O + (size_t)row * 1536 + u.pn * BM + cl) = w; } }
    }
};
struct EpiF32x256 {
    static constexpr bool PERM = false, AFTER_DRAIN = false;
    float* C;
    __device__ __forceinline__ void operator()(const f32x4 (&acc)[2][2][4][2], const Unit& u, int wr, int wc, int fr, int fq) const {
        const int row0 = u.pm * BM + wr * 64 + fr, col0 = wc * 32 + 4 * fq;
#pragma unroll
        for (int ai = 0; ai < 2; ++ai)
#pragma unroll
            for (int m = 0; m < 4; ++m) { float* rowp = C + (size_t)(row0 + ai * HALF + m * 16) * 256 + col0;
#pragma unroll
                for (int bj = 0; bj < 2; ++bj)
#pragma unroll
                    for (int n = 0; n < 2; ++n) *(f32x4*)(rowp + bj * HALF + n * 16) = acc[ai][bj][m][n];
                asm volatile("" ::: "memory"); }
    }
};
__device__ __forceinline__ float gelu_t(float x) { const float z2 = 1.5957691216057308f * (x + 0.044715f * x * x * x); return x * __builtin_amdgcn_rcpf(1.0f + __builtin_amdgcn_exp2f(-z2 * 1.4426950408889634f)); }
struct EpiS5Out {
    static constexpr bool PERM = false, AFTER_DRAIN = false;
    bf16_t* Gs; int nsc;
    __device__ __forceinline__ void operator()(const f32x4 (&acc)[2][2][4][2], const Unit& u, int wr, int wc, int fr, int fq) const {
        const int g = u.pm / 9, sc0 = (u.pm % 9) * BM + wr * 64 + fr;
#pragma unroll
        for (int ai = 0; ai < 2; ++ai)
#pragma unroll
            for (int m = 0; m < 4; ++m) { const int sc = sc0 + ai * HALF + m * 16;
                if (sc < nsc) {
#pragma unroll
                    for (int bj = 0; bj < 2; ++bj)
#pragma unroll
                        for (int n = 0; n < 2; ++n) { const int tau = 8 * bj + 2 * wc + n; const f32x4 v = acc[ai][bj][m][n];
                            unsigned lo = cvt_pk_bf16(gelu_t(v[0]), gelu_t(v[1])), hi = cvt_pk_bf16(gelu_t(v[2]), gelu_t(v[3]));
                            *(unsigned long long*)(Gs + (size_t)(16 * sc + tau) * 256 + 16 * g + 4 * fq) = ((unsigned long long)hi << 32) | lo; } } }
    }
};
struct EpiGluNorm {
    static constexpr bool PERM = true, AFTER_DRAIN = true;
    const bf16_t* Gs; bf16_t* mix; bf16_t* mixn; const float* glu_b; const float* ong; float eps;
    __device__ __forceinline__ void fused(f32x4 (&acc)[2][2][4][2], const Unit& u, int wr, int wc, int fr, int fq, PG8_LAS unsigned char* lds, int wid, int lane) const {
        const int row0 = u.pm * BM + wr * 64 + fr, col0 = wc * 32 + 8 * fq;
        f32x4 bv[2][2];
#pragma unroll
        for (int bj = 0; bj < 2; ++bj)
#pragma unroll
            for (int n = 0; n < 2; ++n) bv[bj][n] = *(const f32x4*)(glu_b + col0 + bj * HALF + 4 * n);
        PG8_LAS float* Pq = (PG8_LAS float*)lds;
#pragma unroll
        for (int ai = 0; ai < 2; ++ai)
#pragma unroll
            for (int m = 0; m < 4; ++m) { const int row = row0 + ai * HALF + m * 16; float ss = 0.f;
#pragma unroll
                for (int bj = 0; bj < 2; ++bj) { const int col = col0 + bj * HALF;
                    const u32x4 gw = *(const u32x4*)(Gs + (size_t)row * 256 + col);
                    const unsigned gws[4] = {gw.x, gw.y, gw.z, gw.w};
#pragma unroll
                    for (int i = 0; i < 8; ++i) { const float gv = __uint_as_float((i & 1) ? (gws[i >> 1] & 0xffff0000u) : (gws[i >> 1] << 16));
                        const float z = acc[ai][bj][m][i >> 2][i & 3] + bv[bj][i >> 2][i & 3];
                        const float o = gv * __builtin_amdgcn_rcpf(1.0f + __builtin_amdgcn_exp2f(-z * 1.4426950408889634f));
                        acc[ai][bj][m][i >> 2][i & 3] = o; ss += o * o; } }
                ss += __shfl_xor(ss, 16); ss += __shfl_xor(ss, 32);
                if (fq == 0) Pq[(ai * HALF + wr * 64 + m * 16 + fr) * 4 + wc] = ss; }
        asm volatile("s_waitcnt lgkmcnt(0)" ::: "memory"); __syncthreads();
        f32x4 gv4[2][2];
#pragma unroll
        for (int bj = 0; bj < 2; ++bj)
#pragma unroll
            for (int n = 0; n < 2; ++n) gv4[bj][n] = *(const f32x4*)(ong + 512 + col0 + bj * HALF + 4 * n);
#pragma unroll
        for (int ai = 0; ai < 2; ++ai)
#pragma unroll
            for (int m = 0; m < 4; ++m) { const int rl = ai * HALF + wr * 64 + m * 16 + fr, row = u.pm * BM + rl;
                const f32x4 p4 = *(const PG8_LAS f32x4*)(Pq + rl * 4);
                const float r = 1.0f / sqrtf(((p4[0] + p4[1]) + (p4[2] + p4[3])) * (1.0f / 256.0f) + eps);
#pragma unroll
                for (int bj = 0; bj < 2; ++bj) { const f32x4 v0 = acc[ai][bj][m][0] * r * gv4[bj][0], v1 = acc[ai][bj][m][1] * r * gv4[bj][1];
                    u32x4 w; w.x = cvt_pk_bf16(v0[0], v0[1]); w.y = cvt_pk_bf16(v0[2], v0[3]); w.z = cvt_pk_bf16(v1[0], v1[1]); w.w = cvt_pk_bf16(v1[2], v1[3]);
                    *(u32x4*)(mixn + (size_t)row * 1024 + 512 + col0 + bj * HALF) = w; } }
        asm volatile("s_waitcnt lgkmcnt(0)" ::: "memory"); __syncthreads();
    }
};

template <class Epi, class Sched, bool ALIGN_EPI = false, bool SP2 = false, bool GATHER = false>
__device__ __forceinline__ void gemm_phase(PG8_LAS unsigned char* lds, const Gemm g, const Sched& S, const Epi& E) {
    int tid_ = threadIdx.x; asm volatile("" : "+v"(tid_));
    const int tid = tid_, wid = __builtin_amdgcn_readfirstlane(tid >> 6), lane = tid & 63, wr = wid >> 2, wc = wid & 3, fr = lane & 15, fq = lane >> 4;
    const int K = g.K, nt = K / BK, lda = g.lda;
    unsigned voffA[2], voffB[2];
#pragma unroll
    for (int i = 0; i < 2; ++i) { int R, C; stage_rc(tid * 16 + i * 8192, R, C); const int Rb = Epi::PERM ? ((R & ~31) + perm32(R & 31)) : R;
        voffA[i] = (unsigned)(R * lda + C) * 2u; voffB[i] = (unsigned)(Rb * K + C) * 2u; }
    const size_t kstep = (size_t)(BK * 2);
    const size_t hstepB = (size_t)HALF * K * 2, hstepA = (size_t)HALF * lda * 2;
    const size_t tstepB = 2 * hstepB, tstepA = 2 * hstepA;
    const unsigned ldsw = (unsigned)wid * 1024u;
    const int aoff = lds_byte(wr * 64 + fr, fq * 8), boff = lds_byte(wc * 32 + fr, fq * 8);
#define PG8_SA(b, h) (((b) * 2 + (h)) * HTB)
#define PG8_SB(b, h) ((4 + (b) * 2 + (h)) * HTB)
#define PG8_STAGE(bufoff, gbase, voff) do { _Pragma("unroll") for (int _i = 0; _i < 2; ++_i) \
        __builtin_amdgcn_global_load_lds((const unsigned*)((const char*)(gbase) + (voff)[_i]), (PG8_LAS unsigned*)(lds + (bufoff) + ldsw + _i * 8192), 16, 0, 0); } while (0)
#define PG8_STAGE_A(bufoff, gbase, h, nx) do { if constexpr (GATHER) { _Pragma("unroll") for (int _i = 0; _i < 2; ++_i) \
        __builtin_amdgcn_global_load_lds((const unsigned*)((const char*)(gbase) + ((nx) ? vAn[h][_i] : vAc[h][_i])), (PG8_LAS unsigned*)(lds + (bufoff) + ldsw + _i * 8192), 16, 0, 0); } \
        else { PG8_STAGE(bufoff, (gbase) + ((h) ? hstepA : 0), voffA); } } while (0)
#define PG8_LDA(dst, b, h) do { _Pragma("unroll") for (int m = 0; m < 4; ++m) _Pragma("unroll") for (int k = 0; k < 2; ++k) dst[m][k] = *(const PG8_LAS bf16x8*)(lds + PG8_SA(b, h) + aoff + m * 2048 + k * 1024); } while (0)
#define PG8_LDB(dst, b, h) do { _Pragma("unroll") for (int n = 0; n < 2; ++n) _Pragma("unroll") for (int k = 0; k < 2; ++k) dst[n][k] = *(const PG8_LAS bf16x8*)(lds + PG8_SB(b, h) + boff + n * 2048 + k * 1024); } while (0)
#define PG8_MMA(ai, bj, At, Bt) do { __builtin_amdgcn_s_setprio(1); _Pragma("unroll") for (int m = 0; m < 4; ++m) _Pragma("unroll") for (int n = 0; n < 2; ++n) _Pragma("unroll") for (int k = 0; k < 2; ++k) \
        acc[ai][bj][m][n] = __builtin_amdgcn_mfma_f32_16x16x32_bf16(Bt[n][k], At[m][k], acc[ai][bj][m][n], 0, 0, 0); __builtin_amdgcn_s_setprio(0); } while (0)
#define PG8_WAIT_V(n) asm volatile("s_waitcnt vmcnt(" #n ")" ::: "memory")
#define PG8_WAIT_L(n) asm volatile("s_waitcnt lgkmcnt(" #n ")" ::: "memory")
#define PG8_BAR __builtin_amdgcn_s_barrier()
#define PG8_SCHED __builtin_amdgcn_sched_barrier(0)
    Unit cur, nxt; int ui = 0;
    if (!S.next(0, cur)) return;
    unsigned vAc[2][2] = {{0u, 0u}, {0u, 0u}}, vAn[2][2] = {{0u, 0u}, {0u, 0u}}; int RA[2], CA[2];
#pragma unroll
    for (int i = 0; i < 2; ++i) stage_rc(tid * 16 + i * 8192, RA[i], CA[i]);
    PG8_LAS int* const ridx = (PG8_LAS int*)(lds + STAGE_BYTES + 1024);
    if constexpr (GATHER) {
        Unit tu; for (int k = 0; k < 15 && S.next(k, tu); ++k) if (tid < 256) ridx[k * 256 + tid] = g.rowidx[tu.pm * BM + tid];
        asm volatile("s_waitcnt vmcnt(0) lgkmcnt(0)" ::: "memory"); __builtin_amdgcn_s_barrier(); asm volatile("" ::: "memory");
#pragma unroll
        for (int h = 0; h < 2; ++h)
#pragma unroll
            for (int i = 0; i < 2; ++i) vAc[h][i] = (unsigned)(ridx[h * HALF + RA[i]] * lda + CA[i]) * 2u;
    }
    f32x4 acc[2][2][4][2];
#pragma unroll
    for (int a = 0; a < 2; ++a)
#pragma unroll
        for (int b = 0; b < 2; ++b)
#pragma unroll
            for (int m = 0; m < 4; ++m)
#pragma unroll
                for (int n = 0; n < 2; ++n) acc[a][b][m][n] = (f32x4){0.f, 0.f, 0.f, 0.f};
    bf16x8 At[4][2], B0[2][2], B1[2][2];
    const char* cA = (const char*)g.A + (GATHER ? (size_t)0 : (size_t)cur.pm * tstepA); const char* cB = (const char*)g.Bt + (size_t)cur.pb * tstepB;
    S.a_ready(cur);
    if constexpr (SP2) {
        PG8_STAGE(PG8_SB(0, 0), cB, voffB); PG8_STAGE(PG8_SB(0, 1), cB + hstepB, voffB); PG8_STAGE_A(PG8_SA(0, 0), cA, 0, false); PG8_STAGE_A(PG8_SA(0, 1), cA, 1, false);
        if (wr == 1) PG8_BAR;
        PG8_WAIT_V(2); PG8_BAR;
        PG8_STAGE(PG8_SB(1, 0), cB + kstep, voffB); PG8_STAGE_A(PG8_SA(1, 0), cA + kstep, 0, false); PG8_STAGE(PG8_SB(1, 1), cB + hstepB + kstep, voffB);
        PG8_WAIT_V(6); PG8_BAR;
    } else {
        PG8_STAGE(PG8_SB(0, 0), cB, voffB); PG8_STAGE_A(PG8_SA(0, 0), cA, 0, false); PG8_STAGE(PG8_SB(0, 1), cB + hstepB, voffB); PG8_STAGE_A(PG8_SA(0, 1), cA, 1, false);
        if (wr == 1) PG8_BAR;
        PG8_WAIT_V(4); PG8_BAR;
        PG8_STAGE(PG8_SB(1, 0), cB + kstep, voffB); PG8_STAGE_A(PG8_SA(1, 0), cA + kstep, 0, false); PG8_STAGE(PG8_SB(1, 1), cB + hstepB + kstep, voffB);
        PG8_WAIT_V(6); PG8_BAR;
    }
    for (;;) {
        const bool has_next = S.next(ui + 1, nxt);
        const char* nA = GATHER ? (const char*)g.A : (has_next ? (const char*)g.A + (size_t)nxt.pm * tstepA : cA);
        if constexpr (GATHER) {
#pragma unroll
            for (int h = 0; h < 2; ++h)
#pragma unroll
                for (int i = 0; i < 2; ++i) vAn[h][i] = has_next ? (unsigned)(ridx[(ui + 1) * 256 + h * HALF + RA[i]] * lda + CA[i]) * 2u : vAc[h][i]; } const char* nB = has_next ? (const char*)g.Bt + (size_t)nxt.pb * tstepB : cB;
        for (int t = 0; t < nt; t += 2) {
            const bool last = (t == nt - 2);
            const char* a1 = cA + (size_t)(t + 1) * kstep;
            const char* a2 = last ? nA : cA + (size_t)(t + 2) * kstep; const char* b2 = last ? nB : cB + (size_t)(t + 2) * kstep;
            const char* a3 = a2 + kstep; const char* b3 = b2 + kstep;
            if (last && has_next) S.a_ready(nxt);
            if constexpr (SP2) {
            PG8_LDB(B0, 0, 0); PG8_LDB(B1, 0, 1); PG8_SCHED; PG8_LDA(At, 0, 0); PG8_STAGE_A(PG8_SA(1, 1), a1, 1, false);
            PG8_WAIT_V(8); PG8_WAIT_L(0); PG8_BAR; PG8_MMA(0, 0, At, B0); PG8_MMA(0, 1, At, B1); PG8_BAR; PG8_SCHED;
            PG8_LDA(At, 0, 1); PG8_STAGE(PG8_SB(0, 0), b2, voffB); PG8_STAGE(PG8_SB(0, 1), b2 + hstepB, voffB); PG8_STAGE_A(PG8_SA(0, 0), a2, 0, last);
            PG8_WAIT_V(8); PG8_WAIT_L(0); PG8_BAR; PG8_MMA(1, 0, At, B0); PG8_MMA(1, 1, At, B1); PG8_BAR; PG8_SCHED;
            PG8_LDB(B0, 1, 0); PG8_LDB(B1, 1, 1); PG8_SCHED; PG8_LDA(At, 1, 0); PG8_STAGE_A(PG8_SA(0, 1), a2, 1, last);
            PG8_WAIT_V(8); PG8_WAIT_L(0); PG8_BAR; PG8_MMA(0, 0, At, B0); PG8_MMA(0, 1, At, B1); PG8_BAR; PG8_SCHED;
            PG8_LDA(At, 1, 1); PG8_STAGE(PG8_SB(1, 0), b3, voffB); PG8_STAGE(PG8_SB(1, 1), b3 + hstepB, voffB); PG8_STAGE_A(PG8_SA(1, 0), a3, 0, last);
            PG8_WAIT_V(8); PG8_WAIT_L(0); PG8_BAR; PG8_MMA(1, 0, At, B0); PG8_MMA(1, 1, At, B1); PG8_BAR; PG8_SCHED;
            } else {
            PG8_LDB(B0, 0, 0); PG8_SCHED; PG8_LDA(At, 0, 0); PG8_STAGE_A(PG8_SA(1, 1), a1, 1, false);
            PG8_WAIT_L(8); PG8_BAR; PG8_WAIT_L(0); PG8_MMA(0, 0, At, B0); PG8_BAR; PG8_SCHED;
            PG8_LDB(B1, 0, 1); PG8_STAGE(PG8_SB(0, 0), b2, voffB);
            PG8_BAR; PG8_WAIT_L(0); PG8_MMA(0, 1, At, B1); PG8_BAR;
            PG8_LDA(At, 0, 1); PG8_STAGE_A(PG8_SA(0, 0), a2, 0, last);
            PG8_BAR; PG8_WAIT_L(0); PG8_MMA(1, 0, At, B0); PG8_BAR; PG8_SCHED;
            PG8_STAGE(PG8_SB(0, 1), b2 + hstepB, voffB);
            PG8_WAIT_V(6); PG8_BAR; PG8_MMA(1, 1, At, B1); PG8_BAR;
            PG8_LDB(B0, 1, 0); PG8_SCHED; PG8_LDA(At, 1, 0); PG8_STAGE_A(PG8_SA(0, 1), a2, 1, last);
            PG8_WAIT_L(8); PG8_BAR; PG8_WAIT_L(0); PG8_MMA(0, 0, At, B0); PG8_BAR; PG8_SCHED;
            PG8_LDB(B1, 1, 1); PG8_STAGE(PG8_SB(1, 0), b3, voffB);
            PG8_BAR; PG8_WAIT_L(0); PG8_MMA(0, 1, At, B1); PG8_BAR;
            PG8_LDA(At, 1, 1); PG8_STAGE_A(PG8_SA(1, 0), a3, 0, last);
            PG8_BAR; PG8_WAIT_L(0); PG8_MMA(1, 0, At, B0); PG8_BAR; PG8_SCHED;
            PG8_STAGE(PG8_SB(1, 1), b3 + hstepB, voffB);
            PG8_WAIT_V(6); PG8_BAR; PG8_MMA(1, 1, At, B1); PG8_BAR;
            }
        }
        if constexpr (ALIGN_EPI) { if (wr == 0) PG8_BAR; }
        if constexpr (!Epi::AFTER_DRAIN) { E(acc, cur, wr, wc, fr, fq); S.done(cur); }
        if (!has_next) break;
#pragma unroll
        for (int a = 0; a < 2; ++a)
#pragma unroll
            for (int b = 0; b < 2; ++b)
#pragma unroll
                for (int m = 0; m < 4; ++m)
#pragma unroll
                    for (int n = 0; n < 2; ++n) acc[a][b][m][n] = (f32x4){0.f, 0.f, 0.f, 0.f};
        cur = nxt; cA = nA; cB = nB; ++ui;
        if constexpr (GATHER) {
#pragma unroll
            for (int h = 0; h < 2; ++h)
#pragma unroll
                for (int i = 0; i < 2; ++i) vAc[h][i] = vAn[h][i]; }
        if constexpr (ALIGN_EPI) { if (wr == 1) PG8_BAR; }
    }
    PG8_WAIT_V(0);
    if constexpr (!ALIGN_EPI) { if (wr == 0) PG8_BAR; }
    PG8_BAR;
    if constexpr (Epi::AFTER_DRAIN) { E.fused(acc, cur, wr, wc, fr, fq, lds, wid, lane); S.done(cur); }
#undef PG8_SA
#undef PG8_SB
#undef PG8_STAGE
#undef PG8_LDA
#undef PG8_LDB
#undef PG8_MMA
#undef PG8_WAIT_V
#undef PG8_WAIT_L
#undef PG8_BAR
#undef PG8_SCHED
}
}
#define GAS __attribute__((address_space(1)))
#define LAS __attribute__((address_space(3)))
typedef unsigned short bf16;
typedef unsigned v4u __attribute__((ext_vector_type(4)));
typedef float f32x4 __attribute__((ext_vector_type(4)));
typedef short bf16x8 __attribute__((ext_vector_type(8)));
typedef GAS unsigned gu32;
typedef GAS unsigned long long gu64;
#define RLX_AGENT __ATOMIC_RELAXED, __HIP_MEMORY_SCOPE_AGENT
#define LDS_WAIT() asm volatile("s_waitcnt lgkmcnt(0)" ::: "memory")
#define VM_WAIT() asm volatile("s_waitcnt vmcnt(0)" ::: "memory")
__device__ __forceinline__ unsigned long long rt() { return __builtin_amdgcn_s_memrealtime(); }
__device__ __forceinline__ unsigned f2bf(float f) { unsigned u = __builtin_bit_cast(unsigned, f); return (u + 0x7fffu + ((u >> 16) & 1u)) >> 16; }
typedef float pk_f32x2 __attribute__((ext_vector_type(2))); typedef __bf16 pk_bf16x2 __attribute__((ext_vector_type(2)));
__device__ __forceinline__ unsigned pk2(float lo, float hi) { pk_f32x2 v = {lo, hi}; pk_bf16x2 b = __builtin_convertvector(v, pk_bf16x2); return __builtin_bit_cast(unsigned, b); }

#define XB_TMO      128
#define XB_XCNT(j)  (256  + 64 * (j))
#define XB_XSUB(j)  (1280 + 64 * (j))
#define XB_XGEN(j)  (2304 + 64 * (j))
#define XB_TOP      3328
#define XB_TOPGEN   3392
#define XCD_BAR_WORDS 3456
#define XB_SPIN_CAP (1u << 18)

__device__ __forceinline__ unsigned xb_ld(unsigned* p)              { return __hip_atomic_load(p, __ATOMIC_RELAXED, __HIP_MEMORY_SCOPE_AGENT); }
__device__ __forceinline__ unsigned xb_add(unsigned* p, unsigned v) { return __hip_atomic_fetch_add(p, v, __ATOMIC_RELAXED, __HIP_MEMORY_SCOPE_AGENT); }
__device__ __forceinline__ unsigned xb_xcc_id() { return (unsigned)__builtin_amdgcn_s_getreg((3 << 11) | 20) & 0xFu; }
#define XB_SPIN(cond, bar) do { unsigned _sp = 0; while (cond) { __builtin_amdgcn_s_sleep(1); \
    if ((++_sp & 255u) == 0u) { if (xb_ld(&(bar)[XB_TMO])) break; if (_sp > XB_SPIN_CAP) { atomicAdd(&(bar)[XB_TMO], 1u); break; } } } } while (0)

struct XcdBarrier {
    unsigned* bar; unsigned x;
    volatile LAS unsigned* st;
};

__device__ __forceinline__ XcdBarrier xcd_barrier_post(unsigned* bar, volatile LAS unsigned* st) {
    XcdBarrier b; b.bar = bar; b.x = xb_xcc_id(); b.st = st;
    if (threadIdx.x == 0) (void)xb_add(&bar[XB_XCNT(b.x)], 1u);
    return b;
}
__device__ __forceinline__ void xcd_barrier_complete(unsigned* bar, unsigned x, unsigned& nloc, unsigned& nx) {
    const unsigned G = gridDim.x * gridDim.y * gridDim.z;
    unsigned sum, cnt, mine, sp = 0u;
    for (;;) {
        sum = 0u; cnt = 0u; mine = 0u;
#pragma unroll
        for (unsigned j = 0; j < 16; ++j) { const unsigned c = xb_ld(&bar[XB_XCNT(j)]); sum += c; cnt += (c > 0u) ? 1u : 0u; mine = (j == x) ? c : mine; }
        if (sum == G) break;
        __builtin_amdgcn_s_sleep(1);
        if ((++sp & 255u) == 0u) { if (xb_ld(&bar[XB_TMO])) break; if (sp > XB_SPIN_CAP) { atomicAdd(&bar[XB_TMO], 1u); break; } }
    }
    nloc = mine > 0u ? mine : 1u; nx = cnt > 0u ? cnt : 1u;
}

__device__ __forceinline__ void xcd_barrier(const XcdBarrier& b) {
    asm volatile("s_waitcnt vmcnt(0)" ::: "memory");
    __syncthreads();
    if (threadIdx.x == 0) {
        unsigned* bar = b.bar;
        __builtin_amdgcn_s_waitcnt(0);
        unsigned nloc = b.st[0], nx = b.st[1];
        if (nloc == 0u) { xcd_barrier_complete(bar, b.x, nloc, nx); b.st[0] = nloc; b.st[1] = nx; }
        const unsigned old = xb_add(&bar[XB_XSUB(b.x)], 1u);
        const unsigned gen = old / nloc;
        if (old + 1u == (gen + 1u) * nloc) {
            __builtin_amdgcn_fence(__ATOMIC_RELEASE, "agent");
            asm volatile("s_waitcnt vmcnt(0)" ::: "memory");
            const unsigned og = xb_add(&bar[XB_TOP], 1u);
            const unsigned tg = og / nx;
            if (og + 1u == (tg + 1u) * nx) xb_add(&bar[XB_TOPGEN], 1u);
            else XB_SPIN(xb_ld(&bar[XB_TOPGEN]) == tg, bar);
            __builtin_amdgcn_fence(__ATOMIC_ACQUIRE, "agent");
            xb_add(&bar[XB_XGEN(b.x)], 1u);
            asm volatile("s_waitcnt vmcnt(0)" ::: "memory");
        } else {
            XB_SPIN(xb_ld(&bar[XB_XGEN(b.x)]) == gen, bar);
            __builtin_amdgcn_fence(__ATOMIC_ACQUIRE, "agent");
            asm volatile("s_waitcnt vmcnt(0)" ::: "memory");
        }
    }
    __syncthreads();
}

typedef float f32x2 __attribute__((ext_vector_type(2)));
typedef float f32x16 __attribute__((ext_vector_type(16)));
typedef unsigned u32x2 __attribute__((ext_vector_type(2)));
typedef short v4i16_t __attribute__((ext_vector_type(4)));

constexpr size_t MiB = 1u << 20;
constexpr size_t WS_CTL = 0, CTL_ZERO_BYTES = 1 * MiB;
constexpr size_t WS_MODV = 1 * MiB;
constexpr size_t WS_POW  = 1 * MiB + 256 * 1024;
constexpr size_t WS_BBAR = 2 * MiB;
constexpr size_t WS_WGLU = 2 * MiB + 512 * 1024;
constexpr size_t WS_WSGU = 2 * MiB + 768 * 1024;
constexpr size_t WS_HCTX = 3 * MiB;
constexpr size_t WS_EB   = 5 * MiB;
constexpr size_t WS_TG   = 9 * MiB;
constexpr size_t WS_ROPE = 17 * MiB;
constexpr size_t WS_KTAB = 19 * MiB + 512 * 1024;
constexpr size_t WS_PROBS = 22 * MiB;
constexpr size_t WS_SMAP = 24 * MiB + 256 * 1024;
constexpr size_t WS_IDX  = 26 * MiB + 512 * 1024;
constexpr size_t WS_GATE = 27 * MiB;
constexpr size_t WS_WIN  = 28 * MiB;
constexpr size_t WS_WOUT = 34 * MiB;
constexpr size_t WS_WGU  = 38 * MiB;
constexpr size_t WS_WD   = 102 * MiB;
constexpr size_t WS_R1   = 134 * MiB;
constexpr size_t WS_R2   = 270 * MiB;
constexpr size_t WS_R3   = 406 * MiB;
constexpr size_t WS_WD1  = 542 * MiB;
constexpr size_t WS_END  = 574 * MiB;
constexpr size_t OFF_GS = 66 * MiB, OFF_AMAT = 84 * MiB;
constexpr size_t OFF_E = 98 * MiB;
constexpr int POWS = 20;
static_assert((size_t)XROWS * 2048 == 136 * MiB, "MoE row buffers are 136 MiB");
constexpr int CW_TMO = 0, CW_CODE = 1;
constexpr int CW_BAR = 4096;
constexpr int CW_TS = 8192;
constexpr int CW_Q = 16384;
constexpr int RING_OFF = 0, RING_BYTES = 131072;
constexpr int LDSCTL_OFF = RING_BYTES, MISC_OFF = LDSCTL_OFF + 320;
constexpr int LDS_BYTES = 147456;
constexpr int NWAVES = 8;


struct Args { const float* in[31]; float* out; unsigned char* ws; int ph_lo, ph_hi; };
typedef const GAS float* fptr_t;
typedef const __attribute__((address_space(4))) fptr_t kfptr;
struct Ctx {
    LAS unsigned char* lds; volatile LAS unsigned* MISC; gu32* ctl;
    int tid, lane, wave, vcu, G;
    kfptr* inp; GAS float* out; GAS unsigned char* ws;
};
enum InIdx { I_X = 0, I_C, I_CTX, I_CCTX, I_ADAW, I_ADAB, I_NMIXG, I_NFFNG, I_WIN, I_QNG, I_KNG, I_SINK, I_LRE, I_LIM, I_LOGDT, I_BRE, I_BIM, I_CRE, I_CIM,
             I_S5D, I_GLUW, I_GLUB, I_SGUNG, I_SGUW, I_SGUB, I_ONG, I_WOUT, I_ROUTW, I_WG, I_WU, I_WDN };

__device__ __forceinline__ float bf2f(unsigned h) { return __uint_as_float(h << 16); }
__device__ __forceinline__ float wave_sum(float v) {
#pragma unroll
    for (int o = 1; o < 64; o <<= 1) v += __shfl_xor(v, o);
    return v;
}
__device__ __forceinline__ float gelu_tanh(float x) {
    const float z2 = 1.5957691216057308f * (x + 0.044715f * x * x * x);
    return x * __builtin_amdgcn_rcpf(1.0f + __builtin_amdgcn_exp2f(-z2 * LOG2E));
}
__device__ __forceinline__ float silu_f(float x) { return x / (1.0f + __expf(-x)); }
#define WG_SYNC() do { asm volatile("s_waitcnt vmcnt(0) lgkmcnt(0)" ::: "memory"); __syncthreads(); } while (0)

__device__ __forceinline__ int q_next(const Ctx& c, int qi) {
    LDS_WAIT(); __syncthreads();
    if (c.tid == 0) c.MISC[16] = __hip_atomic_fetch_add(c.ctl + CW_Q + 64 * qi, 1u, RLX_AGENT);
    __syncthreads();
    const int u = (int)c.MISC[16];
    return __builtin_amdgcn_readfirstlane(u);
}

__device__ __forceinline__ unsigned q_issue(const Ctx& c, int qi) { unsigned t = 0u; if (c.tid == 0) t = __hip_atomic_fetch_add(c.ctl + CW_Q + 64 * qi, 1u, RLX_AGENT); return t; }
__device__ __forceinline__ int q_publish(const Ctx& c, unsigned t) {
    LDS_WAIT(); __syncthreads();
    if (c.tid == 0) c.MISC[16] = t;
    __syncthreads();
    const int u = (int)c.MISC[16];
    return __builtin_amdgcn_readfirstlane(u);
}

__device__ __forceinline__ void transpose_item(const GAS float* W, int K, int N, bf16* WT, int ilv, LAS float* scr, int item, int lane) {
    const int nblk = N / 32, kb = item / nblk, nb = item % nblk, k0 = 64 * kb, n0 = 32 * nb;
    const int row_off = ilv ? ((n0 >> 7) * 128 + (ilv == 2 ? 128 : 0)) : 0;
    { const int n4 = (lane & 7) * 4; f32x4 v[8];
#pragma unroll
      for (int i = 0; i < 8; ++i) v[i] = *(const GAS f32x4*)(W + (size_t)(k0 + (lane >> 3) + 8 * i) * N + n0 + n4);
#pragma unroll
      for (int i = 0; i < 8; ++i) { LAS float* d = scr + ((lane >> 3) + 8 * i) * 33 + n4; d[0] = v[i][0]; d[1] = v[i][1]; d[2] = v[i][2]; d[3] = v[i][3]; } }
    LDS_WAIT(); asm volatile("" ::: "memory");
    const int cc = lane & 7;
#pragma unroll
    for (int j = 0; j < 4; ++j) { const int n = (lane >> 3) + 8 * j; const LAS float* s = scr + (8 * cc) * 33 + n;
        v4u o; o.x = pk2(s[0 * 33], s[1 * 33]); o.y = pk2(s[2 * 33], s[3 * 33]); o.z = pk2(s[4 * 33], s[5 * 33]); o.w = pk2(s[6 * 33], s[7 * 33]);
        *(GAS v4u*)(WT + (size_t)(row_off + n0 + n) * K + k0 + 8 * cc) = o; }
    LDS_WAIT(); asm volatile("" ::: "memory");
}
__device__ __forceinline__ void convert_experts(const Ctx& c_, int l, int w_lo, int w_hi, int blk_lo) { Ctx c = c_; asm volatile("" : "+s"(c.ws), "+s"(c.inp), "+s"(c.out), "+v"(c.tid)); c.lane = c.tid & 63; asm volatile("" : "+s"(l));
    LAS float* scr = (LAS float*)(c.lds + RING_OFF + c.wave * 16384);
    const int gw = (blk_lo ? (int)blockIdx.x - blk_lo : c.vcu) * NWAVES + c.wave, NGW = (c.G - blk_lo) * NWAVES;
    bf16* WGU = (bf16*)(c.ws + WS_WGU); bf16* WD = (bf16*)(c.ws + (l == 0 ? WS_WD : WS_WD1));
    if (gw < 0) return;
    for (int it = w_lo * 16 * 512 + gw; it < w_hi * 16 * 512; it += NGW) {
        const int which = it / (16 * 512), r = it % (16 * 512), e = r / 512, item = r % 512;
        const size_t wofs = ((size_t)l * 16 + e) * 1024 * 1024;
        if (which == 0) transpose_item(c.inp[I_WG] + wofs, 1024, 1024, WGU + (size_t)e * 2048 * 1024, 1, scr, item, c.lane);
        else if (which == 1) transpose_item(c.inp[I_WU] + wofs, 1024, 1024, WGU + (size_t)e * 2048 * 1024, 2, scr, item, c.lane);
        else transpose_item(c.inp[I_WDN] + wofs, 1024, 1024, WD + (size_t)e * 1024 * 1024, 0, scr, item, c.lane);
    }
}

__device__ __forceinline__ void p0a(const Ctx& c_) { Ctx c = c_; asm volatile("" : "+s"(c.ws), "+s"(c.inp), "+s"(c.out), "+v"(c.tid)); c.lane = c.tid & 63;
    {
        float* modv = (float*)(c.ws + WS_MODV); LAS float* red = (LAS float*)(c.lds + RING_OFF);
        for (int it = (int)blockIdx.x; it < 192; it += c.G) {
            const int l = it / 96, col = (it % 96) * 64 + c.lane;
            const GAS float* W = c.inp[I_ADAW] + (size_t)l * 1024 * 6144 + col;
            float a0 = 0.f, a1 = 0.f, a2 = 0.f;
            const int kb = c.wave * 128;
#pragma unroll 8
            for (int k = 0; k < 128; ++k) { const float w = W[(size_t)(kb + k) * 6144];
                a0 += silu_f(c.inp[I_C][kb + k]) * w; a1 += silu_f(c.inp[I_C][1024 + kb + k]) * w; a2 += silu_f(c.inp[I_CCTX][kb + k]) * w; }
            red[(c.wave * 3 + 0) * 64 + c.lane] = a0; red[(c.wave * 3 + 1) * 64 + c.lane] = a1; red[(c.wave * 3 + 2) * 64 + c.lane] = a2;
            WG_SYNC();
            if (c.wave < 3) { float s = 0.f;
#pragma unroll
                for (int w = 0; w < 8; ++w) s += red[(w * 3 + c.wave) * 64 + c.lane];
                modv[(size_t)(l * 3 + c.wave) * 6144 + col] = s + c.inp[I_ADAB][l * 6144 + col]; }
            WG_SYNC();
        }
    }
    {
        LAS float* scr = (LAS float*)(c.lds + RING_OFF + c.wave * 16384);
        const int gw = c.vcu * NWAVES + c.wave, NGW = c.G * NWAVES;
        constexpr int I_IN = 16 * 48, I_OUT = 16 * 32, I_GLU = 4 * 8;
        constexpr int NIT = 2 * (I_IN + I_OUT + I_GLU);
        for (int it = gw; it < NIT; it += NGW) {
            int r = it; const int l = r / (I_IN + I_OUT + I_GLU); r %= (I_IN + I_OUT + I_GLU);
            if (r < I_IN) { transpose_item(c.inp[I_WIN] + (size_t)l * 1024 * INW, 1024, INW, (bf16*)(c.ws + WS_WIN) + (size_t)l * INW * 1024, 0, scr, r, c.lane); continue; } r -= I_IN;
            if (r < I_OUT) { transpose_item(c.inp[I_WOUT] + (size_t)l * 1024 * 1024, 1024, 1024, (bf16*)(c.ws + WS_WOUT) + (size_t)l * 1024 * 1024, 0, scr, r, c.lane); continue; } r -= I_OUT;
            transpose_item(c.inp[I_GLUW] + (size_t)l * 256 * 256, 256, 256, (bf16*)(c.ws + WS_WGLU) + (size_t)l * 256 * 256, 0, scr, r, c.lane);
        }
        bf16* wsgu = (bf16*)(c.ws + WS_WSGU);
        for (int i = c.vcu * 512 + c.tid; i < 131072 / 8; i += c.G * 512) { const GAS float* s = c.inp[I_SGUW] + (size_t)i * 8;
            v4u o; o.x = pk2(s[0], s[1]); o.y = pk2(s[2], s[3]); o.z = pk2(s[4], s[5]); o.w = pk2(s[6], s[7]); *(GAS v4u*)(wsgu + (size_t)i * 8) = o; }
    }
    {
        f32x2* POW = (f32x2*)(c.ws + WS_POW); f32x2* BBAR = (f32x2*)(c.ws + WS_BBAR);
        for (int idx = c.vcu * 512 + c.tid; idx < 2 * 2 * 16 * 64; idx += c.G * 512) {
            const double lr = (double)c.inp[I_LRE][idx], li = (double)c.inp[I_LIM][idx], dt = exp((double)c.inp[I_LOGDT][idx >> 6]);
            for (int k = 0; k < 19; ++k) { const double kk = (k == 17) ? 256.0 : (k == 18) ? 2080.0 : (double)k; const double mag = exp(lr * dt * kk), ang = li * dt * kk;
                POW[(size_t)idx * POWS + k] = (f32x2){(float)(mag * cos(ang)), (float)(mag * sin(ang))}; }
            const double mag = exp(lr * dt), ang = li * dt; const double abr = mag * cos(ang), abi = mag * sin(ang);
            const double nr = abr - 1.0, ni = abi, den = lr * lr + li * li;
            const double cr = (nr * lr + ni * li) / den, ci = (ni * lr - nr * li) / den;
            for (int ch = 0; ch < 16; ++ch) { const double br = (double)c.inp[I_BRE][(size_t)idx * 16 + ch], bi = (double)c.inp[I_BIM][(size_t)idx * 16 + ch];
                BBAR[(size_t)idx * 16 + ch] = (f32x2){(float)(cr * br - ci * bi), (float)(cr * bi + ci * br)}; }
        }
    }
    { f32x2* ROPE = (f32x2*)(c.ws + WS_ROPE);
      for (int i = c.vcu * 512 + c.tid; i < 256 * 16; i += c.G * 512) { const int pos = i >> 4, f = i & 15;
          const double inv = exp2(-(double)(2 * f) * (13.287712379549449 / 32.0)), ang = (double)pos * inv; ROPE[i] = (f32x2){(float)cos(ang), (float)sin(ang)}; } }
    convert_experts(c, 0, 0, 3, 0);
}

__device__ __forceinline__ void p0b_tables(const Ctx& c_) { Ctx c = c_; asm volatile("" : "+s"(c.ws), "+s"(c.inp), "+s"(c.out), "+v"(c.tid)); c.lane = c.tid & 63;
    const GAS f32x2* POW = (const GAS f32x2*)(c.ws + WS_POW); const GAS f32x2* BBAR = (const GAS f32x2*)(c.ws + WS_BBAR);
    bf16* EB = (bf16*)(c.ws + WS_EB);
    const int gt = c.vcu * 512 + c.tid, NT = c.G * 512;
    for (int it = gt; it < 262144; it += NT) {
        const int k0 = (it & 31) * 8, n = (it >> 5) & 255, g = (it >> 13) & 15, l = it >> 17;
        const int d = n >> 7, p = (n & 127) >> 1, ri = n & 1, s = k0 >> 4, c0 = k0 & 15;
        const int cidx = ((l * 2 + d) * 16 + g) * 64 + p;
        const f32x2 pw = POW[(size_t)cidx * POWS + (d == 0 ? 15 - s : s)];
        float v[8];
#pragma unroll
        for (int j = 0; j < 8; ++j) { const f32x2 bb = BBAR[(size_t)cidx * 16 + c0 + j]; v[j] = ri ? (pw.x * bb.y + pw.y * bb.x) : (pw.x * bb.x - pw.y * bb.y); }
        v4u o; o.x = pk2(v[0], v[1]); o.y = pk2(v[2], v[3]); o.z = pk2(v[4], v[5]); o.w = pk2(v[6], v[7]);
        *(GAS v4u*)(EB + ((size_t)((l * 16 + g) * 256 + n)) * 256 + k0) = o;
    }
    float* KT = (float*)(c.ws + WS_KTAB);
    for (int it = gt; it < 32768; it += NT) {
        const int c0 = (it & 1) * 8, ch = (it >> 1) & 15, dl = (it >> 5) & 15, d = (it >> 9) & 1, g = (it >> 10) & 15, l = it >> 14;
        const int cb = ((l * 2 + d) * 16 + g) * 64; const size_t cofs = ((size_t)((l * 2 + d) * 16 + g) * 16 + ch) * 64;
        float v[8];
#pragma unroll
        for (int j = 0; j < 8; ++j) v[j] = 0.f;
        for (int p = 0; p < 64; ++p) {
            const float cre = c.inp[I_CRE][cofs + p], cim = c.inp[I_CIM][cofs + p];
            const f32x2 pw = POW[(size_t)(cb + p) * POWS + dl];
            const float wr = cre * pw.x - cim * pw.y, wi = cre * pw.y + cim * pw.x;
#pragma unroll
            for (int j = 0; j < 8; ++j) { const f32x2 bb = BBAR[(size_t)(cb + p) * 16 + c0 + j]; v[j] += wr * bb.x - wi * bb.y; }
        }
        float* dst = KT + ((size_t)(((l * 16 + g) * 2 + d) * 16 + dl) * 16 + ch) * 16 + c0;
        *(GAS f32x4*)dst = (f32x4){v[0], v[1], v[2], v[3]}; *(GAS f32x4*)(dst + 4) = (f32x4){v[4], v[5], v[6], v[7]};
    }
}
__device__ __forceinline__ void tg_assemble(const Ctx& c_) { Ctx c = c_; asm volatile("" : "+s"(c.ws), "+s"(c.inp), "+s"(c.out), "+v"(c.tid)); c.lane = c.tid & 63;
    const GAS f32x2* POW = (const GAS f32x2*)(c.ws + WS_POW); const GAS float* KT = (const GAS float*)(c.ws + WS_KTAB); bf16* TG = (bf16*)(c.ws + WS_TG);
    const int gt = c.vcu * 512 + c.tid, NT = c.G * 512;
    for (int it = gt; it < 524288; it += NT) {
        const int k0 = (it & 63) * 8, n = (it >> 6) & 255, g = (it >> 14) & 15, l = it >> 18;
        const int tau = n >> 4, ch = n & 15;
        float v[8];
        if (k0 < 256) {
            const int s = k0 >> 4, c0 = k0 & 15;
#pragma unroll
            for (int j = 0; j < 8; ++j) v[j] = (s == tau && (c0 + j) == ch) ? c.inp[I_S5D][l * 256 + g * 16 + ch] : 0.f;
#pragma unroll
            for (int d = 0; d < 2; ++d) { const int dl = d == 0 ? tau - s : s - tau;
                if (dl >= 0) { const GAS float* kp = KT + ((size_t)(((l * 16 + g) * 2 + d) * 16 + dl) * 16 + ch) * 16 + c0; const f32x4 k0v = *(const GAS f32x4*)kp, k1v = *(const GAS f32x4*)(kp + 4);
                    v[0] += k0v[0]; v[1] += k0v[1]; v[2] += k0v[2]; v[3] += k0v[3]; v[4] += k1v[0]; v[5] += k1v[1]; v[6] += k1v[2]; v[7] += k1v[3]; } }
        } else {
#pragma unroll
            for (int j = 0; j < 8; ++j) { const int kk = k0 - 256 + j, d = kk >> 7, p = (kk & 127) >> 1, ri = kk & 1;
                const int cidx = ((l * 2 + d) * 16 + g) * 64 + p;
                const float cre = c.inp[I_CRE][((size_t)((l * 2 + d) * 16 + g) * 16 + ch) * 64 + p], cim = c.inp[I_CIM][((size_t)((l * 2 + d) * 16 + g) * 16 + ch) * 64 + p];
                const f32x2 pw = POW[(size_t)cidx * POWS + (d == 0 ? tau + 1 : 16 - tau)];
                const float wr = cre * pw.x - cim * pw.y, wi = cre * pw.y + cim * pw.x;
                v[j] = ri ? -wi : wr; }
        }
        v4u o; o.x = pk2(v[0], v[1]); o.y = pk2(v[2], v[3]); o.z = pk2(v[4], v[5]); o.w = pk2(v[6], v[7]);
        *(GAS v4u*)(TG + ((size_t)((l * 16 + g) * 256 + n)) * 512 + k0) = o;
    }
}

__device__ __forceinline__ void row_prep(const Ctx& c_, int mode, int l) { Ctx c = c_; asm volatile("" : "+s"(c.ws), "+s"(c.inp), "+s"(c.out), "+v"(c.tid)); c.lane = c.tid & 63; asm volatile("" : "+s"(l));
    const int gw = c.vcu * NWAVES + c.wave, NGW = c.G * NWAVES;
    const GAS float* modv = (const GAS float*)(c.ws + WS_MODV);
    const GAS bf16* Y = (const GAS bf16*)(c.ws + WS_R3); GAS bf16* A1 = (GAS bf16*)(c.ws + WS_R1);
    const GAS int* smapL = (const GAS int*)(c.ws + WS_SMAP); const GAS int* smapC = smapL + 2 * 16 * 16384;
    GAS float* hctx = (GAS float*)(c.ws + WS_HCTX);
    const int nrows = (mode == 2) ? MLAT : MT;
    float dscale = 1.0f;
#if defined(TPROBE) || defined(TPROBE_UNIT)
    if (mode == 2) {
#if defined(TPROBE_UNIT)
        const unsigned su = __hip_atomic_load(c.ctl + CW_TS + 40, RLX_AGENT), cn = __hip_atomic_load(c.ctl + CW_TS + 41, RLX_AGENT);
        dscale = 1.0f + floorf((cn ? (float)su / (float)cn : 0.f) * (0.01f / TPQ) + 0.5f) * (TPQ / 1000.0f);
#else
        const unsigned ta = __hip_atomic_load(c.ctl + CW_TS + TPROBE, RLX_AGENT), tb = __hip_atomic_load(c.ctl + CW_TS + TPROBE + 1, RLX_AGENT);
        dscale = 1.0f + floorf((float)(tb - ta) * (0.01f / TPQ) + 0.5f) * (TPQ / 1000.0f);
#endif
    }
#endif
#define RP_LOAD_X(M0, DST) do { const int m0_ = (M0); const bool ic_ = m0_ >= MLAT; _Pragma("unroll") for (int q = 0; q < 4; ++q) { const int m_ = m0_ + q; \
        const GAS float* src_ = ic_ ? c.inp[I_CTX] + (size_t)(m_ - MLAT) * D : c.inp[I_X] + (size_t)m_ * D; \
        _Pragma("unroll") for (int j = 0; j < 4; ++j) DST[q][j] = *(const GAS f32x4*)(src_ + 4 * c.lane + 256 * j); } } while (0)
    f32x4 vnx[4][4];
    if (mode == 0 && gw * 4 < nrows) RP_LOAD_X(gw * 4, vnx);
    for (int m0 = gw * 4; m0 < nrows; m0 += NGW * 4) {
        const bool isctx = m0 >= MLAT; const int b = isctx ? ((m0 - MLAT) >> 8) : (m0 >> 14), mb = isctx ? 2 : b;
        f32x4 v[4][4];
        if (mode == 0) {
#pragma unroll
            for (int q = 0; q < 4; ++q)
#pragma unroll
                for (int j = 0; j < 4; ++j) v[q][j] = vnx[q][j];
            if (m0 + NGW * 4 < nrows) RP_LOAD_X(m0 + NGW * 4, vnx);
        } else
#pragma unroll
        for (int q = 0; q < 4; ++q) { const int m = m0 + q;
            if (mode != 0 && !isctx) { const GAS bf16* hb = (const GAS bf16*)c.out + (size_t)m * 2048;
#pragma unroll
                for (int j = 0; j < 4; ++j) { const u32x2 w = *(const GAS u32x2*)(hb + 4 * c.lane + 256 * j); v[q][j] = (f32x4){bf2f(w.x & 0xffffu), bf2f(w.x >> 16), bf2f(w.y & 0xffffu), bf2f(w.y >> 16)}; } }
            else { const GAS float* src = (mode == 0) ? (isctx ? c.inp[I_CTX] + (size_t)(m - MLAT) * D : c.inp[I_X] + (size_t)m * D) : hctx + (size_t)(m - MLAT) * D;
#pragma unroll
                for (int j = 0; j < 4; ++j) v[q][j] = *(const GAS f32x4*)(src + 4 * c.lane + 256 * j); } }
        if (mode != 0) {
            const GAS float* gff = modv + (size_t)((l - 1 + (mode == 2 ? 1 : 0)) * 3 + mb) * 6144 + 5 * 1024;
            f32x4 acc[4][4]; int myslot[4]; unsigned long long msk[4];
#pragma unroll
            for (int q = 0; q < 4; ++q) { const int m = m0 + q, t = isctx ? ((m - MLAT) & 255) : (m & 16383);
                myslot[q] = (c.lane < NE) ? (isctx ? smapC[(b * 16 + c.lane) * 256 + t] : smapL[(b * 16 + c.lane) * 16384 + t]) : -1;
#pragma unroll
                for (int j = 0; j < 4; ++j) acc[q][j] = (f32x4){0.f, 0.f, 0.f, 0.f}; }
#pragma unroll
            for (int q = 0; q < 4; ++q) msk[q] = __ballot(myslot[q] >= 0);
            while (msk[0] | msk[1] | msk[2] | msk[3]) {
                u32x2 w[4][4]; float f[4];
#pragma unroll
                for (int q = 0; q < 4; ++q) { const bool has = msk[q] != 0; const int e = has ? __builtin_ctzll(msk[q]) : 0; if (has) msk[q] &= msk[q] - 1;
                    const int sl = __shfl(myslot[q], e); f[q] = has ? 1.0f : 0.0f;
                    const size_t y = !has ? (size_t)0 : isctx ? (size_t)(XLAT + e * 256 + b * 32 + sl) : (size_t)((b * 16 + e) * CAPL + sl);
#pragma unroll
                    for (int j = 0; j < 4; ++j) w[q][j] = *(const GAS u32x2*)(Y + y * D + 4 * c.lane + 256 * j); }
#pragma unroll
                for (int q = 0; q < 4; ++q)
#pragma unroll
                    for (int j = 0; j < 4; ++j) acc[q][j] += (f32x4){bf2f(w[q][j].x & 0xffffu), bf2f(w[q][j].x >> 16), bf2f(w[q][j].y & 0xffffu), bf2f(w[q][j].y >> 16)} * f[q];
            }
#pragma unroll
            for (int q = 0; q < 4; ++q) { const int m = m0 + q;
#pragma unroll
                for (int j = 0; j < 4; ++j) { v[q][j] += *(const GAS f32x4*)(gff + 4 * c.lane + 256 * j) * acc[q][j];
                    if (mode == 2) *(GAS f32x4*)(c.out + (size_t)m * D + 4 * c.lane + 256 * j) = v[q][j] * dscale;
                    else if (isctx) *(GAS f32x4*)(hctx + (size_t)(m - MLAT) * D + 4 * c.lane + 256 * j) = v[q][j];
                    else { u32x2 w; w.x = pk2(v[q][j].x, v[q][j].y); w.y = pk2(v[q][j].z, v[q][j].w); *(GAS u32x2*)((GAS bf16*)c.out + (size_t)m * 2048 + 4 * c.lane + 256 * j) = w; } } }
        }
        if (mode == 2) continue;
        float rstd[4];
#pragma unroll
        for (int q = 0; q < 4; ++q) { float ss = 0.f;
#pragma unroll
            for (int j = 0; j < 4; ++j) ss += (v[q][j].x * v[q][j].x + v[q][j].y * v[q][j].y) + (v[q][j].z * v[q][j].z + v[q][j].w * v[q][j].w);
            rstd[q] = ss; }
#pragma unroll
        for (int o = 1; o < 64; o <<= 1) {
#pragma unroll
            for (int q = 0; q < 4; ++q) rstd[q] += __shfl_xor(rstd[q], o); }
#pragma unroll
        for (int q = 0; q < 4; ++q) rstd[q] = 1.0f / sqrtf(rstd[q] * (1.0f / D) + EPS);
        const GAS float* mo = modv + (size_t)(l * 3 + mb) * 6144; const GAS float* gn = c.inp[I_NMIXG] + l * D;
#pragma unroll
        for (int j = 0; j < 4; ++j) { const int col = 4 * c.lane + 256 * j;
            const f32x4 g = *(const GAS f32x4*)(gn + col), sh = *(const GAS f32x4*)(mo + col), sc = *(const GAS f32x4*)(mo + 1024 + col);
            const f32x4 gs = g * (sc + 1.0f);
#pragma unroll
            for (int q = 0; q < 4; ++q) { const f32x4 a = v[q][j] * rstd[q] * gs + sh;
                u32x2 w; w.x = pk2(a.x, a.y); w.y = pk2(a.z, a.w); *(GAS u32x2*)(A1 + (size_t)(m0 + q) * D + col) = w; } }
    }
}
#undef RP_LOAD_X

__device__ __forceinline__ f32x4 mfma16(bf16x8 a, bf16x8 b, f32x4 c) { return __builtin_amdgcn_mfma_f32_16x16x32_bf16(a, b, c, 0, 0, 0); }
__device__ __forceinline__ f32x16 mfma32(bf16x8 a, bf16x8 b, f32x16 c) { return __builtin_amdgcn_mfma_f32_32x32x16_bf16(a, b, c, 0, 0, 0); }

__device__ __forceinline__ void qk_prep_rows(const Ctx& c_, int l) { Ctx c = c_; asm volatile("" : "+s"(c.ws), "+s"(c.inp), "+s"(c.out), "+v"(c.tid)); c.lane = c.tid & 63; asm volatile("" : "+s"(l));
    bf16* P = (bf16*)(c.ws + WS_R2); const GAS f32x2* ROPE = (const GAS f32x2*)(c.ws + WS_ROPE);
    const int j = c.lane & 7, rsub = c.lane >> 4, chunk = c.lane & 15;
    const f32x4 kg0 = *(const GAS f32x4*)(c.inp[I_KNG] + l * 64 + 8 * j), kg1 = *(const GAS f32x4*)(c.inp[I_KNG] + l * 64 + 8 * j + 4);
    const float kgn[8] = {kg0[0], kg0[1], kg0[2], kg0[3], kg1[0], kg1[1], kg1[2], kg1[3]};
#pragma unroll 2
    for (int blk = c.vcu * NWAVES + c.wave; blk < MT / 4; blk += c.G * NWAVES) {
        const int m = blk * 4 + rsub;
        const bool isctx = m >= MLAT;
        bf16* kp = P + (size_t)m * INW + 512 + 8 * chunk;
        const v4u w = *(const GAS v4u*)kp; const unsigned ws4[4] = {w.x, w.y, w.z, w.w};
        float cs[8], sn[8];
        if (!isctx) { const int n = m & 16383, pos = (j < 4) ? (n >> 6) : (n & 63); const GAS f32x4* tp = (const GAS f32x4*)(ROPE + pos * 16 + 8 * (j & 1));
#pragma unroll
            for (int q = 0; q < 4; ++q) { const f32x4 t4 = tp[q]; cs[2 * q] = t4[0]; sn[2 * q] = t4[1]; cs[2 * q + 1] = t4[2]; sn[2 * q + 1] = t4[3]; } }
        else {
#pragma unroll
            for (int e = 0; e < 8; ++e) { cs[e] = 1.f; sn[e] = 0.f; } }
        float x[8]; float ss = 0.f;
#pragma unroll
        for (int e = 0; e < 8; ++e) { x[e] = __uint_as_float((e & 1) ? (ws4[e >> 1] & 0xffff0000u) : (ws4[e >> 1] << 16)); ss += x[e] * x[e]; }
        ss += __shfl_xor(ss, 1); ss += __shfl_xor(ss, 2); ss += __shfl_xor(ss, 4);
        const float rstd = 1.0f / sqrtf(ss * (1.0f / 64.0f) + EPS);
        float o[8];
#pragma unroll
        for (int e = 0; e < 8; ++e) { const float xn = x[e] * rstd * kgn[e]; const float pr = __shfl_xor(xn, 2);
            o[e] = (j & 2) ? (xn * cs[e] + pr * sn[e]) : (xn * cs[e] - pr * sn[e]); }
        v4u ow; ow.x = pk2(o[0], o[1]); ow.y = pk2(o[2], o[3]); ow.z = pk2(o[4], o[5]); ow.w = pk2(o[6], o[7]);
        *(GAS v4u*)kp = ow;
    }
}
__device__ __forceinline__ int s5_scan_sc(int q, int b, int d) { return q < 16 ? (2048 + 16 * b + (d ? 15 - q : q)) : (b * 1024 + (d ? 1039 - q : q - 16)); }
__device__ __forceinline__ void s5_scan_unit(const Ctx& c_, int l, int unit) { Ctx c = c_; asm volatile("" : "+s"(c.ws), "+s"(c.inp), "+s"(c.out), "+v"(c.tid)); c.lane = c.tid & 63; asm volatile("" : "+s"(l));
    const int g = unit & 15, d = (unit >> 4) & 1, b = unit >> 5;
    const GAS float* E = (const GAS float*)(c.ws + WS_R2 + OFF_E) + (size_t)g * 2304 * 256 + d * 128 + 2 * c.lane;
    bf16* Am = (bf16*)(c.ws + WS_R1 + OFF_AMAT) + (size_t)g * 2304 * 512 + 256 + d * 128 + 2 * c.lane;
    const GAS f32x2* POW = (const GAS f32x2*)(c.ws + WS_POW) + (size_t)(((l * 2 + d) * 16 + g) * 64 + c.lane) * POWS;
    const f32x2 a16 = POW[16], aseg = POW[18];
    LAS f32x2* X = (LAS f32x2*)(c.lds + RING_OFF);
    const int q0 = 130 * c.wave;
    float hr = 0.f, hi = 0.f;
#pragma unroll 1
    for (int s0 = 0; s0 < 130; s0 += 26) {
        f32x2 e[26];
#pragma unroll
        for (int j = 0; j < 26; ++j) e[j] = *(const GAS f32x2*)(E + (size_t)s5_scan_sc(q0 + s0 + j, b, d) * 256);
#pragma unroll
        for (int j = 0; j < 26; ++j) { const float nr = a16.x * hr - a16.y * hi + e[j].x, ni = a16.x * hi + a16.y * hr + e[j].y; hr = nr; hi = ni; }
    }
    __syncthreads();
    X[c.wave * 64 + c.lane] = (f32x2){hr, hi};
    LDS_WAIT(); __syncthreads();
    hr = 0.f; hi = 0.f;
    for (int w = 0; w < c.wave; ++w) { const f32x2 x = X[w * 64 + c.lane]; const float nr = aseg.x * hr - aseg.y * hi + x.x, ni = aseg.x * hi + aseg.y * hr + x.y; hr = nr; hi = ni; }
#pragma unroll 1
    for (int s0 = 0; s0 < 130; s0 += 26) {
        f32x2 e[26];
#pragma unroll
        for (int j = 0; j < 26; ++j) e[j] = *(const GAS f32x2*)(E + (size_t)s5_scan_sc(q0 + s0 + j, b, d) * 256);
#pragma unroll
        for (int j = 0; j < 26; ++j) { *(GAS unsigned*)(Am + (size_t)s5_scan_sc(q0 + s0 + j, b, d) * 512) = pk2(hr, hi);
            const float nr = a16.x * hr - a16.y * hi + e[j].x, ni = a16.x * hi + a16.y * hr + e[j].y; hr = nr; hi = ni; }
    }
}

constexpr int ATT_ROWB = 144;
constexpr int ATT_TILEB = 64 * ATT_ROWB, ATT_BUFB = 4 * ATT_TILEB;
constexpr float ATT_SUMMAX = 1099511627776.0f;
template <bool FAST> __device__ __forceinline__ bool attn_unit_t(const Ctx& c_, int l, int unit) { Ctx c = c_; asm volatile("" : "+s"(c.ws), "+s"(c.inp), "+s"(c.out), "+v"(c.tid)); c.lane = c.tid & 63; asm volatile("" : "+s"(l));
    const GAS bf16* P = (const GAS bf16*)(c.ws + WS_R2); GAS bf16* mix = (GAS bf16*)(c.ws + WS_R1);
    int b, kvh, qb; bool isctx;
    if (unit < 512) { b = unit >> 8; kvh = (unit >> 7) & 1; qb = unit & 127; isctx = false; }
    else { const int u2 = unit - 512; b = u2 >> 2; kvh = (u2 >> 1) & 1; qb = u2 & 1; isctx = true; }
    const int r32 = c.lane & 31, hi = c.lane >> 5, wsub = c.wave >> 2;
    const int hq = kvh * 4 + (c.wave & 3);
    const float sink2 = c.inp[I_SINK][l * 8 + hq] * LOG2E;
    const int q4 = (c.lane & 15) >> 2, p4 = c.lane & 3, d0 = 16 * ((c.lane >> 4) & 1);
    const int vlane_off = (4 * hi + q4) * ATT_ROWB + (d0 + 4 * p4) * 2;
    const int qrow0 = (isctx ? (MLAT + b * LC + qb * 128) : (b * SEQ + qb * 128)) + 64 * wsub + r32;
    const int key = c.tid >> 3, chk = c.tid & 7;
    int p = isctx ? 3 : 0;
    while (p < 3 && (128 * (qb - 1 + p) < 0 || 128 * (qb - 1 + p) >= SEQ)) ++p;
    int pn = p + 1;
    while (pn < 3 && (128 * (qb - 1 + pn) < 0 || 128 * (qb - 1 + pn) >= SEQ)) ++pn;
    v4u kv[2], vv[2];
#define ATT_LOAD(PP) do { const int krow_ = ((PP) < 3 ? b * SEQ + 128 * (qb - 1 + (PP)) : MLAT + b * LC + 128 * ((PP) - 3)) + key; const GAS bf16* src_ = P + (size_t)krow_ * INW + 64 * kvh + 8 * chk; \
        kv[0] = *(const GAS v4u*)(src_ + 512); vv[0] = *(const GAS v4u*)(src_ + 640); kv[1] = *(const GAS v4u*)(src_ + 64 * INW + 512); vv[1] = *(const GAS v4u*)(src_ + 64 * INW + 640); } while (0)
#define ATT_STORE(BUF) do { LAS unsigned char* d_ = c.lds + (BUF) * ATT_BUFB + key * ATT_ROWB + chk * 16; \
        *(LAS v4u*)(d_) = kv[0]; *(LAS v4u*)(d_ + ATT_TILEB) = kv[1]; *(LAS v4u*)(d_ + 2 * ATT_TILEB) = vv[0]; *(LAS v4u*)(d_ + 3 * ATT_TILEB) = vv[1]; } while (0)
    ATT_LOAD(p);
    bf16x8 qf[2][4];
#pragma unroll
    for (int qg = 0; qg < 2; ++qg)
#pragma unroll
        for (int ks = 0; ks < 4; ++ks) qf[qg][ks] = *(const GAS bf16x8*)(P + (size_t)(qrow0 + 32 * qg) * INW + 64 * hq + 16 * ks + 8 * hi);
    { const GAS f32x2* ROPE = (const GAS f32x2*)(c.ws + WS_ROPE);
      float qgn[4][8];
#pragma unroll
      for (int ks = 0; ks < 4; ++ks) { const f32x4 g0 = *(const GAS f32x4*)(c.inp[I_QNG] + l * 64 + 16 * ks + 8 * hi), g1 = *(const GAS f32x4*)(c.inp[I_QNG] + l * 64 + 16 * ks + 8 * hi + 4);
          qgn[ks][0] = g0[0]; qgn[ks][1] = g0[1]; qgn[ks][2] = g0[2]; qgn[ks][3] = g0[3]; qgn[ks][4] = g1[0]; qgn[ks][5] = g1[1]; qgn[ks][6] = g1[2]; qgn[ks][7] = g1[3]; }
#pragma unroll
      for (int qg = 0; qg < 2; ++qg) {
          float x[4][8]; float ss = 0.f;
#pragma unroll
          for (int ks = 0; ks < 4; ++ks) { const v4u w = __builtin_bit_cast(v4u, qf[qg][ks]); const unsigned ws4[4] = {w.x, w.y, w.z, w.w};
#pragma unroll
              for (int e = 0; e < 8; ++e) { x[ks][e] = __uint_as_float((e & 1) ? (ws4[e >> 1] & 0xffff0000u) : (ws4[e >> 1] << 16)); ss += x[ks][e] * x[ks][e]; } }
          ss += __shfl_xor(ss, 32);
          const float rstd = 1.0f / sqrtf(ss * (1.0f / 64.0f) + EPS) * (0.125f * LOG2E);
#pragma unroll
          for (int ks = 0; ks < 4; ++ks)
#pragma unroll
              for (int e = 0; e < 8; ++e) x[ks][e] *= rstd * qgn[ks][e];
          if (!isctx) { const int n = qb * 128 + 64 * wsub + 32 * qg + r32;
#pragma unroll
              for (int ax = 0; ax < 2; ++ax) { const int pos = ax == 0 ? (n >> 6) : (n & 63); const GAS f32x4* tp = (const GAS f32x4*)(ROPE + pos * 16 + 8 * hi);
#pragma unroll
                  for (int q = 0; q < 4; ++q) { const f32x4 t4 = tp[q];
#pragma unroll
                      for (int h2 = 0; h2 < 2; ++h2) { const int e = 2 * q + h2; const float cs = t4[2 * h2], sn = t4[2 * h2 + 1];
                          const float x1 = x[2 * ax][e], x2 = x[2 * ax + 1][e]; x[2 * ax][e] = x1 * cs - x2 * sn; x[2 * ax + 1][e] = x2 * cs + x1 * sn; } } } }
#pragma unroll
          for (int ks = 0; ks < 4; ++ks) { v4u w; w.x = pk2(x[ks][0], x[ks][1]); w.y = pk2(x[ks][2], x[ks][3]); w.z = pk2(x[ks][4], x[ks][5]); w.w = pk2(x[ks][6], x[ks][7]); qf[qg][ks] = __builtin_bit_cast(bf16x8, w); }
      } }
    float m_run[2], l_run[2]; f32x16 o[2][2];
    const float sinkp = __builtin_amdgcn_exp2f(sink2); bool bad = FAST && !(sinkp <= 3.0e38f);
#pragma unroll
    for (int qg = 0; qg < 2; ++qg) { m_run[qg] = FAST ? 0.f : sink2; l_run[qg] = hi == 0 ? (FAST ? sinkp : 1.0f) : 0.0f;
#pragma unroll
        for (int dt = 0; dt < 2; ++dt)
#pragma unroll
            for (int r = 0; r < 16; ++r) o[qg][dt][r] = 0.f; }
    if (FAST && c.tid == 0) c.MISC[24] = 0u;
    __syncthreads();
    ATT_STORE(0);
    if (pn < 5) ATT_LOAD(pn);
    LDS_WAIT(); __syncthreads();
    int cur = 0;
#pragma unroll 1
    while (p < 5) {
        int pnn = pn + 1;
        while (pnn < 3 && (128 * (qb - 1 + pnn) < 0 || 128 * (qb - 1 + pnn) >= SEQ)) ++pnn;
        if (pn < 5) { ATT_STORE(cur ^ 1); if (pnn < 5) ATT_LOAD(pnn); }
        const bool win = p < 3;
#pragma unroll (FAST ? 2 : 1)
        for (int sb = 0; sb < 2; ++sb) {
            const int t = 2 * p + sb;
            LAS unsigned char* kbase = c.lds + cur * ATT_BUFB + sb * ATT_TILEB; LAS unsigned char* vbase = kbase + 2 * ATT_TILEB;
            bool skip[2] = {false, false}, need_mask[2] = {false, false};
            if (win) {
    #pragma unroll
                for (int qg = 0; qg < 2; ++qg) { const int qlo = 128 * qb + 64 * wsub + 32 * qg, klo = 128 * (qb - 1) + 64 * t, dmax = klo + 63 - qlo, dmin = klo - qlo - 31;
                    skip[qg] = dmin > 128 || dmax < -128; need_mask[qg] = dmax > 128 || dmin < -128; } }
            if (!(skip[0] && skip[1])) {
                bf16x8 kf[8];
    #pragma unroll
                for (int ks = 0; ks < 4; ++ks) { kf[2 * ks] = *(const LAS bf16x8*)(kbase + r32 * ATT_ROWB + (16 * ks + 8 * hi) * 2);
                    kf[2 * ks + 1] = *(const LAS bf16x8*)(kbase + (32 + r32) * ATT_ROWB + (16 * ks + 8 * hi) * 2); }
                bf16x8 pf[2][4];
    #pragma unroll
                for (int qg = 0; qg < 2; ++qg) {
                    if (!skip[qg]) {
                        f32x16 s0, s1; { const float nm = FAST ? 0.f : -m_run[qg];
    #pragma unroll
                            for (int r = 0; r < 16; ++r) { s0[r] = nm; s1[r] = nm; } }
    #pragma unroll
                        for (int ks = 0; ks < 4; ++ks) { s0 = mfma32(kf[2 * ks], qf[qg][ks], s0); s1 = mfma32(kf[2 * ks + 1], qf[qg][ks], s1); }
                        if (need_mask[qg]) {
                            const int qp = 128 * qb + 64 * wsub + 32 * qg + r32, kb = 128 * (qb - 1) + 64 * t + 4 * hi;
    #pragma unroll
                            for (int r = 0; r < 16; ++r) { const int dk = kb + (r & 3) + 8 * (r >> 2) - qp;
                                if (dk > 128 || dk < -128) s0[r] = -INFINITY;
                                if (dk + 32 > 128 || dk + 32 < -128) s1[r] = -INFINITY; }
                        }
                        if constexpr (FAST) {
                            float sm[4] = {0.f, 0.f, 0.f, 0.f};
    #pragma unroll
                            for (int r = 0; r < 16; ++r) { s0[r] = __builtin_amdgcn_exp2f(s0[r]); s1[r] = __builtin_amdgcn_exp2f(s1[r]); float t2 = s0[r] + s1[r]; asm("" : "+v"(t2)); sm[r & 3] = r < 4 ? t2 : sm[r & 3] + t2; asm("" : "+v"(sm[r & 3])); }
                            const float st = (sm[0] + sm[1]) + (sm[2] + sm[3]);
                            bad = bad || !(st <= ATT_SUMMAX);
                            l_run[qg] += st;
    #pragma unroll
                            for (int s2 = 0; s2 < 2; ++s2) {
                                v4u pw; pw.x = pk2(s0[8 * s2 + 0], s0[8 * s2 + 1]); pw.y = pk2(s0[8 * s2 + 2], s0[8 * s2 + 3]); pw.z = pk2(s0[8 * s2 + 4], s0[8 * s2 + 5]); pw.w = pk2(s0[8 * s2 + 6], s0[8 * s2 + 7]);
                                pf[qg][s2] = __builtin_bit_cast(bf16x8, pw);
                                v4u pv; pv.x = pk2(s1[8 * s2 + 0], s1[8 * s2 + 1]); pv.y = pk2(s1[8 * s2 + 2], s1[8 * s2 + 3]); pv.z = pk2(s1[8 * s2 + 4], s1[8 * s2 + 5]); pv.w = pk2(s1[8 * s2 + 6], s1[8 * s2 + 7]);
                                pf[qg][2 + s2] = __builtin_bit_cast(bf16x8, pv); }
                        } else {
                        f32x16 e0, e1; float st;
                        { float sm[4] = {0.f, 0.f, 0.f, 0.f};
    #pragma unroll
                          for (int r = 0; r < 16; ++r) { e0[r] = __builtin_amdgcn_exp2f(s0[r]); e1[r] = __builtin_amdgcn_exp2f(s1[r]); float t2 = e0[r] + e1[r]; asm("" : "+v"(t2)); sm[r & 3] = r < 4 ? t2 : sm[r & 3] + t2; asm("" : "+v"(sm[r & 3])); }
                          st = (sm[0] + sm[1]) + (sm[2] + sm[3]); }
                        if (__any(!(st <= ATT_SUMMAX))) {
                            float mxa[8];
    #pragma unroll
                            for (int i = 0; i < 8; ++i) mxa[i] = fmaxf(fmaxf(s0[i], s0[i + 8]), fmaxf(s1[i], s1[i + 8]));
                            float mx = fmaxf(fmaxf(fmaxf(mxa[0], mxa[1]), fmaxf(mxa[2], mxa[3])), fmaxf(fmaxf(mxa[4], mxa[5]), fmaxf(mxa[6], mxa[7])));
                            mx = fmaxf(mx, __shfl_xor(mx, 32));
                            const float dl = fmaxf(mx, 0.f), alpha = __builtin_amdgcn_exp2f(-dl);
                            m_run[qg] += dl; l_run[qg] *= alpha;
    #pragma unroll
                            for (int dt = 0; dt < 2; ++dt)
    #pragma unroll
                                for (int r = 0; r < 16; ++r) o[qg][dt][r] *= alpha;
                            float sm[4] = {0.f, 0.f, 0.f, 0.f};
    #pragma unroll
                            for (int r = 0; r < 16; ++r) { e0[r] = __builtin_amdgcn_exp2f(s0[r] - dl); e1[r] = __builtin_amdgcn_exp2f(s1[r] - dl); sm[r & 3] += e0[r] + e1[r]; }
                            st = (sm[0] + sm[1]) + (sm[2] + sm[3]);
                        }
                        l_run[qg] += st;
    #pragma unroll
                        for (int s2 = 0; s2 < 2; ++s2) {
                            v4u pw; pw.x = pk2(e0[8 * s2 + 0], e0[8 * s2 + 1]); pw.y = pk2(e0[8 * s2 + 2], e0[8 * s2 + 3]); pw.z = pk2(e0[8 * s2 + 4], e0[8 * s2 + 5]); pw.w = pk2(e0[8 * s2 + 6], e0[8 * s2 + 7]);
                            pf[qg][s2] = __builtin_bit_cast(bf16x8, pw);
                            v4u pv; pv.x = pk2(e1[8 * s2 + 0], e1[8 * s2 + 1]); pv.y = pk2(e1[8 * s2 + 2], e1[8 * s2 + 3]); pv.z = pk2(e1[8 * s2 + 4], e1[8 * s2 + 5]); pv.w = pk2(e1[8 * s2 + 6], e1[8 * s2 + 7]);
                            pf[qg][2 + s2] = __builtin_bit_cast(bf16x8, pv); }
                        }
                    } else {
    #pragma unroll
                        for (int i = 0; i < 4; ++i) pf[qg][i] = (bf16x8){0, 0, 0, 0, 0, 0, 0, 0};
                    }
                }
                bf16x8 vf[2][4];
    #pragma unroll
                for (int dt = 0; dt < 2; ++dt)
    #pragma unroll
                    for (int ks4 = 0; ks4 < 4; ++ks4) {
                        LAS unsigned char* vp = vbase + (16 * ks4) * ATT_ROWB + 64 * dt + vlane_off;
                        const v4i16_t lo = __builtin_amdgcn_ds_read_tr16_b64_v4i16((LAS v4i16_t*)vp);
                        const v4i16_t h8 = __builtin_amdgcn_ds_read_tr16_b64_v4i16((LAS v4i16_t*)(vp + 8 * ATT_ROWB));
                        vf[dt][ks4] = (bf16x8){lo[0], lo[1], lo[2], lo[3], h8[0], h8[1], h8[2], h8[3]}; }
    #pragma unroll
                for (int ks4 = 0; ks4 < 4; ++ks4)
    #pragma unroll
                    for (int dt = 0; dt < 2; ++dt)
    #pragma unroll
                        for (int qg = 0; qg < 2; ++qg) o[qg][dt] = mfma32(vf[dt][ks4], pf[qg][ks4], o[qg][dt]);
            }
        }
        LDS_WAIT(); __syncthreads();
        p = pn; pn = pnn; cur ^= 1;
    }
#undef ATT_LOAD
#undef ATT_STORE
    if constexpr (FAST) {
        if (__any(bad) && c.lane == 0) c.MISC[24] = 1u;
        LDS_WAIT(); __syncthreads();
        if (c.MISC[24] != 0u) return true;
    }
#pragma unroll
    for (int qg = 0; qg < 2; ++qg) {
        const float lt = l_run[qg] + __shfl_xor(l_run[qg], 32), il = 1.0f / lt;
        GAS bf16* orow = mix + (size_t)(qrow0 + 32 * qg) * D + 64 * hq + 4 * hi;
#pragma unroll
        for (int dt = 0; dt < 2; ++dt)
#pragma unroll
            for (int rr = 0; rr < 4; ++rr) { u32x2 w; w.x = pk2(o[qg][dt][4 * rr] * il, o[qg][dt][4 * rr + 1] * il); w.y = pk2(o[qg][dt][4 * rr + 2] * il, o[qg][dt][4 * rr + 3] * il);
                *(GAS u32x2*)(orow + 32 * dt + 8 * rr) = w; }
    }
    return false;
}

constexpr int SGU_ROWB = 528;
__device__ __forceinline__ void sgu_unit(const Ctx& c_, int l, int chunk) { Ctx c = c_; asm volatile("" : "+s"(c.ws), "+s"(c.inp), "+s"(c.out), "+v"(c.tid)); c.lane = c.tid & 63; asm volatile("" : "+s"(l));
    const bf16* P = (const bf16*)(c.ws + WS_R2); bf16* mix = (bf16*)(c.ws + WS_R1);
    const bf16* Ws = (const bf16*)(c.ws + WS_WSGU) + (size_t)l * 4 * 128 * 128;
    const int r0 = chunk * 128, fr = c.lane & 15, fq = c.lane >> 4;
    __syncthreads();
    { const f32x4 gn = *(const GAS f32x4*)(c.inp[I_SGUNG] + l * 256 + 4 * c.lane);
#pragma unroll 1
      for (int r4 = 0; r4 < 16; r4 += 4) {
        u32x2 w[4]; float v[4][4], ss[4];
#pragma unroll
        for (int q = 0; q < 4; ++q) w[q] = *(const GAS u32x2*)(P + (size_t)(r0 + c.wave * 16 + r4 + q) * INW + 1280 + 4 * c.lane);
#pragma unroll
        for (int q = 0; q < 4; ++q) { v[q][0] = gelu_tanh(bf2f(w[q].x & 0xffffu)); v[q][1] = gelu_tanh(bf2f(w[q].x >> 16)); v[q][2] = gelu_tanh(bf2f(w[q].y & 0xffffu)); v[q][3] = gelu_tanh(bf2f(w[q].y >> 16));
            ss[q] = (v[q][0] * v[q][0] + v[q][1] * v[q][1]) + (v[q][2] * v[q][2] + v[q][3] * v[q][3]); }
#pragma unroll
        for (int o = 1; o < 64; o <<= 1) {
#pragma unroll
            for (int q = 0; q < 4; ++q) ss[q] += __shfl_xor(ss[q], o); }
#pragma unroll
        for (int q = 0; q < 4; ++q) { const int s = c.wave * 16 + r4 + q; const float rstd = 1.0f / sqrtf(ss[q] * (1.0f / 256.0f) + EPS);
            u32x2 ow; ow.x = pk2(v[q][0] * rstd * gn.x, v[q][1] * rstd * gn.y); ow.y = pk2(v[q][2] * rstd * gn.z, v[q][3] * rstd * gn.w);
            *(LAS u32x2*)(c.lds + s * SGU_ROWB + 8 * c.lane) = ow; } } }
    LDS_WAIT(); __syncthreads();
    const int gg = c.wave >> 1, th = c.wave & 1;
    bf16x8 a[4][4];
#pragma unroll
    for (int mt = 0; mt < 4; ++mt)
#pragma unroll
        for (int ks = 0; ks < 4; ++ks) a[mt][ks] = *(const GAS bf16x8*)(Ws + ((size_t)gg * 128 + 64 * th + 16 * mt + fr) * 128 + 32 * ks + 8 * fq);
    u32x2 uw[4][4]; float bsv[4];
#pragma unroll
    for (int mt = 0; mt < 4; ++mt) { const int t = 64 * th + 16 * mt + fr; bsv[mt] = c.inp[I_SGUB][(l * 4 + gg) * 128 + t];
#pragma unroll
        for (int nt = 0; nt < 4; ++nt) uw[nt][mt] = *(const GAS u32x2*)(P + (size_t)(r0 + t) * INW + 1024 + 64 * gg + 16 * nt + 4 * fq); }
#pragma unroll
    for (int nt = 0; nt < 4; ++nt) {
        f32x4 acc[4];
#pragma unroll
        for (int mt = 0; mt < 4; ++mt) acc[mt] = (f32x4){0.f, 0.f, 0.f, 0.f};
#pragma unroll
        for (int ks = 0; ks < 4; ++ks) {
            LAS unsigned char* vp = c.lds + (32 * ks + 8 * fq + (fr >> 2)) * SGU_ROWB + (64 * gg + 16 * nt + 4 * (fr & 3)) * 2;
            const v4i16_t lo = __builtin_amdgcn_ds_read_tr16_b64_v4i16((LAS v4i16_t*)vp);
            const v4i16_t h8 = __builtin_amdgcn_ds_read_tr16_b64_v4i16((LAS v4i16_t*)(vp + 4 * SGU_ROWB));
            const bf16x8 bfr = (bf16x8){lo[0], lo[1], lo[2], lo[3], h8[0], h8[1], h8[2], h8[3]};
#pragma unroll
            for (int mt = 0; mt < 4; ++mt) acc[mt] = mfma16(bfr, a[mt][ks], acc[mt]); }
#pragma unroll
        for (int mt = 0; mt < 4; ++mt) { const int t = 64 * th + 16 * mt + fr, ch = 64 * gg + 16 * nt + 4 * fq;
            const float bs = bsv[mt]; const u32x2 w = uw[nt][mt];
            const float u0 = gelu_tanh(bf2f(w.x & 0xffffu)), u1 = gelu_tanh(bf2f(w.x >> 16)), u2 = gelu_tanh(bf2f(w.y & 0xffffu)), u3 = gelu_tanh(bf2f(w.y >> 16));
            u32x2 ow; ow.x = pk2(u0 * (acc[mt][0] + bs), u1 * (acc[mt][1] + bs)); ow.y = pk2(u2 * (acc[mt][2] + bs), u3 * (acc[mt][3] + bs));
            *(GAS u32x2*)(mix + (size_t)(r0 + t) * D + 768 + ch) = ow; }
    }
}

constexpr int RW_PITCH = 1040;
__device__ __forceinline__ void ffn_prep(const Ctx& c_, int l, int nrows) { Ctx c = c_; asm volatile("" : "+s"(c.ws), "+s"(c.inp), "+s"(c.out), "+v"(c.tid)); c.lane = c.tid & 63; asm volatile("" : "+s"(l));
    const int gw = c.vcu * NWAVES + c.wave, NGW = c.G * NWAVES;
    const GAS float* modv = (const GAS float*)(c.ws + WS_MODV); bf16* F = (bf16*)(c.ws + WS_R3 + 66 * MiB);
    float* probsL = (float*)(c.ws + WS_PROBS); float* probsC = probsL + 2 * 16 * 16384;
    const GAS float* hctx = (const GAS float*)(c.ws + WS_HCTX); const GAS float* rw = c.inp[I_ROUTW] + (size_t)l * D * NE;
    __syncthreads();
    { f32x4 rv[8];
#pragma unroll
      for (int r = 0; r < 8; ++r) rv[r] = *(const GAS f32x4*)(rw + 4 * (c.tid + 512 * r));
#pragma unroll
      for (int r = 0; r < 8; ++r) { const int idx = 4 * (c.tid + 512 * r), k = idx >> 4, e = idx & 15, L = (k & 255) >> 2, j = k >> 8, i = k & 3;
        *(LAS f32x4*)(c.lds + L * RW_PITCH + ((j * 4 + i) * 16 + e) * 4) = rv[r]; } }
    LDS_WAIT(); __syncthreads();
    const GAS float* gn = c.inp[I_NFFNG] + l * D;
    const int myexp = ((c.lane & 1) << 3) | (((c.lane >> 1) & 1) << 2) | (((c.lane >> 2) & 1) << 1) | ((c.lane >> 3) & 1);
#define FFN_LOAD_RAW(BLK, DST) do { _Pragma("unroll") for (int q = 0; q < 4; ++q) { const GAS bf16* hb_ = (const GAS bf16*)c.out + (size_t)((BLK) * 4 + q) * 2048; \
            _Pragma("unroll") for (int j = 0; j < 4; ++j) DST[q][j] = *(const GAS u32x2*)(hb_ + 4 * c.lane + 256 * j); } } while (0)
    u32x2 wn[4][4];
    if (gw < nrows / 4 && gw * 4 < MLAT) FFN_LOAD_RAW(gw, wn);
    for (int blk = gw; blk < nrows / 4; blk += NGW) {
        const int m0 = blk * 4; const bool isctx = m0 >= MLAT; const int b = isctx ? ((m0 - MLAT) >> 8) : (m0 >> 14), mb = isctx ? 2 : b;
        const GAS float* mo = modv + (size_t)(l * 3 + mb) * 6144;
        f32x4 gsc[4], sh[4];
#pragma unroll
        for (int j = 0; j < 4; ++j) { const int col = 4 * c.lane + 256 * j; gsc[j] = *(const GAS f32x4*)(gn + col) * (*(const GAS f32x4*)(mo + 4 * 1024 + col) + 1.0f); sh[j] = *(const GAS f32x4*)(mo + 3 * 1024 + col); }
#pragma unroll 1
        for (int r4 = 0; r4 < 4; r4 += 4) { asm volatile("" ::: "memory");
            f32x4 v[4][4]; float rstd[4];
#pragma unroll
            for (int q = 0; q < 4; ++q) { const int m = m0 + r4 + q;
                if (isctx) { const GAS float* src = hctx + (size_t)(m - MLAT) * D;
#pragma unroll
                    for (int j = 0; j < 4; ++j) v[q][j] = *(const GAS f32x4*)(src + 4 * c.lane + 256 * j); }
                else {
#pragma unroll
                    for (int j = 0; j < 4; ++j) { const u32x2 w = wn[q][j]; v[q][j] = (f32x4){bf2f(w.x & 0xffffu), bf2f(w.x >> 16), bf2f(w.y & 0xffffu), bf2f(w.y >> 16)}; } } }
            if (blk + NGW < nrows / 4 && (blk + NGW) * 4 < MLAT) FFN_LOAD_RAW(blk + NGW, wn);
#pragma unroll
            for (int q = 0; q < 4; ++q) { float ss = 0.f;
#pragma unroll
                for (int j = 0; j < 4; ++j) ss += (v[q][j].x * v[q][j].x + v[q][j].y * v[q][j].y) + (v[q][j].z * v[q][j].z + v[q][j].w * v[q][j].w);
                rstd[q] = ss; }
#pragma unroll
            for (int o = 1; o < 64; o <<= 1) {
#pragma unroll
                for (int q = 0; q < 4; ++q) rstd[q] += __shfl_xor(rstd[q], o); }
#pragma unroll
            for (int q = 0; q < 4; ++q) rstd[q] = 1.0f / sqrtf(rstd[q] * (1.0f / D) + EPS);
            float lg[4][16];
#pragma unroll
            for (int q = 0; q < 4; ++q)
#pragma unroll
                for (int e = 0; e < 16; ++e) lg[q][e] = 0.f;
#pragma unroll
            for (int j = 0; j < 4; ++j) {
#pragma unroll
                for (int q = 0; q < 4; ++q) { v[q][j] = v[q][j] * rstd[q] * gsc[j] + sh[j];
                    u32x2 w; w.x = pk2(v[q][j].x, v[q][j].y); w.y = pk2(v[q][j].z, v[q][j].w); *(GAS u32x2*)(F + (size_t)(m0 + r4 + q) * D + 4 * c.lane + 256 * j) = w; }
#pragma unroll
                for (int i = 0; i < 4; ++i) { const LAS f32x4* rp = (const LAS f32x4*)(c.lds + c.lane * RW_PITCH + (j * 4 + i) * 64);
#pragma unroll
                    for (int k4 = 0; k4 < 4; ++k4) { const f32x4 w4 = rp[k4];
#pragma unroll
                        for (int q = 0; q < 4; ++q) { const float ai = v[q][j][i]; lg[q][4 * k4] += ai * w4.x; lg[q][4 * k4 + 1] += ai * w4.y; lg[q][4 * k4 + 2] += ai * w4.z; lg[q][4 * k4 + 3] += ai * w4.w; } } } }
            float lgt[4];
#pragma unroll
            for (int q = 0; q < 4; ++q) {
                float r8[8];
#pragma unroll
                for (int i = 0; i < 8; ++i) { const bool up = c.lane & 1; const float keep = up ? lg[q][i + 8] : lg[q][i], send = up ? lg[q][i] : lg[q][i + 8]; r8[i] = keep + __shfl_xor(send, 1); }
                float r4v[4];
#pragma unroll
                for (int i = 0; i < 4; ++i) { const bool up = c.lane & 2; const float keep = up ? r8[i + 4] : r8[i], send = up ? r8[i] : r8[i + 4]; r4v[i] = keep + __shfl_xor(send, 2); }
                float r2[2];
#pragma unroll
                for (int i = 0; i < 2; ++i) { const bool up = c.lane & 4; const float keep = up ? r4v[i + 2] : r4v[i], send = up ? r4v[i] : r4v[i + 2]; r2[i] = keep + __shfl_xor(send, 4); }
                { const bool up = c.lane & 8; const float keep = up ? r2[1] : r2[0], send = up ? r2[0] : r2[1]; lgt[q] = keep + __shfl_xor(send, 8); }
            }
#pragma unroll
            for (int o = 16; o < 64; o <<= 1) {
#pragma unroll
                for (int q = 0; q < 4; ++q) lgt[q] += __shfl_xor(lgt[q], o); }
            float mx[4], ex[4], den[4];
#pragma unroll
            for (int q = 0; q < 4; ++q) mx[q] = lgt[q];
#pragma unroll
            for (int o = 1; o < 16; o <<= 1) {
#pragma unroll
                for (int q = 0; q < 4; ++q) mx[q] = fmaxf(mx[q], __shfl_xor(mx[q], o)); }
#pragma unroll
            for (int q = 0; q < 4; ++q) { ex[q] = expf(lgt[q] - mx[q]); den[q] = ex[q]; }
#pragma unroll
            for (int o = 1; o < 16; o <<= 1) {
#pragma unroll
                for (int q = 0; q < 4; ++q) den[q] += __shfl_xor(den[q], o); }
            if (c.lane < 16) {
#pragma unroll
                for (int q = 0; q < 4; ++q) { const int m = m0 + r4 + q; const int t = isctx ? ((m - MLAT) & 255) : (m & 16383); const float pr = ex[q] / den[q];
                    if (isctx) probsC[(b * 16 + myexp) * 256 + t] = pr; else probsL[(b * 16 + myexp) * 16384 + t] = pr; } }
        }
    }
}

#undef FFN_LOAD_RAW
__device__ __forceinline__ int block_excl_scan(const Ctx& c, int v, volatile LAS int* tmp, int& total) {
    int inc = v;
#pragma unroll
    for (int o = 1; o < 64; o <<= 1) { const int y = __shfl_up(inc, o); if (c.lane >= o) inc += y; }
    __syncthreads();
    if (c.lane == 63) tmp[c.wave] = inc;
    __syncthreads();
    int base = 0, tot = 0;
#pragma unroll
    for (int w = 0; w < 8; ++w) { const int x = tmp[w]; if (w < c.wave) base += x; tot += x; }
    total = tot;
    return base + inc - v;
}
__device__ __forceinline__ void select_unit(const Ctx& c_, int unit) { Ctx c = c_; asm volatile("" : "+s"(c.ws), "+s"(c.inp), "+s"(c.out), "+v"(c.tid)); c.lane = c.tid & 63;
    const bool isctx = unit >= 32; const int be = isctx ? unit - 32 : unit, b = be >> 4, e = be & 15;
    const int N = isctx ? 256 : 16384, cap = isctx ? CAPC : CAPL;
    const GAS float* probs = (const GAS float*)(c.ws + WS_PROBS) + (isctx ? 2 * 16 * 16384 + be * 256 : be * 16384);
    int* smap = (int*)(c.ws + WS_SMAP) + (isctx ? 2 * 16 * 16384 + be * 256 : be * 16384);
    int* idx = (int*)(c.ws + WS_IDX); float* gate = (float*)(c.ws + WS_GATE);
    const int rowbase = isctx ? (XLAT + e * 256 + b * 32) : be * CAPL;
    const int tokbase = isctx ? (MLAT + b * LC) : b * SEQ;
    LAS unsigned* keys = (LAS unsigned*)(c.lds + RING_OFF);
    volatile LAS unsigned* hist = (volatile LAS unsigned*)(c.lds + RING_OFF + 65536);
    volatile LAS int* tmp = (volatile LAS int*)(c.lds + RING_OFF + 65536 + 16384);
    __syncthreads();
    unsigned kreg[32];
    const int R = isctx ? 1 : N / 512; const bool act = !isctx || c.tid < 256;
    if (!isctx) {
#pragma unroll
        for (int r = 0; r < 32; ++r) kreg[r] = __float_as_uint(probs[c.tid + 512 * r]);
#pragma unroll
        for (int r = 0; r < 32; ++r) keys[c.tid + 512 * r] = kreg[r]; }
    else {
#pragma unroll
        for (int r = 0; r < 32; ++r) kreg[r] = 0u;
        if (c.tid < 256) { kreg[0] = __float_as_uint(probs[c.tid]); keys[c.tid] = kreg[0]; } }
    unsigned prefix = 0; int remaining = cap;
#pragma unroll 1
    for (int pass = 0; pass < 3; ++pass) {
        const int shift = pass == 0 ? 19 : pass == 1 ? 9 : 0, width = pass == 0 ? 12 : pass == 1 ? 10 : 9, B = 1 << width, nb = B >> 6;
        for (int i = c.tid; i < B; i += 512) hist[i] = 0u;
        __syncthreads();
        if (act) {
#pragma unroll
            for (int r = 0; r < 32; ++r) { const unsigned k = kreg[r];
                if (r < R && (pass == 0 || (k >> (shift + width)) == (prefix >> (shift + width)))) __hip_atomic_fetch_add((LAS unsigned*)&hist[(k >> shift) & (unsigned)(B - 1)], 1u, __ATOMIC_RELAXED, __HIP_MEMORY_SCOPE_WORKGROUP); } }
        __syncthreads();
        if (c.wave == 0) {
            const int d0 = B - 1 - c.lane * nb; int cl = 0;
            for (int q = 0; q < nb; ++q) cl += (int)hist[d0 - ((q + c.lane) & (nb - 1))];
            int inc = cl;
#pragma unroll
            for (int o = 1; o < 64; o <<= 1) { const int y = __shfl_up(inc, o); if (c.lane >= o) inc += y; }
            const int before = inc - cl;
            const unsigned long long own = __ballot(before < remaining && remaining <= inc);
            const int ol = __builtin_ctzll(own);
            const int obefore = __shfl(before, ol), od0 = B - 1 - ol * nb;
            const int hb = c.lane < nb ? (int)hist[od0 - c.lane] : 0; int hinc = hb;
#pragma unroll
            for (int o = 1; o < 64; o <<= 1) { const int y = __shfl_up(hinc, o); if (c.lane >= o) hinc += y; }
            const int hbefore = obefore + hinc - hb;
            if (c.lane < nb && hbefore < remaining && remaining <= hbefore + hb) { tmp[16] = od0 - c.lane; tmp[17] = remaining - hbefore; }
        }
        __syncthreads();
        prefix |= ((unsigned)tmp[16]) << shift; remaining = tmp[17];
        __syncthreads();
    }
    int cnt2 = 0;
    if (act) {
#pragma unroll
        for (int r = 0; r < 32; ++r) { const unsigned k = kreg[r]; if (r < R) cnt2 += (k >= prefix ? 1 : 0) + (k == prefix ? 65536 : 0); } }
    int tot2; int base2 = block_excl_scan(c, cnt2, tmp, tot2);
    const int toteq = tot2 >> 16;
    int cutoff = N;
    int slot = base2 & 0xffff;
    if (toteq != remaining) {
        if (c.wave == 0) { int cum = 0;
            for (int base = 0; base < N; base += 64) { const unsigned long long m = __ballot(keys[base + c.lane] == prefix); const int pc = __popcll(m);
                if (cum + pc >= remaining) { unsigned long long mm = m; for (int q = cum + 1; q < remaining; ++q) mm &= mm - 1; if (c.lane == 0) tmp[18] = base + __builtin_ctzll(mm); break; }
                cum += pc; } }
        __syncthreads();
        cutoff = tmp[18];
        __syncthreads();
        int nsel = 0;
        if (act) {
#pragma unroll
            for (int r = 0; r < 32; ++r) { const int i = c.tid + 512 * r; const unsigned k = kreg[r]; if (r < R) nsel += (k > prefix || (k == prefix && i <= cutoff)) ? 1 : 0; } }
        int tot; slot = block_excl_scan(c, nsel, tmp, tot);
    }
    if (act) {
#pragma unroll
        for (int r = 0; r < 32; ++r) { if (r < R) { const int i = c.tid + 512 * r; const unsigned k = kreg[r]; const bool sel = (k > prefix || (k == prefix && i <= cutoff)) && slot < cap;
            if (sel) { smap[i] = slot; idx[rowbase + slot] = tokbase + i; gate[rowbase + slot] = __uint_as_float(k); ++slot; } else smap[i] = -1; } } }
}


__device__ __forceinline__ void sg_stage_a(const Ctx& c, const GAS bf16* const (&srow)[16]) {
    __syncthreads();
    v4u v[16];
#pragma unroll
    for (int i = 0; i < 16; ++i) { const int p = c.tid + 512 * i; v[i] = *(const GAS v4u*)(srow[i] + (p & 127) * 8); }
#pragma unroll
    for (int i = 0; i < 16; ++i) { const int p = c.tid + 512 * i, row = p >> 7, ch = p & 127; *(LAS v4u*)(c.lds + RING_OFF + row * 2048 + ((ch ^ (row & 15)) << 4)) = v[i]; }
    LDS_WAIT(); __syncthreads();
}
template <int NB> __device__ __forceinline__ void sg_mainloop(const Ctx& c, const GAS bf16* const (&brow)[NB], int fr, int fq, f32x4 (&acc)[NB][4]) {
#pragma unroll
    for (int nb = 0; nb < NB; ++nb)
#pragma unroll
        for (int mt = 0; mt < 4; ++mt) acc[nb][mt] = (f32x4){0.f, 0.f, 0.f, 0.f};
    bf16x8 b0[NB][8], b1[NB][8];
#pragma unroll
    for (int nb = 0; nb < NB; ++nb)
#pragma unroll
        for (int k = 0; k < 8; ++k) b0[nb][k] = *(const GAS bf16x8*)(brow[nb] + 32 * k + 8 * fq);
#pragma unroll
    for (int kb = 0; kb < 4; ++kb) {
        if (kb < 3) {
#pragma unroll
            for (int nb = 0; nb < NB; ++nb)
#pragma unroll
                for (int k = 0; k < 8; ++k) { const bf16x8 t = *(const GAS bf16x8*)(brow[nb] + 32 * (8 * (kb + 1) + k) + 8 * fq); if (kb & 1) b0[nb][k] = t; else b1[nb][k] = t; }
        }
#pragma unroll
        for (int k = 0; k < 8; ++k) { const int ch = 4 * (8 * kb + k) + fq;
            bf16x8 a[4];
#pragma unroll
            for (int mt = 0; mt < 4; ++mt) { const int row = 16 * mt + fr; a[mt] = *(const LAS bf16x8*)(c.lds + RING_OFF + row * 2048 + ((ch ^ (row & 15)) << 4)); }
#pragma unroll
            for (int nb = 0; nb < NB; ++nb) { const bf16x8 bb = (kb & 1) ? b1[nb][k] : b0[nb][k];
#pragma unroll
                for (int mt = 0; mt < 4; ++mt) acc[nb][mt] = mfma16(bb, a[mt], acc[nb][mt]); } }
    }
}
__device__ __forceinline__ void ctx_inproj_item(const Ctx& c_, int l, int item, int nb_lo, int nb_cnt) { Ctx c = c_; asm volatile("" : "+s"(c.ws), "+s"(c.inp), "+s"(c.out), "+v"(c.tid)); c.lane = c.tid & 63; asm volatile("" : "+s"(l));
    const int fr = c.lane & 15, fq = c.lane >> 4; const int mblk = item / nb_cnt, nbk = nb_lo + item % nb_cnt;
    const GAS bf16* A1 = (const GAS bf16*)(c.ws + WS_R1); const GAS bf16* W = (const GAS bf16*)(c.ws + WS_WIN) + (size_t)l * INW * 1024;
    GAS bf16* P = (GAS bf16*)(c.ws + WS_R2); GAS bf16* Amat = (GAS bf16*)(c.ws + WS_R1 + OFF_AMAT); GAS bf16* U2 = (GAS bf16*)(c.ws + WS_R3);
    const int row0 = MLAT + 64 * mblk, col0 = 128 * nbk + 16 * c.wave;
    const GAS bf16* srow[16]; const GAS bf16* brow[1];
#pragma unroll
    for (int i = 0; i < 16; ++i) srow[i] = A1 + (size_t)(row0 + ((c.tid + 512 * i) >> 7)) * 1024;
    brow[0] = W + (size_t)(col0 + fr) * 1024;
    sg_stage_a(c, srow);
    f32x4 acc[1][4]; sg_mainloop<1>(c, brow, fr, fq, acc);
#pragma unroll
    for (int mt = 0; mt < 4; ++mt) { const int row = row0 + 16 * mt + fr, col = col0 + 4 * fq; u32x2 w; w.x = pk2(acc[0][mt][0], acc[0][mt][1]); w.y = pk2(acc[0][mt][2], acc[0][mt][3]);
        if (col >= 768 && col < 1024) { const int cl = col - 768; const size_t r = (size_t)(cl >> 4) * 2304 + (row >> 4); const int k = (row & 15) * 16 + (cl & 15); *(GAS u32x2*)(Amat + r * 512 + k) = w; *(GAS u32x2*)(U2 + r * 256 + k) = w; }
        else *(GAS u32x2*)(P + (size_t)row * INW + col) = w; }
}
__device__ __forceinline__ void ctx_outproj_item(const Ctx& c_, int l, int item) { Ctx c = c_; asm volatile("" : "+s"(c.ws), "+s"(c.inp), "+s"(c.out), "+v"(c.tid)); c.lane = c.tid & 63; asm volatile("" : "+s"(l));
    const int fr = c.lane & 15, fq = c.lane >> 4; const int mblk = item >> 3, nbk = item & 7;
    const GAS bf16* mixn = (const GAS bf16*)(c.ws + WS_R3); const GAS bf16* W = (const GAS bf16*)(c.ws + WS_WOUT) + (size_t)l * 1024 * 1024;
    const GAS float* gate = (const GAS float*)(c.ws + WS_MODV) + (size_t)(l * 3 + 2) * 6144 + 2 * 1024; GAS float* hctx = (GAS float*)(c.ws + WS_HCTX);
    const int r0 = 64 * mblk, col0 = 128 * nbk + 16 * c.wave;
    const GAS bf16* srow[16]; const GAS bf16* brow[1];
#pragma unroll
    for (int i = 0; i < 16; ++i) srow[i] = mixn + (size_t)(MLAT + r0 + ((c.tid + 512 * i) >> 7)) * 1024;
    brow[0] = W + (size_t)(col0 + fr) * 1024;
    sg_stage_a(c, srow);
    f32x4 acc[1][4]; sg_mainloop<1>(c, brow, fr, fq, acc);
    const f32x4 gv = *(const GAS f32x4*)(gate + col0 + 4 * fq);
#pragma unroll
    for (int mt = 0; mt < 4; ++mt) { const size_t off = (size_t)(r0 + 16 * mt + fr) * 1024 + col0 + 4 * fq;
        const f32x4 h = *(const GAS f32x4*)(c.inp[I_CTX] + off); *(GAS f32x4*)(hctx + off) = h + gv * acc[0][mt]; }
}
__device__ __forceinline__ void ctx_moe1_item(const Ctx& c_, int item) { Ctx c = c_; asm volatile("" : "+s"(c.ws), "+s"(c.inp), "+s"(c.out), "+v"(c.tid)); c.lane = c.tid & 63;
    const int fr = c.lane & 15, fq = c.lane >> 4; const int e = item >> 3, fb = item & 7;
    const GAS bf16* F = (const GAS bf16*)(c.ws + WS_R3 + 66 * MiB); const GAS int* idx = (const GAS int*)(c.ws + WS_IDX);
    const GAS bf16* W = (const GAS bf16*)(c.ws + WS_WGU) + (size_t)e * 2048 * 1024; GAS bf16* hid = (GAS bf16*)(c.ws + WS_R2);
    const int xr0 = XLAT + 256 * e;
    const GAS bf16* srow[16]; const GAS bf16* brow[2];
#pragma unroll
    for (int i = 0; i < 16; ++i) srow[i] = F + (size_t)idx[xr0 + ((c.tid + 512 * i) >> 7)] * 1024;
    brow[0] = W + (size_t)(256 * fb + 16 * c.wave + fr) * 1024; brow[1] = brow[0] + (size_t)128 * 1024;
    sg_stage_a(c, srow);
    f32x4 acc[2][4]; sg_mainloop<2>(c, brow, fr, fq, acc);
#pragma unroll
    for (int mt = 0; mt < 4; ++mt) { float hv[4];
#pragma unroll
        for (int i = 0; i < 4; ++i) { const float g = acc[0][mt][i]; hv[i] = g * __builtin_amdgcn_rcpf(1.0f + __builtin_amdgcn_exp2f(-g * LOG2E)) * acc[1][mt][i]; }
        u32x2 w; w.x = pk2(hv[0], hv[1]); w.y = pk2(hv[2], hv[3]);
        *(GAS u32x2*)(hid + (size_t)(xr0 + 16 * mt + fr) * 1024 + 128 * fb + 16 * c.wave + 4 * fq) = w; }
}
__device__ __forceinline__ void ctx_moe2_item(const Ctx& c_, int item) { Ctx c = c_; asm volatile("" : "+s"(c.ws), "+s"(c.inp), "+s"(c.out), "+v"(c.tid)); c.lane = c.tid & 63;
    const int fr = c.lane & 15, fq = c.lane >> 4; const int e = item >> 3, nbk = item & 7;
    const GAS bf16* hid = (const GAS bf16*)(c.ws + WS_R2); const GAS bf16* W = (const GAS bf16*)(c.ws + WS_WD) + (size_t)e * 1024 * 1024;
    GAS bf16* Y = (GAS bf16*)(c.ws + WS_R3); const GAS float* gate = (const GAS float*)(c.ws + WS_GATE);
    const int xr0 = XLAT + 256 * e, col0 = 128 * nbk + 16 * c.wave;
    const GAS bf16* srow[16]; const GAS bf16* brow[1];
#pragma unroll
    for (int i = 0; i < 16; ++i) srow[i] = hid + (size_t)(xr0 + ((c.tid + 512 * i) >> 7)) * 1024;
    brow[0] = W + (size_t)(col0 + fr) * 1024;
    sg_stage_a(c, srow);
    f32x4 acc[1][4]; sg_mainloop<1>(c, brow, fr, fq, acc);
#pragma unroll
    for (int mt = 0; mt < 4; ++mt) { const int row = xr0 + 16 * mt + fr; const float gt = gate[row];
        u32x2 w; w.x = pk2(acc[0][mt][0] * gt, acc[0][mt][1] * gt); w.y = pk2(acc[0][mt][2] * gt, acc[0][mt][3] * gt);
        *(GAS u32x2*)(Y + (size_t)row * 1024 + col0 + 4 * fq) = w; }
}

__device__ __forceinline__ void norm_unit(const Ctx& c_, int l, int unit) { Ctx c = c_; asm volatile("" : "+s"(c.ws), "+s"(c.inp), "+s"(c.out), "+v"(c.tid)); c.lane = c.tid & 63; asm volatile("" : "+s"(l));
    const int lane = c.lane; const bool sg = lane >= 32;
    const GAS bf16* mix = (const GAS bf16*)(c.ws + WS_R1); GAS bf16* mixn = (GAS bf16*)(c.ws + WS_R3); const GAS float* ong = c.inp[I_ONG] + l * D;
    const f32x4 ga0 = *(const GAS f32x4*)(ong + 8 * lane), gb0 = *(const GAS f32x4*)(ong + 8 * lane + 4), ga1 = *(const GAS f32x4*)(ong + 512 + 8 * lane), gb1 = *(const GAS f32x4*)(ong + 512 + 8 * lane + 4);
    const int row0 = unit * 64 + c.wave * 8;
    float x[8][2][8]; float sa[8], sh[8];
#pragma unroll
    for (int q = 0; q < 8; ++q)
#pragma unroll
        for (int j = 0; j < 2; ++j) { v4u w = (v4u){0u, 0u, 0u, 0u}; if (j == 0 || sg) w = *(const GAS v4u*)(mix + (size_t)(row0 + q) * 1024 + 8 * lane + 512 * j);
            x[q][j][0] = __uint_as_float(w.x << 16); x[q][j][1] = __uint_as_float(w.x & 0xffff0000u); x[q][j][2] = __uint_as_float(w.y << 16); x[q][j][3] = __uint_as_float(w.y & 0xffff0000u);
            x[q][j][4] = __uint_as_float(w.z << 16); x[q][j][5] = __uint_as_float(w.z & 0xffff0000u); x[q][j][6] = __uint_as_float(w.w << 16); x[q][j][7] = __uint_as_float(w.w & 0xffff0000u); }
#pragma unroll
    for (int q = 0; q < 8; ++q) { float s0 = 0.f, s1 = 0.f;
#pragma unroll
        for (int i = 0; i < 8; ++i) { s0 += x[q][0][i] * x[q][0][i]; s1 += x[q][1][i] * x[q][1][i]; }
        sa[q] = s0; sh[q] = s1; }
#pragma unroll
    for (int o = 1; o < 64; o <<= 1) {
#pragma unroll
        for (int q = 0; q < 8; ++q) { sa[q] += __shfl_xor(sa[q], o); sh[q] += __shfl_xor(sh[q], o); } }
#pragma unroll
    for (int q = 0; q < 8; ++q) {
        const float r_att = 1.0f / sqrtf(sa[q] * (1.0f / 512.0f) + EPS), r_b = 1.0f / sqrtf(sh[q] * (1.0f / 256.0f) + EPS);
#pragma unroll
        for (int j = 0; j < 2; ++j) { if (j == 0 || sg) { const float r = j == 0 ? r_att : r_b; const f32x4 ga = j == 0 ? ga0 : ga1, gb = j == 0 ? gb0 : gb1;
            v4u w; w.x = pk2(x[q][j][0] * r * ga[0], x[q][j][1] * r * ga[1]); w.y = pk2(x[q][j][2] * r * ga[2], x[q][j][3] * r * ga[3]);
            w.z = pk2(x[q][j][4] * r * gb[0], x[q][j][5] * r * gb[1]); w.w = pk2(x[q][j][6] * r * gb[2], x[q][j][7] * r * gb[3]);
            *(GAS v4u*)(mixn + (size_t)(row0 + q) * 1024 + 8 * lane + 512 * j) = w; } } }
}

#ifndef MK_N_LAUNCHES
#define MK_N_LAUNCHES 1
#endif
constexpr int N_PHASES = 24;
constexpr int N_LAUNCHES = MK_N_LAUNCHES;
static_assert(N_LAUNCHES == 1 || N_LAUNCHES == N_PHASES, "MK_N_LAUNCHES is 1 or 24");

typedef const __attribute__((address_space(4))) unsigned char* kargp_t;
__device__ __forceinline__ Ctx make_ctx(LAS unsigned char* lds) {
    Ctx c; kargp_t kp = (kargp_t)__builtin_amdgcn_kernarg_segment_ptr(); asm volatile("" : "+s"(kp));
    c.inp = (kfptr*)kp;
    c.out = *(GAS float* const __attribute__((address_space(4)))*)(kp + 248); c.ws = *(GAS unsigned char* const __attribute__((address_space(4)))*)(kp + 256);
    c.ctl = (gu32*)(c.ws + WS_CTL);
    c.lds = lds; c.MISC = (volatile LAS unsigned*)(lds + MISC_OFF);
    int t = threadIdx.x; asm volatile("" : "+v"(t)); c.tid = t; c.lane = t & 63; c.wave = __builtin_amdgcn_readfirstlane(t >> 6);
    int G = gridDim.x, bx = blockIdx.x; asm volatile("" : "+s"(G), "+s"(bx)); c.G = G; c.vcu = (G % 8 == 0) ? (bx % 8) * (G / 8) + bx / 8 : bx;
    return c;
}
static_assert(offsetof(Args, out) == 248 && offsetof(Args, ws) == 256 && offsetof(Args, ph_lo) == 264, "Args layout");
__device__ __forceinline__ void grid_bar(const Ctx& c) {
    XcdBarrier bar; bar.bar = (unsigned*)(c.ctl + CW_BAR); bar.x = xb_xcc_id(); bar.st = c.MISC + 8;
    xcd_barrier(bar);
}

__global__ void __launch_bounds__(NWAVES * 64, 2) mega_fwd(Args args) {
    extern __shared__ __attribute__((aligned(16))) unsigned char lds[];
    {
        Ctx c = make_ctx((LAS unsigned char*)lds);
        for (int u = c.tid; u < (LDS_BYTES - LDSCTL_OFF) / 4; u += NWAVES * 64) ((LAS unsigned*)(c.lds + LDSCTL_OFF))[u] = 0u;
        __syncthreads();
        if (N_LAUNCHES == 1) (void)xcd_barrier_post((unsigned*)(c.ctl + CW_BAR), c.MISC + 8);
    }
    const int lo = args.ph_lo, hi = args.ph_hi;
#ifndef KIND_MASK
#define KIND_MASK 0x1fff
#endif
#define KIND_OF(k) ((k) < 2 ? (k) : 2 + ((k) - 2) % 11)
#define IN(k) (((KIND_MASK >> KIND_OF(k)) & 1) && lo <= (k) && (k) < hi)
#ifndef TPROBE
#define TPROBE -1
#endif
#ifndef TPROBE_UNIT
#define TPROBE_UNIT 0
#endif
#define STAMP(i) do { if ((TPROBE >= 0) && blockIdx.x == 0 && c.tid == 0) __hip_atomic_store(c.ctl + CW_TS + (i), (unsigned)__builtin_amdgcn_s_memrealtime(), RLX_AGENT); } while (0)
#define SEAM(k) do { if (IN((k) + 1)) grid_bar(c); STAMP((k) + 1); } while (0)
#ifndef REPEAT_MASK
#define REPEAT_MASK 0
#endif
#ifndef D_REP_MASK
#define D_REP_MASK 7
#endif
#define NREP(k) ((((REPEAT_MASK) >> KIND_OF(k)) & 1) ? 2 : 1)
#define REPEAT(k) for (int rep = 0; rep < NREP(k); ++rep)
#define LAUNDER() Ctx c = make_ctx((LAS unsigned char*)lds)
#define A1 ((bf16*)(c.ws + WS_R1))
#define Pb ((bf16*)(c.ws + WS_R2))
#define mixn ((bf16*)(c.ws + WS_R3))
#define xin ((bf16*)(c.ws + WS_R1))
#define hid ((bf16*)(c.ws + WS_R2))
#define Yb ((bf16*)(c.ws + WS_R3))
#define hctx ((float*)(c.ws + WS_HCTX))
#define AMAT ((bf16*)(c.ws + WS_R1 + OFF_AMAT))
#define U2M ((bf16*)(c.ws + WS_R3))
#define GS ((bf16*)(c.ws + WS_R1 + OFF_GS))
#define MIX ((bf16*)(c.ws + WS_R1))

    { Ctx c = make_ctx((LAS unsigned char*)lds); STAMP(0); }
    if (IN(0)) { REPEAT(0) { LAUNDER(); if (rep) grid_bar(c); p0a(c); } LAUNDER(); SEAM(0); }
    if (IN(1)) { REPEAT(1) { LAUNDER(); if (rep) grid_bar(c); p0b_tables(c); row_prep(c, 0, 0); } LAUNDER(); SEAM(1); }
#pragma unroll 1
    for (int l = 0; l < 2; ++l) {
        const int pb = 2 + 11 * l;
#define PH_BEGIN(k) if (IN(pb + (k))) { for (int rep = 0; rep < NREP(pb + (k)); ++rep) { LAUNDER(); if (rep) grid_bar(c);
#define PH_END(k) } LAUNDER(); SEAM(pb + (k)); }
        PH_BEGIN(0)
            pg8::Gemm g{A1, (const bf16*)(c.ws + WS_WIN) + (size_t)l * INW * 1024, MLAT, INW, 1024, 1024, nullptr}; pg8::StaticOrder S; S.init(MLAT, INW, c.G, (int)blockIdx.x);
            pg8::EpiInProj E{Pb, AMAT, U2M};
            pg8::gemm_phase<pg8::EpiInProj, pg8::StaticOrder, true, true>(c.lds + RING_OFF, g, S, E);
            { const int nb_lo = l == 0 ? 0 : 4, nb_cnt = l == 0 ? 12 : 4;
              for (int it = (int)blockIdx.x; it < 8 * nb_cnt; it += c.G) ctx_inproj_item(c, l, it, nb_lo, nb_cnt); }
        PH_END(0)
        PH_BEGIN(1)
            if (l == 0 && rep == 0) tg_assemble(c);
            { pg8::Gemm g{U2M, (const bf16*)(c.ws + WS_EB) + (size_t)l * 16 * 256 * 256, 144 * 256, 256, 256, 256, nullptr}; pg8::StaticOrder S; S.init(144 * 256, 256, c.G, (int)blockIdx.x, 2);
              pg8::EpiF32x256 E{(float*)(c.ws + WS_R2 + OFF_E)};
              pg8::gemm_phase<pg8::EpiF32x256, pg8::StaticOrder, false, true>(c.lds + RING_OFF, g, S, E); }
            if (rep == 0) qk_prep_rows(c, l);
        PH_END(1)
        PH_BEGIN(2)
            const int natt = l == 0 ? 520 : 512, nsgu = l == 0 ? 260 : 256;
            int nredo = 0;
            for (int u = q_next(c, pb + 2 + 32 * rep), un = 0; u < 64 + natt + nsgu; u = un) { const bool ahead = u < 64 + 256; unsigned tk = 0u; if (ahead) tk = q_issue(c, pb + 2 + 32 * rep);
                const int ukind = u < 64 ? 3 : u < 64 + natt ? 1 : 2;
                unsigned long long t0_ = 0; if (TPROBE_UNIT == ukind) t0_ = __builtin_amdgcn_s_memrealtime();
                if (u < 64) { if (rep == 0 || (D_REP_MASK & 1)) s5_scan_unit(c, l, u); }
                else if (u < 64 + natt) { if (rep == 0 || (D_REP_MASK & 2)) { if (attn_unit_t<true>(c, l, u - 64)) { if (c.tid == 0) c.MISC[64 + nredo] = (unsigned)(u - 64); ++nredo; } } }
                else { if (rep == 0 || (D_REP_MASK & 4)) sgu_unit(c, l, u - 64 - natt); }
                if (TPROBE_UNIT == ukind && l == 0) { WG_SYNC(); if (blockIdx.x == 0 && c.tid == 0) { const unsigned dt_ = (unsigned)(__builtin_amdgcn_s_memrealtime() - t0_);
                    __hip_atomic_fetch_add(c.ctl + CW_TS + 40, dt_, RLX_AGENT); __hip_atomic_fetch_add(c.ctl + CW_TS + 41, 1u, RLX_AGENT); } }
                un = ahead ? q_publish(c, tk) : q_next(c, pb + 2 + 32 * rep); }
            for (int i = 0; i < nredo; ++i) { LDS_WAIT(); __syncthreads(); const int uu = (int)c.MISC[64 + i]; (void)attn_unit_t<false>(c, l, __builtin_amdgcn_readfirstlane(uu)); }
        PH_END(2)
        PH_BEGIN(3)
            pg8::Gemm g{AMAT, (const bf16*)(c.ws + WS_TG) + (size_t)l * 16 * 256 * 512, 144 * 256, 256, 512, 512, nullptr}; pg8::StaticOrder S; S.init(144 * 256, 256, c.G, (int)blockIdx.x, 2);
            pg8::EpiS5Out E{GS, NSC};
            pg8::gemm_phase<pg8::EpiS5Out, pg8::StaticOrder, true, true>(c.lds + RING_OFF, g, S, E);
            if (rep == 0) for (;;) { const int u = q_next(c, pb + 3); if (u >= (l == 0 ? MT : MLAT) / 64) break; norm_unit(c, l, u); }
        PH_END(3)
        PH_BEGIN(4)
            const int M = l == 0 ? MT : MLAT;
            pg8::Gemm g{GS, (const bf16*)(c.ws + WS_WGLU) + (size_t)l * 256 * 256, M, 256, 256, 256, nullptr}; pg8::StaticOrder S; S.init(M, 256, c.G, (int)blockIdx.x);
            pg8::EpiGluNorm E{GS, MIX, mixn, (const float*)(c.inp[I_GLUB] + l * 256), (const float*)(c.inp[I_ONG] + l * D), EPS};
            pg8::gemm_phase<pg8::EpiGluNorm, pg8::StaticOrder, false, true>(c.lds + RING_OFF, g, S, E);
        PH_END(4)
        if (IN(pb + 5)) { for (int rep = 0; rep < (l == 0 ? NREP(pb + 5) : 1); ++rep) { LAUNDER(); if (rep) grid_bar(c);
            const int M = MLAT;
            pg8::Gemm g{mixn, (const bf16*)(c.ws + WS_WOUT) + (size_t)l * 1024 * 1024, M, 1024, 1024, 1024, nullptr}; pg8::StaticOrder S; S.init(M, 1024, c.G, (int)blockIdx.x);
            pg8::EpiResidBf E{l == 0 ? (const float*)c.inp[I_X] : nullptr, (bf16*)c.out, (const float*)(c.ws + WS_MODV) + (size_t)l * 3 * 6144, 2 * 1024};
            pg8::gemm_phase<pg8::EpiResidBf, pg8::StaticOrder, true, true>(c.lds + RING_OFF, g, S, E);
            if (l == 0) for (int it = (int)blockIdx.x; it < 64; it += c.G) ctx_outproj_item(c, l, it);
        PH_END(5)
        PH_BEGIN(6) ffn_prep(c, l, l == 0 ? MT : MLAT); PH_END(6)
        PH_BEGIN(7) const int nu = l == 0 ? 64 : 32; for (int u = (int)blockIdx.x; u < nu; u += c.G) select_unit(c, u);
            if (l == 0 && rep == 0 && c.G > 128) convert_experts(c, 1, 2, 3, 64);
        PH_END(7)
        PH_BEGIN(8)
            const int M = XLAT;
            pg8::Gemm g{(const bf16*)(c.ws + WS_R3 + 66 * MiB), (const bf16*)(c.ws + WS_WGU), M, 2048, 1024, 1024, (const int*)(c.ws + WS_IDX)};   pg8::StaticOrder S; S.init(M, 2048, c.G, (int)blockIdx.x, 1);
            pg8::EpiSwiGLU E{hid};
            pg8::gemm_phase<pg8::EpiSwiGLU, pg8::StaticOrder, true, true, true>(c.lds + RING_OFF, g, S, E);
            if (l == 0) for (int it = (int)blockIdx.x; it < 128; it += c.G) ctx_moe1_item(c, it);
        PH_END(8)
        PH_BEGIN(9)
            const int M = XLAT;
            pg8::Gemm g{hid, (const bf16*)(c.ws + (l == 0 ? WS_WD : WS_WD1)), M, 1024, 1024, 1024, nullptr}; pg8::StaticOrder S; S.init(M, 1024, c.G, (int)blockIdx.x, 1);
            pg8::EpiGateY E{Yb, (const float*)(c.ws + WS_GATE)};
            pg8::gemm_phase<pg8::EpiGateY, pg8::StaticOrder, true, true>(c.lds + RING_OFF, g, S, E);
            if (l == 0) for (int it = (int)blockIdx.x; it < 128; it += c.G) ctx_moe2_item(c, it);
        PH_END(9)
        if (IN(pb + 10)) { LAUNDER();
            if (l == 0) { row_prep(c, 1, 1); if (c.G > 128) convert_experts(c, 1, 0, 2, 0); else convert_experts(c, 1, 0, 3, 0); SEAM(pb + 10); }
            else row_prep(c, 2, 1);
        }
    }
#undef PH_BEGIN
#undef PH_END
#undef AMAT
#undef U2M
#undef GS
#undef MIX
#undef IN
#undef SEAM
#undef A1
#undef Pb
#undef mixn
#undef xin
#undef hid
#undef Yb
#undef hctx
}

extern "C" void kernel_launch(void* const* d_in, const int* in_sizes, int n_in, void* d_out, int out_size, void* d_ws, size_t ws_size, hipStream_t stream) {
    static int grid = 0;
    if (grid == 0) {
        if (n_in != 31 || in_sizes[0] != MLAT * D || out_size != MLAT * D || ws_size < WS_END) {
            fprintf(stderr, "kernel_launch: unexpected shapes (n_in %d, in0 %d, out %d, ws %zu < %zu); nothing launched\n", n_in, n_in > 0 ? in_sizes[0] : -1, out_size, ws_size, (size_t)WS_END); grid = -1; return; }
        int dev = 0, cus = 0, per_cu = 0;
        if (hipGetDevice(&dev) != hipSuccess || hipDeviceGetAttribute(&cus, hipDeviceAttributeMultiprocessorCount, dev) != hipSuccess) { grid = -1; return; }
        if (hipFuncSetAttribute((const void*)mega_fwd, hipFuncAttributeMaxDynamicSharedMemorySize, LDS_BYTES) != hipSuccess) { fprintf(stderr, "kernel_launch: hipFuncSetAttribute failed\n"); grid = -1; return; }
        if (hipOccupancyMaxActiveBlocksPerMultiprocessor(&per_cu, (const void*)mega_fwd, NWAVES * 64, LDS_BYTES) != hipSuccess || per_cu < 1)
            fprintf(stderr, "kernel_launch: note: occupancy query reports %d workgroups per CU\n", per_cu);
        (void)hipGetLastError();
        grid = cus;
    }
    if (grid < 0) return;
    if (hipMemsetAsync((char*)d_ws + WS_CTL, 0, CTL_ZERO_BYTES, stream) != hipSuccess) { fprintf(stderr, "kernel_launch: hipMemsetAsync failed\n"); return; }
    Args a{};
    for (int i = 0; i < 31; ++i) a.in[i] = (const float*)d_in[i];
    a.out = (float*)d_out; a.ws = (unsigned char*)d_ws;
    for (int li = 0; li < N_LAUNCHES; ++li) {
        a.ph_lo = (N_LAUNCHES == 1) ? 0 : li; a.ph_hi = (N_LAUNCHES == 1) ? N_PHASES : li + 1;
        hipLaunchKernelGGL(mega_fwd, dim3(grid), dim3(NWAVES * 64), LDS_BYTES, stream, a);
        const hipError_t le = hipPeekAtLastError();
        if (le != hipSuccess) { fprintf(stderr, "kernel_launch: launch %d failed: %s\n", li, hipGetErrorName(le)); break; }
    }
}
```

```cpp
#include <hip/hip_runtime.h>
#include <cstdio>
#include <cstdint>
#include <cmath>

constexpr int D = 1024, NBATCH = 2, SEQ = 16384, LC = 256;
constexpr int MLAT = NBATCH * SEQ, MCTX = NBATCH * LC, MT = MLAT + MCTX;
constexpr int INW = 1536;
constexpr int NE = 16, CAPL = 2048, CAPC = 32;
constexpr int XLAT = NBATCH * NE * CAPL;
constexpr int XROWS = XLAT + NE * 256;
constexpr float EPS = 1e-6f;
constexpr float LOG2E = 1.4426950408889634f;
constexpr int NTILE = MT / 256;
constexpr int NSC = MT / 16;

namespace pg8 {
#define PG8_LAS __attribute__((address_space(3)))
typedef unsigned short bf16_t;
typedef short bf16x8 __attribute__((ext_vector_type(8)));
typedef float f32x4 __attribute__((ext_vector_type(4)));
typedef unsigned u32x4 __attribute__((ext_vector_type(4)));
constexpr int BM = 256, BK = 64, HALF = 128, HTB = HALF * BK * 2  , STAGE_BYTES = 8 * HTB, NXCD = 8, WGM = 8;

__host__ __device__ __forceinline__ int lds_byte(int r, int c) { const int st = (r >> 4) * 2 + (c >> 5), rr = r & 15, cc = c & 31, ob = rr * 64 + cc * 2; return st * 1024 + (ob ^ (((ob >> 9) & 1) << 5)); }
__host__ __device__ __forceinline__ void stage_rc(int b, int& R, int& C) { const int st = b / 1024, sb = b % 1024, swz = sb ^ (((sb >> 9) & 1) << 5); R = (st >> 1) * 16 + swz / 64; C = (st & 1) * 32 + (swz % 64) / 2; }
__host__ __device__ __forceinline__ int perm32(int rho) { const int n = rho >> 4, i = rho & 15; return 8 * (i >> 2) + 4 * n + (i & 3); }

struct Unit { int pm, pn, pb; };
struct Gemm { const bf16_t* A; const bf16_t* Bt; int M, N, K, lda; const int* rowidx; };

struct StaticOrder {
    int nM, nN, nwg, G, c, moe;
    __host__ __device__ void init(int M, int N, int G_, int c_, int moe_ = 0) { nM = M / BM; nN = N / BM; nwg = nM * nN; G = G_; c = c_; moe = moe_; }
    __host__ __device__ bool next(int i, Unit& u) const {
        const long L = (long)i * G + c; if (L >= nwg) return false;
        int wgid = (int)L; { const int q = nwg / NXCD, r = nwg % NXCD, xcd = wgid % NXCD, off = wgid / NXCD; wgid = (xcd < r ? xcd * (q + 1) : r * (q + 1) + (xcd - r) * q) + off; }
        const int nig = WGM * nN, gid = wgid / nig, fm = gid * WGM, gsz = (nM - fm) < WGM ? (nM - fm) : WGM;
        u.pm = fm + ((wgid % nig) % gsz); u.pn = (wgid % nig) / gsz;
        u.pb = moe == 1 ? ((u.pm < 256 ? ((u.pm >> 3) & 15) : (u.pm - 256)) * nN + u.pn) : moe == 2 ? u.pm / 9 : u.pn; return true;
    }
    __device__ __forceinline__ void a_ready(const Unit&) const {}
    __device__ __forceinline__ void done(const Unit&) const {}
};

__device__ __forceinline__ unsigned cvt_pk_bf16(float lo, float hi) { unsigned r; asm volatile("v_cvt_pk_bf16_f32 %0, %1, %2" : "=v"(r) : "v"(lo), "v"(hi)); return r; }

struct EpiResid {
    static constexpr bool PERM = false, AFTER_DRAIN = false;
    const float* src_lat; float* dst_lat; const float* src_ctx; float* dst_ctx; const float* gate3;
    int mlat, gate_off;
    __device__ __forceinline__ void operator()(const f32x4 (&acc)[2][2][4][2], const Unit& u, int wr, int wc, int fr, int fq) const {
        const int r0 = u.pm * BM; const bool isctx = r0 >= mlat; const int mb = isctx ? 2 : (r0 >> 14);
        const float* src = isctx ? src_ctx : src_lat; float* dst = isctx ? dst_ctx : dst_lat;
        const int rb = (isctx ? r0 - mlat : r0) + wr * 64 + fr, col0 = u.pn * BM + wc * 32 + 4 * fq;
        const float* gate = gate3 + mb * 6144 + gate_off;
        f32x4 gv[2][2];
#pragma unroll
        for (int bj = 0; bj < 2; ++bj)
#pragma unroll
            for (int n = 0; n < 2; ++n) gv[bj][n] = *(const f32x4*)(gate + col0 + bj * HALF + n * 16);
#pragma unroll
        for (int ai = 0; ai < 2; ++ai)
#pragma unroll
            for (int m = 0; m < 4; ++m) { const size_t off = (size_t)(rb + ai * HALF + m * 16) * 1024 + col0;
#pragma unroll
                for (int bj = 0; bj < 2; ++bj)
#pragma unroll
                    for (int n = 0; n < 2; ++n) { const f32x4 h = *(const f32x4*)(src + off + bj * HALF + n * 16); *(f32x4*)(dst + off + bj * HALF + n * 16) = h + gv[bj][n] * acc[ai][bj][m][n]; }
                if (m & 1) asm volatile("" ::: "memory"); }
    }
};
struct EpiResidBf {
    static constexpr bool PERM = true, AFTER_DRAIN = false;
    const float* src_f32; bf16_t* hb; const float* gate3; int gate_off;
    __device__ __forceinline__ void operator()(const f32x4 (&acc)[2][2][4][2], const Unit& u, int wr, int wc, int fr, int fq) const {
        const int r0 = u.pm * BM, mb = r0 >> 14, row0 = r0 + wr * 64 + fr, col0 = u.pn * BM + wc * 32 + 8 * fq;
        const float* gate = gate3 + mb * 6144 + gate_off;
        f32x4 gv[2][2];
#pragma unroll
        for (int bj = 0; bj < 2; ++bj)
#pragma unroll
            for (int n = 0; n < 2; ++n) gv[bj][n] = *(const f32x4*)(gate + col0 + bj * HALF + 4 * n);
#pragma unroll
        for (int ai = 0; ai < 2; ++ai)
#pragma unroll
            for (int m = 0; m < 4; ++m) { const int row = row0 + ai * HALF + m * 16;
#pragma unroll
                for (int bj = 0; bj < 2; ++bj) { const int col = col0 + bj * HALF; f32x4 h0, h1;
                    if (src_f32) { h0 = *(const f32x4*)(src_f32 + (size_t)row * 1024 + col); h1 = *(const f32x4*)(src_f32 + (size_t)row * 1024 + col + 4); }
                    else { const u32x4 w = *(const u32x4*)(hb + (size_t)row * 2048 + col);
                        h0 = (f32x4){__uint_as_float(w.x << 16), __uint_as_float(w.x & 0xffff0000u), __uint_as_float(w.y << 16), __uint_as_float(w.y & 0xffff0000u)};
                        h1 = (f32x4){__uint_as_float(w.z << 16), __uint_as_float(w.z & 0xffff0000u), __uint_as_float(w.w << 16), __uint_as_float(w.w & 0xffff0000u)}; }
                    const f32x4 o0 = h0 + gv[bj][0] * acc[ai][bj][m][0], o1 = h1 + gv[bj][1] * acc[ai][bj][m][1];
                    u32x4 ow; ow.x = cvt_pk_bf16(o0[0], o0[1]); ow.y = cvt_pk_bf16(o0[2], o0[3]); ow.z = cvt_pk_bf16(o1[0], o1[1]); ow.w = cvt_pk_bf16(o1[2], o1[3]);
                    *(u32x4*)(hb + (size_t)row * 2048 + col) = ow; }
                if (m & 1) asm volatile("" ::: "memory"); }
    }
};
struct EpiSwiGLU {
    static constexpr bool PERM = true, AFTER_DRAIN = false;
    bf16_t* O;
    __device__ __forceinline__ void operator()(const f32x4 (&acc)[2][2][4][2], const Unit& u, int wr, int wc, int fr, int fq) const {
        const int row0 = u.pm * BM + wr * 64 + fr, col0 = u.pn * HALF + wc * 32 + 8 * fq;
#pragma unroll
        for (int ai = 0; ai < 2; ++ai)
#pragma unroll
            for (int m = 0; m < 4; ++m) { bf16_t* rowp = O + (size_t)(row0 + ai * HALF + m * 16) * 1024 + col0;
                float hv[8];
#pragma unroll
                for (int n = 0; n < 2; ++n)
#pragma unroll
                    for (int i = 0; i < 4; ++i) { const float g = acc[ai][0][m][n][i], up = acc[ai][1][m][n][i];
                        const float sg = g * __builtin_amdgcn_rcpf(1.0f + __builtin_amdgcn_exp2f(-g * 1.4426950408889634f)); hv[n * 4 + i] = sg * up; }
                u32x4 w; w.x = cvt_pk_bf16(hv[0], hv[1]); w.y = cvt_pk_bf16(hv[2], hv[3]); w.z = cvt_pk_bf16(hv[4], hv[5]); w.w = cvt_pk_bf16(hv[6], hv[7]);
                *(u32x4*)rowp = w; }
    }
};
struct EpiGateY {
    static constexpr bool PERM = true, AFTER_DRAIN = false;
    bf16_t* O; const float* gate;
    __device__ __forceinline__ void operator()(const f32x4 (&acc)[2][2][4][2], const Unit& u, int wr, int wc, int fr, int fq) const {
        const int row0 = u.pm * BM + wr * 64 + fr, col0 = u.pn * BM + wc * 32 + 8 * fq;
        float gts[2][4];
#pragma unroll
        for (int ai = 0; ai < 2; ++ai)
#pragma unroll
            for (int m = 0; m < 4; ++m) gts[ai][m] = gate[row0 + ai * HALF + m * 16];
#pragma unroll
        for (int ai = 0; ai < 2; ++ai)
#pragma unroll
            for (int m = 0; m < 4; ++m) { const int row = row0 + ai * HALF + m * 16; const float gt = gts[ai][m]; bf16_t* rowp = O + (size_t)row * 1024 + col0;
#pragma unroll
                for (int bj = 0; bj < 2; ++bj) { const f32x4 v0 = acc[ai][bj][m][0] * gt, v1 = acc[ai][bj][m][1] * gt;
                    u32x4 w; w.x = cvt_pk_bf16(v0[0], v0[1]); w.y = cvt_pk_bf16(v0[2], v0[3]); w.z = cvt_pk_bf16(v1[0], v1[1]); w.w = cvt_pk_bf16(v1[2], v1[3]);
                    *(u32x4*)(rowp + bj * HALF) = w; } }
    }
};

struct EpiInProj {
    static constexpr bool PERM = true, AFTER_DRAIN = false;
    bf16_t* O; bf16_t* Amat; bf16_t* U2;
    __device__ __forceinline__ void operator()(const f32x4 (&acc)[2][2][4][2], const Unit& u, int wr, int wc, int fr, int fq) const {
        const int row0 = u.pm * BM + wr * 64 + fr, cw = wc * 32 + 8 * fq;
#pragma unroll
        for (int ai = 0; ai < 2; ++ai)
#pragma unroll
            for (int m = 0; m < 4; ++m) { const int row = row0 + ai * HALF + m * 16;
#pragma unroll
                for (int bj = 0; bj < 2; ++bj) { const f32x4 v0 = acc[ai][bj][m][0], v1 = acc[ai][bj][m][1];
                    u32x4 w; w.x = cvt_pk_bf16(v0[0], v0[1]); w.y = cvt_pk_bf16(v0[2], v0[3]); w.z = cvt_pk_bf16(v1[0], v1[1]); w.w = cvt_pk_bf16(v1[2], v1[3]);
                    const int cl = cw + bj * HALF;
                    if (u.pn == 3) { const size_t r = (size_t)(cl >> 4) * 2304 + (row >> 4); const int k = (row & 15) * 16 + (cl & 15); *(u32x4*)(Amat + r * 512 + k) = w; *(u32x4*)(U2 + r * 256 + k) = w; }
                    else *(u32x4*)(O + (size_t)row * 1536 + u.pn * BM + cl) = w; } }
    }
};
struct EpiF32x256 {
    static constexpr bool PERM = false, AFTER_DRAIN = false;
    float* C;
    __device__ __forceinline__ void operator()(const f32x4 (&acc)[2][2][4][2], const Unit& u, int wr, int wc, int fr, int fq) const {
        const int row0 = u.pm * BM + wr * 64 + fr, col0 = wc * 32 + 4 * fq;
#pragma unroll
        for (int ai = 0; ai < 2; ++ai)
#pragma unroll
            for (int m = 0; m < 4; ++m) { float* rowp = C + (size_t)(row0 + ai * HALF + m * 16) * 256 + col0;
#pragma unroll
                for (int bj = 0; bj < 2; ++bj)
#pragma unroll
                    for (int n = 0; n < 2; ++n) *(f32x4*)(rowp + bj * HALF + n * 16) = acc[ai][bj][m][n];
                asm volatile("" ::: "memory"); }
    }
};
__device__ __forceinline__ float gelu_t(float x) { const float z2 = 1.5957691216057308f * (x + 0.044715f * x * x * x); return x * __builtin_amdgcn_rcpf(1.0f + __builtin_amdgcn_exp2f(-z2 * 1.4426950408889634f)); }
struct EpiS5Out {
    static constexpr bool PERM = false, AFTER_DRAIN = false;
    bf16_t* Gs; int nsc;
    __device__ __forceinline__ void operator()(const f32x4 (&acc)[2][2][4][2], const Unit& u, int wr, int wc, int fr, int fq) const {
        const int g = u.pm / 9, sc0 = (u.pm % 9) * BM + wr * 64 + fr;
#pragma unroll
        for (int ai = 0; ai < 2; ++ai)
#pragma unroll
            for (int m = 0; m < 4; ++m) { const int sc = sc0 + ai * HALF + m * 16;
                if (sc < nsc) {
#pragma unroll
                    for (int bj = 0; bj < 2; ++bj)
#pragma unroll
                        for (int n = 0; n < 2; ++n) { const int tau = 8 * bj + 2 * wc + n; const f32x4 v = acc[ai][bj][m][n];
                            unsigned lo = cvt_pk_bf16(gelu_t(v[0]), gelu_t(v[1])), hi = cvt_pk_bf16(gelu_t(v[2]), gelu_t(v[3]));
                            *(unsigned long long*)(Gs + (size_t)(16 * sc + tau) * 256 + 16 * g + 4 * fq) = ((unsigned long long)hi << 32) | lo; } } }
    }
};
struct EpiGluNorm {
    static constexpr bool PERM = true, AFTER_DRAIN = true;
    const bf16_t* Gs; bf16_t* mix; bf16_t* mixn; const float* glu_b; const float* ong; float eps;
    __device__ __forceinline__ void fused(f32x4 (&acc)[2][2][4][2], const Unit& u, int wr, int wc, int fr, int fq, PG8_LAS unsigned char* lds, int wid, int lane) const {
        const int row0 = u.pm * BM + wr * 64 + fr, col0 = wc * 32 + 8 * fq;
        f32x4 bv[2][2];
#pragma unroll
        for (int bj = 0; bj < 2; ++bj)
#pragma unroll
            for (int n = 0; n < 2; ++n) bv[bj][n] = *(const f32x4*)(glu_b + col0 + bj * HALF + 4 * n);
        PG8_LAS float* Pq = (PG8_LAS float*)lds;
#pragma unroll
        for (int ai = 0; ai < 2; ++ai)
#pragma unroll
            for (int m = 0; m < 4; ++m) { const int row = row0 + ai * HALF + m * 16; float ss = 0.f;
#pragma unroll
                for (int bj = 0; bj < 2; ++bj) { const int col = col0 + bj * HALF;
                    const u32x4 gw = *(const u32x4*)(Gs + (size_t)row * 256 + col);
                    const unsigned gws[4] = {gw.x, gw.y, gw.z, gw.w};
#pragma unroll
                    for (int i = 0; i < 8; ++i) { const float gv = __uint_as_float((i & 1) ? (gws[i >> 1] & 0xffff0000u) : (gws[i >> 1] << 16));
                        const float z = acc[ai][bj][m][i >> 2][i & 3] + bv[bj][i >> 2][i & 3];
                        const float o = gv * __builtin_amdgcn_rcpf(1.0f + __builtin_amdgcn_exp2f(-z * 1.4426950408889634f));
                        acc[ai][bj][m][i >> 2][i & 3] = o; ss += o * o; } }
                ss += __shfl_xor(ss, 16); ss += __shfl_xor(ss, 32);
                if (fq == 0) Pq[(ai * HALF + wr * 64 + m * 16 + fr) * 4 + wc] = ss; }
        asm volatile("s_waitcnt lgkmcnt(0)" ::: "memory"); __syncthreads();
        f32x4 gv4[2][2];
#pragma unroll
        for (int bj = 0; bj < 2; ++bj)
#pragma unroll
            for (int n = 0; n < 2; ++n) gv4[bj][n] = *(const f32x4*)(ong + 512 + col0 + bj * HALF + 4 * n);
#pragma unroll
        for (int ai = 0; ai < 2; ++ai)
#pragma unroll
            for (int m = 0; m < 4; ++m) { const int rl = ai * HALF + wr * 64 + m * 16 + fr, row = u.pm * BM + rl;
                const f32x4 p4 = *(const PG8_LAS f32x4*)(Pq + rl * 4);
                const float r = 1.0f / sqrtf(((p4[0] + p4[1]) + (p4[2] + p4[3])) * (1.0f / 256.0f) + eps);
#pragma unroll
                for (int bj = 0; bj < 2; ++bj) { const f32x4 v0 = acc[ai][bj][m][0] * r * gv4[bj][0], v1 = acc[ai][bj][m][1] * r * gv4[bj][1];
                    u32x4 w; w.x = cvt_pk_bf16(v0[0], v0[1]); w.y = cvt_pk_bf16(v0[2], v0[3]); w.z = cvt_pk_bf16(v1[0], v1[1]); w.w = cvt_pk_bf16(v1[2], v1[3]);
                    *(u32x4*)(mixn + (size_t)row * 1024 + 512 + col0 + bj * HALF) = w; } }
        asm volatile("s_waitcnt lgkmcnt(0)" ::: "memory"); __syncthreads();
    }
};

template <class Epi, class Sched, bool ALIGN_EPI = false, bool SP2 = false, bool GATHER = false>
__device__ __forceinline__ void gemm_phase(PG8_LAS unsigned char* lds, const Gemm g, const Sched& S, const Epi& E) {
    int tid_ = threadIdx.x; asm volatile("" : "+v"(tid_));
    const int tid = tid_, wid = __builtin_amdgcn_readfirstlane(tid >> 6), lane = tid & 63, wr = wid >> 2, wc = wid & 3, fr = lane & 15, fq = lane >> 4;
    const int K = g.K, nt = K / BK, lda = g.lda;
    unsigned voffA[2], voffB[2];
#pragma unroll
    for (int i = 0; i < 2; ++i) { int R, C; stage_rc(tid * 16 + i * 8192, R, C); const int Rb = Epi::PERM ? ((R & ~31) + perm32(R & 31)) : R;
        voffA[i] = (unsigned)(R * lda + C) * 2u; voffB[i] = (unsigned)(Rb * K + C) * 2u; }
    const size_t kstep = (size_t)(BK * 2);
    const size_t hstepB = (size_t)HALF * K * 2, hstepA = (size_t)HALF * lda * 2;
    const size_t tstepB = 2 * hstepB, tstepA = 2 * hstepA;
    const unsigned ldsw = (unsigned)wid * 1024u;
    const int aoff = lds_byte(wr * 64 + fr, fq * 8), boff = lds_byte(wc * 32 + fr, fq * 8);
#define PG8_SA(b, h) (((b) * 2 + (h)) * HTB)
#define PG8_SB(b, h) ((4 + (b) * 2 + (h)) * HTB)
#define PG8_STAGE(bufoff, gbase, voff) do { _Pragma("unroll") for (int _i = 0; _i < 2; ++_i) \
        __builtin_amdgcn_global_load_lds((const unsigned*)((const char*)(gbase) + (voff)[_i]), (PG8_LAS unsigned*)(lds + (bufoff) + ldsw + _i * 8192), 16, 0, 0); } while (0)
#define PG8_STAGE_A(bufoff, gbase, h, nx) do { if constexpr (GATHER) { _Pragma("unroll") for (int _i = 0; _i < 2; ++_i) \
        __builtin_amdgcn_global_load_lds((const unsigned*)((const char*)(gbase) + ((nx) ? vAn[h][_i] : vAc[h][_i])), (PG8_LAS unsigned*)(lds + (bufoff) + ldsw + _i * 8192), 16, 0, 0); } \
        else { PG8_STAGE(bufoff, (gbase) + ((h) ? hstepA : 0), voffA); } } while (0)
#define PG8_LDA(dst, b, h) do { _Pragma("unroll") for (int m = 0; m < 4; ++m) _Pragma("unroll") for (int k = 0; k < 2; ++k) dst[m][k] = *(const PG8_LAS bf16x8*)(lds + PG8_SA(b, h) + aoff + m * 2048 + k * 1024); } while (0)
#define PG8_LDB(dst, b, h) do { _Pragma("unroll") for (int n = 0; n < 2; ++n) _Pragma("unroll") for (int k = 0; k < 2; ++k) dst[n][k] = *(const PG8_LAS bf16x8*)(lds + PG8_SB(b, h) + boff + n * 2048 + k * 1024); } while (0)
#define PG8_MMA(ai, bj, At, Bt) do { __builtin_amdgcn_s_setprio(1); _Pragma("unroll") for (int m = 0; m < 4; ++m) _Pragma("unroll") for (int n = 0; n < 2; ++n) _Pragma("unroll") for (int k = 0; k < 2; ++k) \
        acc[ai][bj][m][n] = __builtin_amdgcn_mfma_f32_16x16x32_bf16(Bt[n][k], At[m][k], acc[ai][bj][m][n], 0, 0, 0); __builtin_amdgcn_s_setprio(0); } while (0)
#define PG8_WAIT_V(n) asm volatile("s_waitcnt vmcnt(" #n ")" ::: "memory")
#define PG8_WAIT_L(n) asm volatile("s_waitcnt lgkmcnt(" #n ")" ::: "memory")
#define PG8_BAR __builtin_amdgcn_s_barrier()
#define PG8_SCHED __builtin_amdgcn_sched_barrier(0)
    Unit cur, nxt; int ui = 0;
    if (!S.next(0, cur)) return;
    unsigned vAc[2][2] = {{0u, 0u}, {0u, 0u}}, vAn[2][2] = {{0u, 0u}, {0u, 0u}}; int RA[2], CA[2];
#pragma unroll
    for (int i = 0; i < 2; ++i) stage_rc(tid * 16 + i * 8192, RA[i], CA[i]);
    PG8_LAS int* const ridx = (PG8_LAS int*)(lds + STAGE_BYTES + 1024);
    if constexpr (GATHER) {
        Unit tu; for (int k = 0; k < 15 && S.next(k, tu); ++k) if (tid < 256) ridx[k * 256 + tid] = g.rowidx[tu.pm * BM + tid];
        asm volatile("s_waitcnt vmcnt(0) lgkmcnt(0)" ::: "memory"); __builtin_amdgcn_s_barrier(); asm volatile("" ::: "memory");
#pragma unroll
        for (int h = 0; h < 2; ++h)
#pragma unroll
            for (int i = 0; i < 2; ++i) vAc[h][i] = (unsigned)(ridx[h * HALF + RA[i]] * lda + CA[i]) * 2u;
    }
    f32x4 acc[2][2][4][2];
#pragma unroll
    for (int a = 0; a < 2; ++a)
#pragma unroll
        for (int b = 0; b < 2; ++b)
#pragma unroll
            for (int m = 0; m < 4; ++m)
#pragma unroll
                for (int n = 0; n < 2; ++n) acc[a][b][m][n] = (f32x4){0.f, 0.f, 0.f, 0.f};
    bf16x8 At[4][2], B0[2][2], B1[2][2];
    const char* cA = (const char*)g.A + (GATHER ? (size_t)0 : (size_t)cur.pm * tstepA); const char* cB = (const char*)g.Bt + (size_t)cur.pb * tstepB;
    S.a_ready(cur);
    if constexpr (SP2) {
        PG8_STAGE(PG8_SB(0, 0), cB, voffB); PG8_STAGE(PG8_SB(0, 1), cB + hstepB, voffB); PG8_STAGE_A(PG8_SA(0, 0), cA, 0, false); PG8_STAGE_A(PG8_SA(0, 1), cA, 1, false);
        if (wr == 1) PG8_BAR;
        PG8_WAIT_V(2); PG8_BAR;
        PG8_STAGE(PG8_SB(1, 0), cB + kstep, voffB); PG8_STAGE_A(PG8_SA(1, 0), cA + kstep, 0, false); PG8_STAGE(PG8_SB(1, 1), cB + hstepB + kstep, voffB);
        PG8_WAIT_V(6); PG8_BAR;
    } else {
        PG8_STAGE(PG8_SB(0, 0), cB, voffB); PG8_STAGE_A(PG8_SA(0, 0), cA, 0, false); PG8_STAGE(PG8_SB(0, 1), cB + hstepB, voffB); PG8_STAGE_A(PG8_SA(0, 1), cA, 1, false);
        if (wr == 1) PG8_BAR;
        PG8_WAIT_V(4); PG8_BAR;
        PG8_STAGE(PG8_SB(1, 0), cB + kstep, voffB); PG8_STAGE_A(PG8_SA(1, 0), cA + kstep, 0, false); PG8_STAGE(PG8_SB(1, 1), cB + hstepB + kstep, voffB);
        PG8_WAIT_V(6); PG8_BAR;
    }
    for (;;) {
        const bool has_next = S.next(ui + 1, nxt);
        const char* nA = GATHER ? (const char*)g.A : (has_next ? (const char*)g.A + (size_t)nxt.pm * tstepA : cA);
        if constexpr (GATHER) {
#pragma unroll
            for (int h = 0; h < 2; ++h)
#pragma unroll
                for (int i = 0; i < 2; ++i) vAn[h][i] = has_next ? (unsigned)(ridx[(ui + 1) * 256 + h * HALF + RA[i]] * lda + CA[i]) * 2u : vAc[h][i]; } const char* nB = has_next ? (const char*)g.Bt + (size_t)nxt.pb * tstepB : cB;
        for (int t = 0; t < nt; t += 2) {
            const bool last = (t == nt - 2);
            const char* a1 = cA + (size_t)(t + 1) * kstep;
            const char* a2 = last ? nA : cA + (size_t)(t + 2) * kstep; const char* b2 = last ? nB : cB + (size_t)(t + 2) * kstep;
            const char* a3 = a2 + kstep; const char* b3 = b2 + kstep;
            if (last && has_next) S.a_ready(nxt);
            if constexpr (SP2) {
            PG8_LDB(B0, 0, 0); PG8_LDB(B1, 0, 1); PG8_SCHED; PG8_LDA(At, 0, 0); PG8_STAGE_A(PG8_SA(1, 1), a1, 1, false);
            PG8_WAIT_V(8); PG8_WAIT_L(0); PG8_BAR; PG8_MMA(0, 0, At, B0); PG8_MMA(0, 1, At, B1); PG8_BAR; PG8_SCHED;
            PG8_LDA(At, 0, 1); PG8_STAGE(PG8_SB(0, 0), b2, voffB); PG8_STAGE(PG8_SB(0, 1), b2 + hstepB, voffB); PG8_STAGE_A(PG8_SA(0, 0), a2, 0, last);
            PG8_WAIT_V(8); PG8_WAIT_L(0); PG8_BAR; PG8_MMA(1, 0, At, B0); PG8_MMA(1, 1, At, B1); PG8_BAR; PG8_SCHED;
            PG8_LDB(B0, 1, 0); PG8_LDB(B1, 1, 1); PG8_SCHED; PG8_LDA(At, 1, 0); PG8_STAGE_A(PG8_SA(0, 1), a2, 1, last);
            PG8_WAIT_V(8); PG8_WAIT_L(0); PG8_BAR; PG8_MMA(0, 0, At, B0); PG8_MMA(0, 1, At, B1); PG8_BAR; PG8_SCHED;
            PG8_LDA(At, 1, 1); PG8_STAGE(PG8_SB(1, 0), b3, voffB); PG8_STAGE(PG8_SB(1, 1), b3 + hstepB, voffB); PG8_STAGE_A(PG8_SA(1, 0), a3, 0, last);
            PG8_WAIT_V(8); PG8_WAIT_L(0); PG8_BAR; PG8_MMA(1, 0, At, B0); PG8_MMA(1, 1, At, B1); PG8_BAR; PG8_SCHED;
            } else {
            PG8_LDB(B0, 0, 0); PG8_SCHED; PG8_LDA(At, 0, 0); PG8_STAGE_A(PG8_SA(1, 1), a1, 1, false);
            PG8_WAIT_L(8); PG8_BAR; PG8_WAIT_L(0); PG8_MMA(0, 0, At, B0); PG8_BAR; PG8_SCHED;
            PG8_LDB(B1, 0, 1); PG8_STAGE(PG8_SB(0, 0), b2, voffB);
            PG8_BAR; PG8_WAIT_L(0); PG8_MMA(0, 1, At, B1); PG8_BAR;
            PG8_LDA(At, 0, 1); PG8_STAGE_A(PG8_SA(0, 0), a2, 0, last);
            PG8_BAR; PG8_WAIT_L(0); PG8_MMA(1, 0, At, B0); PG8_BAR; PG8_SCHED;
            PG8_STAGE(PG8_SB(0, 1), b2 + hstepB, voffB);
            PG8_WAIT_V(6); PG8_BAR; PG8_MMA(1, 1, At, B1); PG8_BAR;
            PG8_LDB(B0, 1, 0); PG8_SCHED; PG8_LDA(At, 1, 0); PG8_STAGE_A(PG8_SA(0, 1), a2, 1, last);
            PG8_WAIT_L(8); PG8_BAR; PG8_WAIT_L(0); PG8_MMA(0, 0, At, B0); PG8_BAR; PG8_SCHED;
            PG8_LDB(B1, 1, 1); PG8_STAGE(PG8_SB(1, 0), b3, voffB);
            PG8_BAR; PG8_WAIT_L(0); PG8_MMA(0, 1, At, B1); PG8_BAR;
            PG8_LDA(At, 1, 1); PG8_STAGE_A(PG8_SA(1, 0), a3, 0, last);
            PG8_BAR; PG8_WAIT_L(0); PG8_MMA(1, 0, At, B0); PG8_BAR; PG8_SCHED;
            PG8_STAGE(PG8_SB(1, 1), b3 + hstepB, voffB);
            PG8_WAIT_V(6); PG8_BAR; PG8_MMA(1, 1, At, B1); PG8_BAR;
            }
        }
        if constexpr (ALIGN_EPI) { if (wr == 0) PG8_BAR; }
        if constexpr (!Epi::AFTER_DRAIN) { E(acc, cur, wr, wc, fr, fq); S.done(cur); }
        if (!has_next) break;
#pragma unroll
        for (int a = 0; a < 2; ++a)
#pragma unroll
            for (int b = 0; b < 2; ++b)
#pragma unroll
                for (int m = 0; m < 4; ++m)
#pragma unroll
                    for (int n = 0; n < 2; ++n) acc[a][b][m][n] = (f32x4){0.f, 0.f, 0.f, 0.f};
        cur = nxt; cA = nA; cB = nB; ++ui;
        if constexpr (GATHER) {
#pragma unroll
            for (int h = 0; h < 2; ++h)
#pragma unroll
                for (int i = 0; i < 2; ++i) vAc[h][i] = vAn[h][i]; }
        if constexpr (ALIGN_EPI) { if (wr == 1) PG8_BAR; }
    }
    PG8_WAIT_V(0);
    if constexpr (!ALIGN_EPI) { if (wr == 0) PG8_BAR; }
    PG8_BAR;
    if constexpr (Epi::AFTER_DRAIN) { E.fused(acc, cur, wr, wc, fr, fq, lds, wid, lane); S.done(cur); }
#undef PG8_SA
#undef PG8_SB
#undef PG8_STAGE
#undef PG8_LDA
#undef PG8_LDB
#undef PG8_MMA
#undef PG8_WAIT_V
#undef PG8_WAIT_L
#undef PG8_BAR
#undef PG8_SCHED
}
}
#define GAS __attribute__((address_space(1)))
#define LAS __attribute__((address_space(3)))
typedef unsigned short bf16;
typedef unsigned v4u __attribute__((ext_vector_type(4)));
typedef float f32x4 __attribute__((ext_vector_type(4)));
typedef short bf16x8 __attribute__((ext_vector_type(8)));
typedef GAS unsigned gu32;
typedef GAS unsigned long long gu64;
#define RLX_AGENT __ATOMIC_RELAXED, __HIP_MEMORY_SCOPE_AGENT
#define LDS_WAIT() asm volatile("s_waitcnt lgkmcnt(0)" ::: "memory")
#define VM_WAIT() asm volatile("s_waitcnt vmcnt(0)" ::: "memory")
__device__ __forceinline__ unsigned long long rt() { return __builtin_amdgcn_s_memrealtime(); }
__device__ __forceinline__ unsigned f2bf(float f) { unsigned u = __builtin_bit_cast(unsigned, f); return (u + 0x7fffu + ((u >> 16) & 1u)) >> 16; }
typedef float pk_f32x2 __attribute__((ext_vector_type(2))); typedef __bf16 pk_bf16x2 __attribute__((ext_vector_type(2)));
__device__ __forceinline__ unsigned pk2(float lo, float hi) { pk_f32x2 v = {lo, hi}; pk_bf16x2 b = __builtin_convertvector(v, pk_bf16x2); return __builtin_bit_cast(unsigned, b); }

#define XB_TMO      128
#define XB_XCNT(j)  (256  + 64 * (j))
#define XB_XSUB(j)  (1280 + 64 * (j))
#define XB_XGEN(j)  (2304 + 64 * (j))
#define XB_TOP      3328
#define XB_TOPGEN   3392
#define XCD_BAR_WORDS 3456
#define XB_SPIN_CAP (1u << 18)

__device__ __forceinline__ unsigned xb_ld(unsigned* p)              { return __hip_atomic_load(p, __ATOMIC_RELAXED, __HIP_MEMORY_SCOPE_AGENT); }
__device__ __forceinline__ unsigned xb_add(unsigned* p, unsigned v) { return __hip_atomic_fetch_add(p, v, __ATOMIC_RELAXED, __HIP_MEMORY_SCOPE_AGENT); }
__device__ __forceinline__ unsigned xb_xcc_id() { return (unsigned)__builtin_amdgcn_s_getreg((3 << 11) | 20) & 0xFu; }
#define XB_SPIN(cond, bar) do { unsigned _sp = 0; while (cond) { __builtin_amdgcn_s_sleep(1); \
    if ((++_sp & 255u) == 0u) { if (xb_ld(&(bar)[XB_TMO])) break; if (_sp > XB_SPIN_CAP) { atomicAdd(&(bar)[XB_TMO], 1u); break; } } } } while (0)

struct XcdBarrier {
    unsigned* bar; unsigned x;
    volatile LAS unsigned* st;
};

__device__ __forceinline__ XcdBarrier xcd_barrier_post(unsigned* bar, volatile LAS unsigned* st) {
    XcdBarrier b; b.bar = bar; b.x = xb_xcc_id(); b.st = st;
    if (threadIdx.x == 0) (void)xb_add(&bar[XB_XCNT(b.x)], 1u);
    return b;
}
__device__ __forceinline__ void xcd_barrier_complete(unsigned* bar, unsigned x, unsigned& nloc, unsigned& nx) {
    const unsigned G = gridDim.x * gridDim.y * gridDim.z;
    unsigned sum, cnt, mine, sp = 0u;
    for (;;) {
        sum = 0u; cnt = 0u; mine = 0u;
#pragma unroll
        for (unsigned j = 0; j < 16; ++j) { const unsigned c = xb_ld(&bar[XB_XCNT(j)]); sum += c; cnt += (c > 0u) ? 1u : 0u; mine = (j == x) ? c : mine; }
        if (sum == G) break;
        __builtin_amdgcn_s_sleep(1);
        if ((++sp & 255u) == 0u) { if (xb_ld(&bar[XB_TMO])) break; if (sp > XB_SPIN_CAP) { atomicAdd(&bar[XB_TMO], 1u); break; } }
    }
    nloc = mine > 0u ? mine : 1u; nx = cnt > 0u ? cnt : 1u;
}

__device__ __forceinline__ void xcd_barrier(const XcdBarrier& b) {
    asm volatile("s_waitcnt vmcnt(0)" ::: "memory");
    __syncthreads();
    if (threadIdx.x == 0) {
        unsigned* bar = b.bar;
        __builtin_amdgcn_s_waitcnt(0);
        unsigned nloc = b.st[0], nx = b.st[1];
        if (nloc == 0u) { xcd_barrier_complete(bar, b.x, nloc, nx); b.st[0] = nloc; b.st[1] = nx; }
        const unsigned old = xb_add(&bar[XB_XSUB(b.x)], 1u);
        const unsigned gen = old / nloc;
        if (old + 1u == (gen + 1u) * nloc) {
            __builtin_amdgcn_fence(__ATOMIC_RELEASE, "agent");
            asm volatile("s_waitcnt vmcnt(0)" ::: "memory");
            const unsigned og = xb_add(&bar[XB_TOP], 1u);
            const unsigned tg = og / nx;
            if (og + 1u == (tg + 1u) * nx) xb_add(&bar[XB_TOPGEN], 1u);
            else XB_SPIN(xb_ld(&bar[XB_TOPGEN]) == tg, bar);
            __builtin_amdgcn_fence(__ATOMIC_ACQUIRE, "agent");
            xb_add(&bar[XB_XGEN(b.x)], 1u);
            asm volatile("s_waitcnt vmcnt(0)" ::: "memory");
        } else {
            XB_SPIN(xb_ld(&bar[XB_XGEN(b.x)]) == gen, bar);
            __builtin_amdgcn_fence(__ATOMIC_ACQUIRE, "agent");
            asm volatile("s_waitcnt vmcnt(0)" ::: "memory");
        }
    }
    __syncthreads();
}

typedef float f32x2 __attribute__((ext_vector_type(2)));
typedef float f32x16 __attribute__((ext_vector_type(16)));
typedef unsigned u32x2 __attribute__((ext_vector_type(2)));
typedef short v4i16_t __attribute__((ext_vector_type(4)));

constexpr size_t MiB = 1u << 20;
constexpr size_t WS_CTL = 0, CTL_ZERO_BYTES = 128 * 1024;
constexpr size_t WS_MODV = 1 * MiB;
constexpr size_t WS_POW  = 1 * MiB + 256 * 1024;
constexpr size_t WS_BBAR = 2 * MiB;
constexpr size_t WS_WGLU = 2 * MiB + 512 * 1024;
constexpr size_t WS_WSGU = 2 * MiB + 768 * 1024;
constexpr size_t WS_HCTX = 3 * MiB;
constexpr size_t WS_EB   = 5 * MiB;
constexpr size_t WS_TG   = 9 * MiB;
constexpr size_t WS_ROPE = 17 * MiB;
constexpr size_t WS_KTAB = 19 * MiB + 512 * 1024;
constexpr size_t WS_PROBS = 22 * MiB;
constexpr size_t WS_SMAP = 24 * MiB + 256 * 1024;
constexpr size_t WS_IDX  = 26 * MiB + 512 * 1024;
constexpr size_t WS_GATE = 27 * MiB;
constexpr size_t WS_WIN  = 28 * MiB;
constexpr size_t WS_WOUT = 34 * MiB;
constexpr size_t WS_WGU  = 38 * MiB;
constexpr size_t WS_WD   = 102 * MiB;
constexpr size_t WS_R1   = 134 * MiB;
constexpr size_t WS_R2   = 270 * MiB;
constexpr size_t WS_R3   = 406 * MiB;
constexpr size_t WS_WD1  = 542 * MiB;
constexpr size_t WS_END  = 574 * MiB;
constexpr size_t OFF_GS = 66 * MiB, OFF_AMAT = 84 * MiB;
constexpr size_t OFF_E = 98 * MiB;
constexpr int POWS = 20;
static_assert((size_t)XROWS * 2048 == 136 * MiB, "MoE row buffers are 136 MiB");
constexpr int CW_TMO = 0, CW_CODE = 1;
constexpr int CW_BAR = 4096;
constexpr int CW_TS = 8192;
constexpr int CW_Q = 16384;
constexpr int RING_OFF = 0, RING_BYTES = 131072;
constexpr int LDSCTL_OFF = RING_BYTES, MISC_OFF = LDSCTL_OFF + 320;
constexpr int LDS_BYTES = 147456;
constexpr int NWAVES = 8;


struct Args { const float* in[31]; float* out; unsigned char* ws; int ph_lo, ph_hi; };
typedef const GAS float* fptr_t;
typedef const __attribute__((address_space(4))) fptr_t kfptr;
struct Ctx {
    LAS unsigned char* lds; volatile LAS unsigned* MISC; gu32* ctl;
    int tid, lane, wave, vcu, G;
    kfptr* inp; GAS float* out; GAS unsigned char* ws;
};
enum InIdx { I_X = 0, I_C, I_CTX, I_CCTX, I_ADAW, I_ADAB, I_NMIXG, I_NFFNG, I_WIN, I_QNG, I_KNG, I_SINK, I_LRE, I_LIM, I_LOGDT, I_BRE, I_BIM, I_CRE, I_CIM,
             I_S5D, I_GLUW, I_GLUB, I_SGUNG, I_SGUW, I_SGUB, I_ONG, I_WOUT, I_ROUTW, I_WG, I_WU, I_WDN };

__device__ __forceinline__ float bf2f(unsigned h) { return __uint_as_float(h << 16); }
__device__ __forceinline__ float wave_sum(float v) {
#pragma unroll
    for (int o = 1; o < 64; o <<= 1) v += __shfl_xor(v, o);
    return v;
}
__device__ __forceinline__ float gelu_tanh(float x) {
    const float z2 = 1.5957691216057308f * (x + 0.044715f * x * x * x);
    return x * __builtin_amdgcn_rcpf(1.0f + __builtin_amdgcn_exp2f(-z2 * LOG2E));
}
__device__ __forceinline__ float silu_f(float x) { return x / (1.0f + __expf(-x)); }
#define WG_SYNC() do { asm volatile("s_waitcnt vmcnt(0) lgkmcnt(0)" ::: "memory"); __syncthreads(); } while (0)

__device__ __forceinline__ int q_next(const Ctx& c, int qi) {
    LDS_WAIT(); __syncthreads();
    if (c.tid == 0) c.MISC[16] = __hip_atomic_fetch_add(c.ctl + CW_Q + 64 * qi, 1u, RLX_AGENT);
    __syncthreads();
    const int u = (int)c.MISC[16];
    return __builtin_amdgcn_readfirstlane(u);
}

__device__ __forceinline__ unsigned q_issue(const Ctx& c, int qi) { unsigned t = 0u; if (c.tid == 0) t = __hip_atomic_fetch_add(c.ctl + CW_Q + 64 * qi, 1u, RLX_AGENT); return t; }
__device__ __forceinline__ int q_publish(const Ctx& c, unsigned t) {
    LDS_WAIT(); __syncthreads();
    if (c.tid == 0) c.MISC[16] = t;
    __syncthreads();
    const int u = (int)c.MISC[16];
    return __builtin_amdgcn_readfirstlane(u);
}

__device__ __forceinline__ void transpose_item(const GAS float* W, int K, int N, bf16* WT, int ilv, LAS float* scr, int item, int lane) {
    const int nblk = N / 32, kb = item / nblk, nb = item % nblk, k0 = 64 * kb, n0 = 32 * nb;
    const int row_off = ilv ? ((n0 >> 7) * 128 + (ilv == 2 ? 128 : 0)) : 0;
    { const int n4 = (lane & 7) * 4; f32x4 v[8];
#pragma unroll
      for (int i = 0; i < 8; ++i) v[i] = *(const GAS f32x4*)(W + (size_t)(k0 + (lane >> 3) + 8 * i) * N + n0 + n4);
#pragma unroll
      for (int i = 0; i < 8; ++i) { LAS float* d = scr + ((lane >> 3) + 8 * i) * 33 + n4; d[0] = v[i][0]; d[1] = v[i][1]; d[2] = v[i][2]; d[3] = v[i][3]; } }
    LDS_WAIT(); asm volatile("" ::: "memory");
    const int cc = lane & 7;
#pragma unroll
    for (int j = 0; j < 4; ++j) { const int n = (lane >> 3) + 8 * j; const LAS float* s = scr + (8 * cc) * 33 + n;
        v4u o; o.x = pk2(s[0 * 33], s[1 * 33]); o.y = pk2(s[2 * 33], s[3 * 33]); o.z = pk2(s[4 * 33], s[5 * 33]); o.w = pk2(s[6 * 33], s[7 * 33]);
        *(GAS v4u*)(WT + (size_t)(row_off + n0 + n) * K + k0 + 8 * cc) = o; }
    LDS_WAIT(); asm volatile("" ::: "memory");
}
__device__ __forceinline__ void convert_experts(const Ctx& c_, int l, int w_lo, int w_hi, int blk_lo) { Ctx c = c_; asm volatile("" : "+s"(c.ws), "+s"(c.inp), "+s"(c.out), "+v"(c.tid)); c.lane = c.tid & 63; asm volatile("" : "+s"(l));
    LAS float* scr = (LAS float*)(c.lds + RING_OFF + c.wave * 16384);
    const int gw = (blk_lo ? (int)blockIdx.x - blk_lo : c.vcu) * NWAVES + c.wave, NGW = (c.G - blk_lo) * NWAVES;
    bf16* WGU = (bf16*)(c.ws + WS_WGU); bf16* WD = (bf16*)(c.ws + (l == 0 ? WS_WD : WS_WD1));
    if (gw < 0) return;
    for (int it = w_lo * 16 * 512 + gw; it < w_hi * 16 * 512; it += NGW) {
        const int which = it / (16 * 512), r = it % (16 * 512), e = r / 512, item = r % 512;
        const size_t wofs = ((size_t)l * 16 + e) * 1024 * 1024;
        if (which == 0) transpose_item(c.inp[I_WG] + wofs, 1024, 1024, WGU + (size_t)e * 2048 * 1024, 1, scr, item, c.lane);
        else if (which == 1) transpose_item(c.inp[I_WU] + wofs, 1024, 1024, WGU + (size_t)e * 2048 * 1024, 2, scr, item, c.lane);
        else transpose_item(c.inp[I_WDN] + wofs, 1024, 1024, WD + (size_t)e * 1024 * 1024, 0, scr, item, c.lane);
    }
}

__device__ __forceinline__ void p0a(const Ctx& c_) { Ctx c = c_; asm volatile("" : "+s"(c.ws), "+s"(c.inp), "+s"(c.out), "+v"(c.tid)); c.lane = c.tid & 63;
    {
        float* modv = (float*)(c.ws + WS_MODV); LAS float* red = (LAS float*)(c.lds + RING_OFF);
        for (int it = (int)blockIdx.x; it < 192; it += c.G) {
            const int l = it / 96, col = (it % 96) * 64 + c.lane;
            const GAS float* W = c.inp[I_ADAW] + (size_t)l * 1024 * 6144 + col;
            float a0 = 0.f, a1 = 0.f, a2 = 0.f;
            const int kb = c.wave * 128;
#pragma unroll 8
            for (int k = 0; k < 128; ++k) { const float w = W[(size_t)(kb + k) * 6144];
                a0 += silu_f(c.inp[I_C][kb + k]) * w; a1 += silu_f(c.inp[I_C][1024 + kb + k]) * w; a2 += silu_f(c.inp[I_CCTX][kb + k]) * w; }
            red[(c.wave * 3 + 0) * 64 + c.lane] = a0; red[(c.wave * 3 + 1) * 64 + c.lane] = a1; red[(c.wave * 3 + 2) * 64 + c.lane] = a2;
            WG_SYNC();
            if (c.wave < 3) { float s = 0.f;
#pragma unroll
                for (int w = 0; w < 8; ++w) s += red[(w * 3 + c.wave) * 64 + c.lane];
                modv[(size_t)(l * 3 + c.wave) * 6144 + col] = s + c.inp[I_ADAB][l * 6144 + col]; }
            WG_SYNC();
        }
    }
    {
        LAS float* scr = (LAS float*)(c.lds + RING_OFF + c.wave * 16384);
        const int gw = c.vcu * NWAVES + c.wave, NGW = c.G * NWAVES;
        constexpr int I_IN = 16 * 48, I_OUT = 16 * 32, I_GLU = 4 * 8;
        constexpr int NIT = 2 * (I_IN + I_OUT + I_GLU);
        for (int it = gw; it < NIT; it += NGW) {
            int r = it; const int l = r / (I_IN + I_OUT + I_GLU); r %= (I_IN + I_OUT + I_GLU);
            if (r < I_IN) { transpose_item(c.inp[I_WIN] + (size_t)l * 1024 * INW, 1024, INW, (bf16*)(c.ws + WS_WIN) + (size_t)l * INW * 1024, 0, scr, r, c.lane); continue; } r -= I_IN;
            if (r < I_OUT) { transpose_item(c.inp[I_WOUT] + (size_t)l * 1024 * 1024, 1024, 1024, (bf16*)(c.ws + WS_WOUT) + (size_t)l * 1024 * 1024, 0, scr, r, c.lane); continue; } r -= I_OUT;
            transpose_item(c.inp[I_GLUW] + (size_t)l * 256 * 256, 256, 256, (bf16*)(c.ws + WS_WGLU) + (size_t)l * 256 * 256, 0, scr, r, c.lane);
        }
        bf16* wsgu = (bf16*)(c.ws + WS_WSGU);
        for (int i = c.vcu * 512 + c.tid; i < 131072 / 8; i += c.G * 512) { const GAS float* s = c.inp[I_SGUW] + (size_t)i * 8;
            v4u o; o.x = pk2(s[0], s[1]); o.y = pk2(s[2], s[3]); o.z = pk2(s[4], s[5]); o.w = pk2(s[6], s[7]); *(GAS v4u*)(wsgu + (size_t)i * 8) = o; }
    }
    {
        f32x2* POW = (f32x2*)(c.ws + WS_POW); f32x2* BBAR = (f32x2*)(c.ws + WS_BBAR);
        for (int idx = c.vcu * 512 + c.tid; idx < 2 * 2 * 16 * 64; idx += c.G * 512) {
            const double lr = (double)c.inp[I_LRE][idx], li = (double)c.inp[I_LIM][idx], dt = exp((double)c.inp[I_LOGDT][idx >> 6]);
            for (int k = 0; k < 19; ++k) { const double kk = (k == 17) ? 256.0 : (k == 18) ? 2080.0 : (double)k; const double mag = exp(lr * dt * kk), ang = li * dt * kk;
                POW[(size_t)idx * POWS + k] = (f32x2){(float)(mag * cos(ang)), (float)(mag * sin(ang))}; }
            const double mag = exp(lr * dt), ang = li * dt; const double abr = mag * cos(ang), abi = mag * sin(ang);
            const double nr = abr - 1.0, ni = abi, den = lr * lr + li * li;
            const double cr = (nr * lr + ni * li) / den, ci = (ni * lr - nr * li) / den;
            for (int ch = 0; ch < 16; ++ch) { const double br = (double)c.inp[I_BRE][(size_t)idx * 16 + ch], bi = (double)c.inp[I_BIM][(size_t)idx * 16 + ch];
                BBAR[(size_t)idx * 16 + ch] = (f32x2){(float)(cr * br - ci * bi), (float)(cr * bi + ci * br)}; }
        }
    }
    { f32x2* ROPE = (f32x2*)(c.ws + WS_ROPE);
      for (int i = c.vcu * 512 + c.tid; i < 256 * 16; i += c.G * 512) { const int pos = i >> 4, f = i & 15;
          const double inv = exp2(-(double)(2 * f) * (13.287712379549449 / 32.0)), ang = (double)pos * inv; ROPE[i] = (f32x2){(float)cos(ang), (float)sin(ang)}; } }
    convert_experts(c, 0, 0, 3, 0);
}

__device__ __forceinline__ void p0b_tables(const Ctx& c_) { Ctx c = c_; asm volatile("" : "+s"(c.ws), "+s"(c.inp), "+s"(c.out), "+v"(c.tid)); c.lane = c.tid & 63;
    const GAS f32x2* POW = (const GAS f32x2*)(c.ws + WS_POW); const GAS f32x2* BBAR = (const GAS f32x2*)(c.ws + WS_BBAR);
    bf16* EB = (bf16*)(c.ws + WS_EB);
    const int gt = c.vcu * 512 + c.tid, NT = c.G * 512;
    for (int it = gt; it < 262144; it += NT) {
        const int k0 = (it & 31) * 8, n = (it >> 5) & 255, g = (it >> 13) & 15, l = it >> 17;
        const int d = n >> 7, p = (n & 127) >> 1, ri = n & 1, s = k0 >> 4, c0 = k0 & 15;
        const int cidx = ((l * 2 + d) * 16 + g) * 64 + p;
        const f32x2 pw = POW[(size_t)cidx * POWS + (d == 0 ? 15 - s : s)];
        float v[8];
#pragma unroll
        for (int j = 0; j < 8; ++j) { const f32x2 bb = BBAR[(size_t)cidx * 16 + c0 + j]; v[j] = ri ? (pw.x * bb.y + pw.y * bb.x) : (pw.x * bb.x - pw.y * bb.y); }
        v4u o; o.x = pk2(v[0], v[1]); o.y = pk2(v[2], v[3]); o.z = pk2(v[4], v[5]); o.w = pk2(v[6], v[7]);
        *(GAS v4u*)(EB + ((size_t)((l * 16 + g) * 256 + n)) * 256 + k0) = o;
    }
    float* KT = (float*)(c.ws + WS_KTAB);
    for (int it = gt; it < 32768; it += NT) {
        const int c0 = (it & 1) * 8, ch = (it >> 1) & 15, dl = (it >> 5) & 15, d = (it >> 9) & 1, g = (it >> 10) & 15, l = it >> 14;
        const int cb = ((l * 2 + d) * 16 + g) * 64; const size_t cofs = ((size_t)((l * 2 + d) * 16 + g) * 16 + ch) * 64;
        float v[8];
#pragma unroll
        for (int j = 0; j < 8; ++j) v[j] = 0.f;
        for (int p = 0; p < 64; ++p) {
            const float cre = c.inp[I_CRE][cofs + p], cim = c.inp[I_CIM][cofs + p];
            const f32x2 pw = POW[(size_t)(cb + p) * POWS + dl];
            const float wr = cre * pw.x - cim * pw.y, wi = cre * pw.y + cim * pw.x;
#pragma unroll
            for (int j = 0; j < 8; ++j) { const f32x2 bb = BBAR[(size_t)(cb + p) * 16 + c0 + j]; v[j] += wr * bb.x - wi * bb.y; }
        }
        float* dst = KT + ((size_t)(((l * 16 + g) * 2 + d) * 16 + dl) * 16 + ch) * 16 + c0;
        *(GAS f32x4*)dst = (f32x4){v[0], v[1], v[2], v[3]}; *(GAS f32x4*)(dst + 4) = (f32x4){v[4], v[5], v[6], v[7]};
    }
}
__device__ __forceinline__ void tg_assemble(const Ctx& c_) { Ctx c = c_; asm volatile("" : "+s"(c.ws), "+s"(c.inp), "+s"(c.out), "+v"(c.tid)); c.lane = c.tid & 63;
    const GAS f32x2* POW = (const GAS f32x2*)(c.ws + WS_POW); const GAS float* KT = (const GAS float*)(c.ws + WS_KTAB); bf16* TG = (bf16*)(c.ws + WS_TG);
    const int gt = c.vcu * 512 + c.tid, NT = c.G * 512;
    for (int it = gt; it < 524288; it += NT) {
        const int k0 = (it & 63) * 8, n = (it >> 6) & 255, g = (it >> 14) & 15, l = it >> 18;
        const int tau = n >> 4, ch = n & 15;
        float v[8];
        if (k0 < 256) {
            const int s = k0 >> 4, c0 = k0 & 15;
#pragma unroll
            for (int j = 0; j < 8; ++j) v[j] = (s == tau && (c0 + j) == ch) ? c.inp[I_S5D][l * 256 + g * 16 + ch] : 0.f;
#pragma unroll
            for (int d = 0; d < 2; ++d) { const int dl = d == 0 ? tau - s : s - tau;
                if (dl >= 0) { const GAS float* kp = KT + ((size_t)(((l * 16 + g) * 2 + d) * 16 + dl) * 16 + ch) * 16 + c0; const f32x4 k0v = *(const GAS f32x4*)kp, k1v = *(const GAS f32x4*)(kp + 4);
                    v[0] += k0v[0]; v[1] += k0v[1]; v[2] += k0v[2]; v[3] += k0v[3]; v[4] += k1v[0]; v[5] += k1v[1]; v[6] += k1v[2]; v[7] += k1v[3]; } }
        } else {
#pragma unroll
            for (int j = 0; j < 8; ++j) { const int kk = k0 - 256 + j, d = kk >> 7, p = (kk & 127) >> 1, ri = kk & 1;
                const int cidx = ((l * 2 + d) * 16 + g) * 64 + p;
                const float cre = c.inp[I_CRE][((size_t)((l * 2 + d) * 16 + g) * 16 + ch) * 64 + p], cim = c.inp[I_CIM][((size_t)((l * 2 + d) * 16 + g) * 16 + ch) * 64 + p];
                const f32x2 pw = POW[(size_t)cidx * POWS + (d == 0 ? tau + 1 : 16 - tau)];
                const float wr = cre * pw.x - cim * pw.y, wi = cre * pw.y + cim * pw.x;
                v[j] = ri ? -wi : wr; }
        }
        v4u o; o.x = pk2(v[0], v[1]); o.y = pk2(v[2], v[3]); o.z = pk2(v[4], v[5]); o.w = pk2(v[6], v[7]);
        *(GAS v4u*)(TG + ((size_t)((l * 16 + g) * 256 + n)) * 512 + k0) = o;
    }
}

__device__ __forceinline__ void row_prep(const Ctx& c_, int mode, int l) { Ctx c = c_; asm volatile("" : "+s"(c.ws), "+s"(c.inp), "+s"(c.out), "+v"(c.tid)); c.lane = c.tid & 63; asm volatile("" : "+s"(l));
    const int gw = c.vcu * NWAVES + c.wave, NGW = c.G * NWAVES;
    const GAS float* modv = (const GAS float*)(c.ws + WS_MODV);
    const GAS bf16* Y = (const GAS bf16*)(c.ws + WS_R3); GAS bf16* A1 = (GAS bf16*)(c.ws + WS_R1);
    const GAS int* smapL = (const GAS int*)(c.ws + WS_SMAP); const GAS int* smapC = smapL + 2 * 16 * 16384;
    GAS float* hctx = (GAS float*)(c.ws + WS_HCTX);
    const int nrows = (mode == 2) ? MLAT : MT;
    float dscale = 1.0f;
#if defined(TPROBE) || defined(TPROBE_UNIT)
    if (mode == 2) {
#if defined(TPROBE_UNIT)
        const unsigned su = __hip_atomic_load(c.ctl + CW_TS + 40, RLX_AGENT), cn = __hip_atomic_load(c.ctl + CW_TS + 41, RLX_AGENT);
        dscale = 1.0f + floorf((cn ? (float)su / (float)cn : 0.f) * (0.01f / TPQ) + 0.5f) * (TPQ / 1000.0f);
#else
        const unsigned ta = __hip_atomic_load(c.ctl + CW_TS + TPROBE, RLX_AGENT), tb = __hip_atomic_load(c.ctl + CW_TS + TPROBE + 1, RLX_AGENT);
        dscale = 1.0f + floorf((float)(tb - ta) * (0.01f / TPQ) + 0.5f) * (TPQ / 1000.0f);
#endif
    }
#endif
#define RP_LOAD_X(M0, DST) do { const int m0_ = (M0); const bool ic_ = m0_ >= MLAT; _Pragma("unroll") for (int q = 0; q < 4; ++q) { const int m_ = m0_ + q; \
        const GAS float* src_ = ic_ ? c.inp[I_CTX] + (size_t)(m_ - MLAT) * D : c.inp[I_X] + (size_t)m_ * D; \
        _Pragma("unroll") for (int j = 0; j < 4; ++j) DST[q][j] = *(const GAS f32x4*)(src_ + 4 * c.lane + 256 * j); } } while (0)
    f32x4 vnx[4][4];
    if (mode == 0 && gw * 4 < nrows) RP_LOAD_X(gw * 4, vnx);
    for (int m0 = gw * 4; m0 < nrows; m0 += NGW * 4) {
        const bool isctx = m0 >= MLAT; const int b = isctx ? ((m0 - MLAT) >> 8) : (m0 >> 14), mb = isctx ? 2 : b;
        f32x4 v[4][4];
        if (mode == 0) {
#pragma unroll
            for (int q = 0; q < 4; ++q)
#pragma unroll
                for (int j = 0; j < 4; ++j) v[q][j] = vnx[q][j];
            if (m0 + NGW * 4 < nrows) RP_LOAD_X(m0 + NGW * 4, vnx);
        } else
#pragma unroll
        for (int q = 0; q < 4; ++q) { const int m = m0 + q;
            if (mode != 0 && !isctx) { const GAS bf16* hb = (const GAS bf16*)c.out + (size_t)m * 2048;
#pragma unroll
                for (int j = 0; j < 4; ++j) { const u32x2 w = *(const GAS u32x2*)(hb + 4 * c.lane + 256 * j); v[q][j] = (f32x4){bf2f(w.x & 0xffffu), bf2f(w.x >> 16), bf2f(w.y & 0xffffu), bf2f(w.y >> 16)}; } }
            else { const GAS float* src = (mode == 0) ? (isctx ? c.inp[I_CTX] + (size_t)(m - MLAT) * D : c.inp[I_X] + (size_t)m * D) : hctx + (size_t)(m - MLAT) * D;
#pragma unroll
                for (int j = 0; j < 4; ++j) v[q][j] = *(const GAS f32x4*)(src + 4 * c.lane + 256 * j); } }
        if (mode != 0) {
            const GAS float* gff = modv + (size_t)((l - 1 + (mode == 2 ? 1 : 0)) * 3 + mb) * 6144 + 5 * 1024;
            f32x4 acc[4][4]; int myslot[4]; unsigned long long msk[4];
#pragma unroll
            for (int q = 0; q < 4; ++q) { const int m = m0 + q, t = isctx ? ((m - MLAT) & 255) : (m & 16383);
                myslot[q] = (c.lane < NE) ? (isctx ? smapC[(b * 16 + c.lane) * 256 + t] : smapL[(b * 16 + c.lane) * 16384 + t]) : -1;
#pragma unroll
                for (int j = 0; j < 4; ++j) acc[q][j] = (f32x4){0.f, 0.f, 0.f, 0.f}; }
#pragma unroll
            for (int q = 0; q < 4; ++q) msk[q] = __ballot(myslot[q] >= 0);
            while (msk[0] | msk[1] | msk[2] | msk[3]) {
                u32x2 w[4][4]; float f[4];
#pragma unroll
                for (int q = 0; q < 4; ++q) { const bool has = msk[q] != 0; const int e = has ? __builtin_ctzll(msk[q]) : 0; if (has) msk[q] &= msk[q] - 1;
                    const int sl = __shfl(myslot[q], e); f[q] = has ? 1.0f : 0.0f;
                    const size_t y = !has ? (size_t)0 : isctx ? (size_t)(XLAT + e * 256 + b * 32 + sl) : (size_t)((b * 16 + e) * CAPL + sl);
#pragma unroll
                    for (int j = 0; j < 4; ++j) w[q][j] = *(const GAS u32x2*)(Y + y * D + 4 * c.lane + 256 * j); }
#pragma unroll
                for (int q = 0; q < 4; ++q)
#pragma unroll
                    for (int j = 0; j < 4; ++j) acc[q][j] += (f32x4){bf2f(w[q][j].x & 0xffffu), bf2f(w[q][j].x >> 16), bf2f(w[q][j].y & 0xffffu), bf2f(w[q][j].y >> 16)} * f[q];
            }
#pragma unroll
            for (int q = 0; q < 4; ++q) { const int m = m0 + q;
#pragma unroll
                for (int j = 0; j < 4; ++j) { v[q][j] += *(const GAS f32x4*)(gff + 4 * c.lane + 256 * j) * acc[q][j];
                    if (mode == 2) *(GAS f32x4*)(c.out + (size_t)m * D + 4 * c.lane + 256 * j) = v[q][j] * dscale;
                    else if (isctx) *(GAS f32x4*)(hctx + (size_t)(m - MLAT) * D + 4 * c.lane + 256 * j) = v[q][j];
                    else { u32x2 w; w.x = pk2(v[q][j].x, v[q][j].y); w.y = pk2(v[q][j].z, v[q][j].w); *(GAS u32x2*)((GAS bf16*)c.out + (size_t)m * 2048 + 4 * c.lane + 256 * j) = w; } } }
        }
        if (mode == 2) continue;
        float rstd[4];
#pragma unroll
        for (int q = 0; q < 4; ++q) { float ss = 0.f;
#pragma unroll
            for (int j = 0; j < 4; ++j) ss += (v[q][j].x * v[q][j].x + v[q][j].y * v[q][j].y) + (v[q][j].z * v[q][j].z + v[q][j].w * v[q][j].w);
            rstd[q] = ss; }
#pragma unroll
        for (int o = 1; o < 64; o <<= 1) {
#pragma unroll
            for (int q = 0; q < 4; ++q) rstd[q] += __shfl_xor(rstd[q], o); }
#pragma unroll
        for (int q = 0; q < 4; ++q) rstd[q] = 1.0f / sqrtf(rstd[q] * (1.0f / D) + EPS);
        const GAS float* mo = modv + (size_t)(l * 3 + mb) * 6144; const GAS float* gn = c.inp[I_NMIXG] + l * D;
#pragma unroll
        for (int j = 0; j < 4; ++j) { const int col = 4 * c.lane + 256 * j;
            const f32x4 g = *(const GAS f32x4*)(gn + col), sh = *(const GAS f32x4*)(mo + col), sc = *(const GAS f32x4*)(mo + 1024 + col);
            const f32x4 gs = g * (sc + 1.0f);
#pragma unroll
            for (int q = 0; q < 4; ++q) { const f32x4 a = v[q][j] * rstd[q] * gs + sh;
                u32x2 w; w.x = pk2(a.x, a.y); w.y = pk2(a.z, a.w); *(GAS u32x2*)(A1 + (size_t)(m0 + q) * D + col) = w; } }
    }
}
#undef RP_LOAD_X

__device__ __forceinline__ f32x4 mfma16(bf16x8 a, bf16x8 b, f32x4 c) { return __builtin_amdgcn_mfma_f32_16x16x32_bf16(a, b, c, 0, 0, 0); }
__device__ __forceinline__ f32x16 mfma32(bf16x8 a, bf16x8 b, f32x16 c) { return __builtin_amdgcn_mfma_f32_32x32x16_bf16(a, b, c, 0, 0, 0); }

__device__ __forceinline__ void qk_prep_rows(const Ctx& c_, int l) { Ctx c = c_; asm volatile("" : "+s"(c.ws), "+s"(c.inp), "+s"(c.out), "+v"(c.tid)); c.lane = c.tid & 63; asm volatile("" : "+s"(l));
    bf16* P = (bf16*)(c.ws + WS_R2); const GAS f32x2* ROPE = (const GAS f32x2*)(c.ws + WS_ROPE);
    const int j = c.lane & 7, rsub = c.lane >> 4, chunk = c.lane & 15;
    const f32x4 kg0 = *(const GAS f32x4*)(c.inp[I_KNG] + l * 64 + 8 * j), kg1 = *(const GAS f32x4*)(c.inp[I_KNG] + l * 64 + 8 * j + 4);
    const float kgn[8] = {kg0[0], kg0[1], kg0[2], kg0[3], kg1[0], kg1[1], kg1[2], kg1[3]};
#pragma unroll 2
    for (int blk = c.vcu * NWAVES + c.wave; blk < MT / 4; blk += c.G * NWAVES) {
        const int m = blk * 4 + rsub;
        const bool isctx = m >= MLAT;
        bf16* kp = P + (size_t)m * INW + 512 + 8 * chunk;
        const v4u w = *(const GAS v4u*)kp; const unsigned ws4[4] = {w.x, w.y, w.z, w.w};
        float cs[8], sn[8];
        if (!isctx) { const int n = m & 16383, pos = (j < 4) ? (n >> 6) : (n & 63); const GAS f32x4* tp = (const GAS f32x4*)(ROPE + pos * 16 + 8 * (j & 1));
#pragma unroll
            for (int q = 0; q < 4; ++q) { const f32x4 t4 = tp[q]; cs[2 * q] = t4[0]; sn[2 * q] = t4[1]; cs[2 * q + 1] = t4[2]; sn[2 * q + 1] = t4[3]; } }
        else {
#pragma unroll
            for (int e = 0; e < 8; ++e) { cs[e] = 1.f; sn[e] = 0.f; } }
        float x[8]; float ss = 0.f;
#pragma unroll
        for (int e = 0; e < 8; ++e) { x[e] = __uint_as_float((e & 1) ? (ws4[e >> 1] & 0xffff0000u) : (ws4[e >> 1] << 16)); ss += x[e] * x[e]; }
        ss += __shfl_xor(ss, 1); ss += __shfl_xor(ss, 2); ss += __shfl_xor(ss, 4);
        const float rstd = 1.0f / sqrtf(ss * (1.0f / 64.0f) + EPS);
        float o[8];
#pragma unroll
        for (int e = 0; e < 8; ++e) { const float xn = x[e] * rstd * kgn[e]; const float pr = __shfl_xor(xn, 2);
            o[e] = (j & 2) ? (xn * cs[e] + pr * sn[e]) : (xn * cs[e] - pr * sn[e]); }
        v4u ow; ow.x = pk2(o[0], o[1]); ow.y = pk2(o[2], o[3]); ow.z = pk2(o[4], o[5]); ow.w = pk2(o[6], o[7]);
        *(GAS v4u*)kp = ow;
    }
}
__device__ __forceinline__ int s5_scan_sc(int q, int b, int d) { return q < 16 ? (2048 + 16 * b + (d ? 15 - q : q)) : (b * 1024 + (d ? 1039 - q : q - 16)); }
__device__ __forceinline__ void s5_scan_unit(const Ctx& c_, int l, int unit) { Ctx c = c_; asm volatile("" : "+s"(c.ws), "+s"(c.inp), "+s"(c.out), "+v"(c.tid)); c.lane = c.tid & 63; asm volatile("" : "+s"(l));
    const int g = unit & 15, d = (unit >> 4) & 1, b = unit >> 5;
    const GAS float* E = (const GAS float*)(c.ws + WS_R2 + OFF_E) + (size_t)g * 2304 * 256 + d * 128 + 2 * c.lane;
    bf16* Am = (bf16*)(c.ws + WS_R1 + OFF_AMAT) + (size_t)g * 2304 * 512 + 256 + d * 128 + 2 * c.lane;
    const GAS f32x2* POW = (const GAS f32x2*)(c.ws + WS_POW) + (size_t)(((l * 2 + d) * 16 + g) * 64 + c.lane) * POWS;
    const f32x2 a16 = POW[16], aseg = POW[18];
    LAS f32x2* X = (LAS f32x2*)(c.lds + RING_OFF);
    const int q0 = 130 * c.wave;
    float hr = 0.f, hi = 0.f;
#pragma unroll 1
    for (int s0 = 0; s0 < 130; s0 += 26) {
        f32x2 e[26];
#pragma unroll
        for (int j = 0; j < 26; ++j) e[j] = *(const GAS f32x2*)(E + (size_t)s5_scan_sc(q0 + s0 + j, b, d) * 256);
#pragma unroll
        for (int j = 0; j < 26; ++j) { const float nr = a16.x * hr - a16.y * hi + e[j].x, ni = a16.x * hi + a16.y * hr + e[j].y; hr = nr; hi = ni; }
    }
    __syncthreads();
    X[c.wave * 64 + c.lane] = (f32x2){hr, hi};
    LDS_WAIT(); __syncthreads();
    hr = 0.f; hi = 0.f;
    for (int w = 0; w < c.wave; ++w) { const f32x2 x = X[w * 64 + c.lane]; const float nr = aseg.x * hr - aseg.y * hi + x.x, ni = aseg.x * hi + aseg.y * hr + x.y; hr = nr; hi = ni; }
#pragma unroll 1
    for (int s0 = 0; s0 < 130; s0 += 26) {
        f32x2 e[26];
#pragma unroll
        for (int j = 0; j < 26; ++j) e[j] = *(const GAS f32x2*)(E + (size_t)s5_scan_sc(q0 + s0 + j, b, d) * 256);
#pragma unroll
        for (int j = 0; j < 26; ++j) { *(GAS unsigned*)(Am + (size_t)s5_scan_sc(q0 + s0 + j, b, d) * 512) = pk2(hr, hi);
            const float nr = a16.x * hr - a16.y * hi + e[j].x, ni = a16.x * hi + a16.y * hr + e[j].y; hr = nr; hi = ni; }
    }
}

constexpr int ATT_ROWB = 144;
constexpr int ATT_TILEB = 64 * ATT_ROWB, ATT_BUFB = 4 * ATT_TILEB;
constexpr float ATT_SUMMAX = 1099511627776.0f;
template <bool FAST> __device__ __forceinline__ bool attn_unit_t(const Ctx& c_, int l, int unit) { Ctx c = c_; asm volatile("" : "+s"(c.ws), "+s"(c.inp), "+s"(c.out), "+v"(c.tid)); c.lane = c.tid & 63; asm volatile("" : "+s"(l));
    const GAS bf16* P = (const GAS bf16*)(c.ws + WS_R2); GAS bf16* mix = (GAS bf16*)(c.ws + WS_R1);
    int b, kvh, qb; bool isctx;
    if (unit < 512) { b = unit >> 8; kvh = (unit >> 7) & 1; qb = unit & 127; isctx = false; }
    else { const int u2 = unit - 512; b = u2 >> 2; kvh = (u2 >> 1) & 1; qb = u2 & 1; isctx = true; }
    const int r32 = c.lane & 31, hi = c.lane >> 5, wsub = c.wave >> 2;
    const int hq = kvh * 4 + (c.wave & 3);
    const float sink2 = c.inp[I_SINK][l * 8 + hq] * LOG2E;
    const int q4 = (c.lane & 15) >> 2, p4 = c.lane & 3, d0 = 16 * ((c.lane >> 4) & 1);
    const int vlane_off = (4 * hi + q4) * ATT_ROWB + (d0 + 4 * p4) * 2;
    const int qrow0 = (isctx ? (MLAT + b * LC + qb * 128) : (b * SEQ + qb * 128)) + 64 * wsub + r32;
    const int key = c.tid >> 3, chk = c.tid & 7;
    int p = isctx ? 3 : 0;
    while (p < 3 && (128 * (qb - 1 + p) < 0 || 128 * (qb - 1 + p) >= SEQ)) ++p;
    int pn = p + 1;
    while (pn < 3 && (128 * (qb - 1 + pn) < 0 || 128 * (qb - 1 + pn) >= SEQ)) ++pn;
    v4u kv[2], vv[2];
#define ATT_LOAD(PP) do { const int krow_ = ((PP) < 3 ? b * SEQ + 128 * (qb - 1 + (PP)) : MLAT + b * LC + 128 * ((PP) - 3)) + key; const GAS bf16* src_ = P + (size_t)krow_ * INW + 64 * kvh + 8 * chk; \
        kv[0] = *(const GAS v4u*)(src_ + 512); vv[0] = *(const GAS v4u*)(src_ + 640); kv[1] = *(const GAS v4u*)(src_ + 64 * INW + 512); vv[1] = *(const GAS v4u*)(src_ + 64 * INW + 640); } while (0)
#define ATT_STORE(BUF) do { LAS unsigned char* d_ = c.lds + (BUF) * ATT_BUFB + key * ATT_ROWB + chk * 16; \
        *(LAS v4u*)(d_) = kv[0]; *(LAS v4u*)(d_ + ATT_TILEB) = kv[1]; *(LAS v4u*)(d_ + 2 * ATT_TILEB) = vv[0]; *(LAS v4u*)(d_ + 3 * ATT_TILEB) = vv[1]; } while (0)
    ATT_LOAD(p);
    bf16x8 qf[2][4];
#pragma unroll
    for (int qg = 0; qg < 2; ++qg)
#pragma unroll
        for (int ks = 0; ks < 4; ++ks) qf[qg][ks] = *(const GAS bf16x8*)(P + (size_t)(qrow0 + 32 * qg) * INW + 64 * hq + 16 * ks + 8 * hi);
    { const GAS f32x2* ROPE = (const GAS f32x2*)(c.ws + WS_ROPE);
      float qgn[4][8];
#pragma unroll
      for (int ks = 0; ks < 4; ++ks) { const f32x4 g0 = *(const GAS f32x4*)(c.inp[I_QNG] + l * 64 + 16 * ks + 8 * hi), g1 = *(const GAS f32x4*)(c.inp[I_QNG] + l * 64 + 16 * ks + 8 * hi + 4);
          qgn[ks][0] = g0[0]; qgn[ks][1] = g0[1]; qgn[ks][2] = g0[2]; qgn[ks][3] = g0[3]; qgn[ks][4] = g1[0]; qgn[ks][5] = g1[1]; qgn[ks][6] = g1[2]; qgn[ks][7] = g1[3]; }
#pragma unroll
      for (int qg = 0; qg < 2; ++qg) {
          float x[4][8]; float ss = 0.f;
#pragma unroll
          for (int ks = 0; ks < 4; ++ks) { const v4u w = __builtin_bit_cast(v4u, qf[qg][ks]); const unsigned ws4[4] = {w.x, w.y, w.z, w.w};
#pragma unroll
              for (int e = 0; e < 8; ++e) { x[ks][e] = __uint_as_float((e & 1) ? (ws4[e >> 1] & 0xffff0000u) : (ws4[e >> 1] << 16)); ss += x[ks][e] * x[ks][e]; } }
          ss += __shfl_xor(ss, 32);
          const float rstd = 1.0f / sqrtf(ss * (1.0f / 64.0f) + EPS) * (0.125f * LOG2E);
#pragma unroll
          for (int ks = 0; ks < 4; ++ks)
#pragma unroll
              for (int e = 0; e < 8; ++e) x[ks][e] *= rstd * qgn[ks][e];
          if (!isctx) { const int n = qb * 128 + 64 * wsub + 32 * qg + r32;
#pragma unroll
              for (int ax = 0; ax < 2; ++ax) { const int pos = ax == 0 ? (n >> 6) : (n & 63); const GAS f32x4* tp = (const GAS f32x4*)(ROPE + pos * 16 + 8 * hi);
#pragma unroll
                  for (int q = 0; q < 4; ++q) { const f32x4 t4 = tp[q];
#pragma unroll
                      for (int h2 = 0; h2 < 2; ++h2) { const int e = 2 * q + h2; const float cs = t4[2 * h2], sn = t4[2 * h2 + 1];
                          const float x1 = x[2 * ax][e], x2 = x[2 * ax + 1][e]; x[2 * ax][e] = x1 * cs - x2 * sn; x[2 * ax + 1][e] = x2 * cs + x1 * sn; } } } }
#pragma unroll
          for (int ks = 0; ks < 4; ++ks) { v4u w; w.x = pk2(x[ks][0], x[ks][1]); w.y = pk2(x[ks][2], x[ks][3]); w.z = pk2(x[ks][4], x[ks][5]); w.w = pk2(x[ks][6], x[ks][7]); qf[qg][ks] = __builtin_bit_cast(bf16x8, w); }
      } }
    float m_run[2], l_run[2]; f32x16 o[2][2];
    const float sinkp = __builtin_amdgcn_exp2f(sink2); bool bad = FAST && !(sinkp <= 3.0e38f);
#pragma unroll
    for (int qg = 0; qg < 2; ++qg) { m_run[qg] = FAST ? 0.f : sink2; l_run[qg] = hi == 0 ? (FAST ? sinkp : 1.0f) : 0.0f;
#pragma unroll
        for (int dt = 0; dt < 2; ++dt)
#pragma unroll
            for (int r = 0; r < 16; ++r) o[qg][dt][r] = 0.f; }
    if (FAST && c.tid == 0) c.MISC[24] = 0u;
    __syncthreads();
    ATT_STORE(0);
    if (pn < 5) ATT_LOAD(pn);
    LDS_WAIT(); __syncthreads();
    int cur = 0;
#pragma unroll 1
    while (p < 5) {
        int pnn = pn + 1;
        while (pnn < 3 && (128 * (qb - 1 + pnn) < 0 || 128 * (qb - 1 + pnn) >= SEQ)) ++pnn;
        if (pn < 5) { ATT_STORE(cur ^ 1); if (pnn < 5) ATT_LOAD(pnn); }
        const bool win = p < 3;
#pragma unroll (FAST ? 2 : 1)
        for (int sb = 0; sb < 2; ++sb) {
            const int t = 2 * p + sb;
            LAS unsigned char* kbase = c.lds + cur * ATT_BUFB + sb * ATT_TILEB; LAS unsigned char* vbase = kbase + 2 * ATT_TILEB;
            bool skip[2] = {false, false}, need_mask[2] = {false, false};
            if (win) {
    #pragma unroll
                for (int qg = 0; qg < 2; ++qg) { const int qlo = 128 * qb + 64 * wsub + 32 * qg, klo = 128 * (qb - 1) + 64 * t, dmax = klo + 63 - qlo, dmin = klo - qlo - 31;
                    skip[qg] = dmin > 128 || dmax < -128; need_mask[qg] = dmax > 128 || dmin < -128; } }
            if (!(skip[0] && skip[1])) {
                bf16x8 kf[8];
    #pragma unroll
                for (int ks = 0; ks < 4; ++ks) { kf[2 * ks] = *(const LAS bf16x8*)(kbase + r32 * ATT_ROWB + (16 * ks + 8 * hi) * 2);
                    kf[2 * ks + 1] = *(const LAS bf16x8*)(kbase + (32 + r32) * ATT_ROWB + (16 * ks + 8 * hi) * 2); }
                bf16x8 pf[2][4];
    #pragma unroll
                for (int qg = 0; qg < 2; ++qg) {
                    if (!skip[qg]) {
                        f32x16 s0, s1; { const float nm = FAST ? 0.f : -m_run[qg];
    #pragma unroll
                            for (int r = 0; r < 16; ++r) { s0[r] = nm; s1[r] = nm; } }
    #pragma unroll
                        for (int ks = 0; ks < 4; ++ks) { s0 = mfma32(kf[2 * ks], qf[qg][ks], s0); s1 = mfma32(kf[2 * ks + 1], qf[qg][ks], s1); }
                        if (need_mask[qg]) {
                            const int qp = 128 * qb + 64 * wsub + 32 * qg + r32, kb = 128 * (qb - 1) + 64 * t + 4 * hi;
    #pragma unroll
                            for (int r = 0; r < 16; ++r) { const int dk = kb + (r & 3) + 8 * (r >> 2) - qp;
                                if (dk > 128 || dk < -128) s0[r] = -INFINITY;
                                if (dk + 32 > 128 || dk + 32 < -128) s1[r] = -INFINITY; }
                        }
                        if constexpr (FAST) {
                            float sm[4] = {0.f, 0.f, 0.f, 0.f};
    #pragma unroll
                            for (int r = 0; r < 16; ++r) { s0[r] = __builtin_amdgcn_exp2f(s0[r]); s1[r] = __builtin_amdgcn_exp2f(s1[r]); float t2 = s0[r] + s1[r]; asm("" : "+v"(t2)); sm[r & 3] = r < 4 ? t2 : sm[r & 3] + t2; asm("" : "+v"(sm[r & 3])); }
                            const float st = (sm[0] + sm[1]) + (sm[2] + sm[3]);
                            bad = bad || !(st <= ATT_SUMMAX);
                            l_run[qg] += st;
    #pragma unroll
                            for (int s2 = 0; s2 < 2; ++s2) {
                                v4u pw; pw.x = pk2(s0[8 * s2 + 0], s0[8 * s2 + 1]); pw.y = pk2(s0[8 * s2 + 2], s0[8 * s2 + 3]); pw.z = pk2(s0[8 * s2 + 4], s0[8 * s2 + 5]); pw.w = pk2(s0[8 * s2 + 6], s0[8 * s2 + 7]);
                                pf[qg][s2] = __builtin_bit_cast(bf16x8, pw);
                                v4u pv; pv.x = pk2(s1[8 * s2 + 0], s1[8 * s2 + 1]); pv.y = pk2(s1[8 * s2 + 2], s1[8 * s2 + 3]); pv.z = pk2(s1[8 * s2 + 4], s1[8 * s2 + 5]); pv.w = pk2(s1[8 * s2 + 6], s1[8 * s2 + 7]);
                                pf[qg][2 + s2] = __builtin_bit_cast(bf16x8, pv); }
                        } else {
                        f32x16 e0, e1; float st;
                        { float sm[4] = {0.f, 0.f, 0.f, 0.f};
    #pragma unroll
                          for (int r = 0; r < 16; ++r) { e0[r] = __builtin_amdgcn_exp2f(s0[r]); e1[r] = __builtin_amdgcn_exp2f(s1[r]); float t2 = e0[r] + e1[r]; asm("" : "+v"(t2)); sm[r & 3] = r < 4 ? t2 : sm[r & 3] + t2; asm("" : "+v"(sm[r & 3])); }
                          st = (sm[0] + sm[1]) + (sm[2] + sm[3]); }
                        if (__any(!(st <= ATT_SUMMAX))) {
                            float mxa[8];
    #pragma unroll
                            for (int i = 0; i < 8; ++i) mxa[i] = fmaxf(fmaxf(s0[i], s0[i + 8]), fmaxf(s1[i], s1[i + 8]));
                            float mx = fmaxf(fmaxf(fmaxf(mxa[0], mxa[1]), fmaxf(mxa[2], mxa[3])), fmaxf(fmaxf(mxa[4], mxa[5]), fmaxf(mxa[6], mxa[7])));
                            mx = fmaxf(mx, __shfl_xor(mx, 32));
                            const float dl = fmaxf(mx, 0.f), alpha = __builtin_amdgcn_exp2f(-dl);
                            m_run[qg] += dl; l_run[qg] *= alpha;
    #pragma unroll
                            for (int dt = 0; dt < 2; ++dt)
    #pragma unroll
                                for (int r = 0; r < 16; ++r) o[qg][dt][r] *= alpha;
                            float sm[4] = {0.f, 0.f, 0.f, 0.f};
    #pragma unroll
                            for (int r = 0; r < 16; ++r) { e0[r] = __builtin_amdgcn_exp2f(s0[r] - dl); e1[r] = __builtin_amdgcn_exp2f(s1[r] - dl); sm[r & 3] += e0[r] + e1[r]; }
                            st = (sm[0] + sm[1]) + (sm[2] + sm[3]);
                        }
                        l_run[qg] += st;
    #pragma unroll
                        for (int s2 = 0; s2 < 2; ++s2) {
                            v4u pw; pw.x = pk2(e0[8 * s2 + 0], e0[8 * s2 + 1]); pw.y = pk2(e0[8 * s2 + 2], e0[8 * s2 + 3]); pw.z = pk2(e0[8 * s2 + 4], e0[8 * s2 + 5]); pw.w = pk2(e0[8 * s2 + 6], e0[8 * s2 + 7]);
                            pf[qg][s2] = __builtin_bit_cast(bf16x8, pw);
                            v4u pv; pv.x = pk2(e1[8 * s2 + 0], e1[8 * s2 + 1]); pv.y = pk2(e1[8 * s2 + 2], e1[8 * s2 + 3]); pv.z = pk2(e1[8 * s2 + 4], e1[8 * s2 + 5]); pv.w = pk2(e1[8 * s2 + 6], e1[8 * s2 + 7]);
                            pf[qg][2 + s2] = __builtin_bit_cast(bf16x8, pv); }
                        }
                    } else {
    #pragma unroll
                        for (int i = 0; i < 4; ++i) pf[qg][i] = (bf16x8){0, 0, 0, 0, 0, 0, 0, 0};
                    }
                }
                bf16x8 vf[2][4];
    #pragma unroll
                for (int dt = 0; dt < 2; ++dt)
    #pragma unroll
                    for (int ks4 = 0; ks4 < 4; ++ks4) {
                        LAS unsigned char* vp = vbase + (16 * ks4) * ATT_ROWB + 64 * dt + vlane_off;
                        const v4i16_t lo = __builtin_amdgcn_ds_read_tr16_b64_v4i16((LAS v4i16_t*)vp);
                        const v4i16_t h8 = __builtin_amdgcn_ds_read_tr16_b64_v4i16((LAS v4i16_t*)(vp + 8 * ATT_ROWB));
                        vf[dt][ks4] = (bf16x8){lo[0], lo[1], lo[2], lo[3], h8[0], h8[1], h8[2], h8[3]}; }
    #pragma unroll
                for (int ks4 = 0; ks4 < 4; ++ks4)
    #pragma unroll
                    for (int dt = 0; dt < 2; ++dt)
    #pragma unroll
                        for (int qg = 0; qg < 2; ++qg) o[qg][dt] = mfma32(vf[dt][ks4], pf[qg][ks4], o[qg][dt]);
            }
        }
        LDS_WAIT(); __syncthreads();
        p = pn; pn = pnn; cur ^= 1;
    }
#undef ATT_LOAD
#undef ATT_STORE
    if constexpr (FAST) {
        if (__any(bad) && c.lane == 0) c.MISC[24] = 1u;
        LDS_WAIT(); __syncthreads();
        if (c.MISC[24] != 0u) return true;
    }
#pragma unroll
    for (int qg = 0; qg < 2; ++qg) {
        const float lt = l_run[qg] + __shfl_xor(l_run[qg], 32), il = 1.0f / lt;
        GAS bf16* orow = mix + (size_t)(qrow0 + 32 * qg) * D + 64 * hq + 4 * hi;
#pragma unroll
        for (int dt = 0; dt < 2; ++dt)
#pragma unroll
            for (int rr = 0; rr < 4; ++rr) { u32x2 w; w.x = pk2(o[qg][dt][4 * rr] * il, o[qg][dt][4 * rr + 1] * il); w.y = pk2(o[qg][dt][4 * rr + 2] * il, o[qg][dt][4 * rr + 3] * il);
                *(GAS u32x2*)(orow + 32 * dt + 8 * rr) = w; }
    }
    return false;
}

constexpr int SGU_ROWB = 528;
__device__ __forceinline__ void sgu_unit(const Ctx& c_, int l, int chunk) { Ctx c = c_; asm volatile("" : "+s"(c.ws), "+s"(c.inp), "+s"(c.out), "+v"(c.tid)); c.lane = c.tid & 63; asm volatile("" : "+s"(l));
    const bf16* P = (const bf16*)(c.ws + WS_R2); bf16* mix = (bf16*)(c.ws + WS_R1);
    const bf16* Ws = (const bf16*)(c.ws + WS_WSGU) + (size_t)l * 4 * 128 * 128;
    const int r0 = chunk * 128, fr = c.lane & 15, fq = c.lane >> 4;
    __syncthreads();
    { const f32x4 gn = *(const GAS f32x4*)(c.inp[I_SGUNG] + l * 256 + 4 * c.lane);
#pragma unroll 1
      for (int r4 = 0; r4 < 16; r4 += 4) {
        u32x2 w[4]; float v[4][4], ss[4];
#pragma unroll
        for (int q = 0; q < 4; ++q) w[q] = *(const GAS u32x2*)(P + (size_t)(r0 + c.wave * 16 + r4 + q) * INW + 1280 + 4 * c.lane);
#pragma unroll
        for (int q = 0; q < 4; ++q) { v[q][0] = gelu_tanh(bf2f(w[q].x & 0xffffu)); v[q][1] = gelu_tanh(bf2f(w[q].x >> 16)); v[q][2] = gelu_tanh(bf2f(w[q].y & 0xffffu)); v[q][3] = gelu_tanh(bf2f(w[q].y >> 16));
            ss[q] = (v[q][0] * v[q][0] + v[q][1] * v[q][1]) + (v[q][2] * v[q][2] + v[q][3] * v[q][3]); }
#pragma unroll
        for (int o = 1; o < 64; o <<= 1) {
#pragma unroll
            for (int q = 0; q < 4; ++q) ss[q] += __shfl_xor(ss[q], o); }
#pragma unroll
        for (int q = 0; q < 4; ++q) { const int s = c.wave * 16 + r4 + q; const float rstd = 1.0f / sqrtf(ss[q] * (1.0f / 256.0f) + EPS);
            u32x2 ow; ow.x = pk2(v[q][0] * rstd * gn.x, v[q][1] * rstd * gn.y); ow.y = pk2(v[q][2] * rstd * gn.z, v[q][3] * rstd * gn.w);
            *(LAS u32x2*)(c.lds + s * SGU_ROWB + 8 * c.lane) = ow; } } }
    LDS_WAIT(); __syncthreads();
    const int gg = c.wave >> 1, th = c.wave & 1;
    bf16x8 a[4][4];
#pragma unroll
    for (int mt = 0; mt < 4; ++mt)
#pragma unroll
        for (int ks = 0; ks < 4; ++ks) a[mt][ks] = *(const GAS bf16x8*)(Ws + ((size_t)gg * 128 + 64 * th + 16 * mt + fr) * 128 + 32 * ks + 8 * fq);
    u32x2 uw[4][4]; float bsv[4];
#pragma unroll
    for (int mt = 0; mt < 4; ++mt) { const int t = 64 * th + 16 * mt + fr; bsv[mt] = c.inp[I_SGUB][(l * 4 + gg) * 128 + t];
#pragma unroll
        for (int nt = 0; nt < 4; ++nt) uw[nt][mt] = *(const GAS u32x2*)(P + (size_t)(r0 + t) * INW + 1024 + 64 * gg + 16 * nt + 4 * fq); }
#pragma unroll
    for (int nt = 0; nt < 4; ++nt) {
        f32x4 acc[4];
#pragma unroll
        for (int mt = 0; mt < 4; ++mt) acc[mt] = (f32x4){0.f, 0.f, 0.f, 0.f};
#pragma unroll
        for (int ks = 0; ks < 4; ++ks) {
            LAS unsigned char* vp = c.lds + (32 * ks + 8 * fq + (fr >> 2)) * SGU_ROWB + (64 * gg + 16 * nt + 4 * (fr & 3)) * 2;
            const v4i16_t lo = __builtin_amdgcn_ds_read_tr16_b64_v4i16((LAS v4i16_t*)vp);
            const v4i16_t h8 = __builtin_amdgcn_ds_read_tr16_b64_v4i16((LAS v4i16_t*)(vp + 4 * SGU_ROWB));
            const bf16x8 bfr = (bf16x8){lo[0], lo[1], lo[2], lo[3], h8[0], h8[1], h8[2], h8[3]};
#pragma unroll
            for (int mt = 0; mt < 4; ++mt) acc[mt] = mfma16(bfr, a[mt][ks], acc[mt]); }
#pragma unroll
        for (int mt = 0; mt < 4; ++mt) { const int t = 64 * th + 16 * mt + fr, ch = 64 * gg + 16 * nt + 4 * fq;
            const float bs = bsv[mt]; const u32x2 w = uw[nt][mt];
            const float u0 = gelu_tanh(bf2f(w.x & 0xffffu)), u1 = gelu_tanh(bf2f(w.x >> 16)), u2 = gelu_tanh(bf2f(w.y & 0xffffu)), u3 = gelu_tanh(bf2f(w.y >> 16));
            u32x2 ow; ow.x = pk2(u0 * (acc[mt][0] + bs), u1 * (acc[mt][1] + bs)); ow.y = pk2(u2 * (acc[mt][2] + bs), u3 * (acc[mt][3] + bs));
            *(GAS u32x2*)(mix + (size_t)(r0 + t) * D + 768 + ch) = ow; }
    }
}

constexpr int RW_PITCH = 1040;
__device__ __forceinline__ void ffn_prep(const Ctx& c_, int l, int nrows) { Ctx c = c_; asm volatile("" : "+s"(c.ws), "+s"(c.inp), "+s"(c.out), "+v"(c.tid)); c.lane = c.tid & 63; asm volatile("" : "+s"(l));
    const int gw = c.vcu * NWAVES + c.wave, NGW = c.G * NWAVES;
    const GAS float* modv = (const GAS float*)(c.ws + WS_MODV); bf16* F = (bf16*)(c.ws + WS_R3 + 66 * MiB);
    float* probsL = (float*)(c.ws + WS_PROBS); float* probsC = probsL + 2 * 16 * 16384;
    const GAS float* hctx = (const GAS float*)(c.ws + WS_HCTX); const GAS float* rw = c.inp[I_ROUTW] + (size_t)l * D * NE;
    __syncthreads();
    { f32x4 rv[8];
#pragma unroll
      for (int r = 0; r < 8; ++r) rv[r] = *(const GAS f32x4*)(rw + 4 * (c.tid + 512 * r));
#pragma unroll
      for (int r = 0; r < 8; ++r) { const int idx = 4 * (c.tid + 512 * r), k = idx >> 4, e = idx & 15, L = (k & 255) >> 2, j = k >> 8, i = k & 3;
        *(LAS f32x4*)(c.lds + L * RW_PITCH + ((j * 4 + i) * 16 + e) * 4) = rv[r]; } }
    LDS_WAIT(); __syncthreads();
    const GAS float* gn = c.inp[I_NFFNG] + l * D;
    const int myexp = ((c.lane & 1) << 3) | (((c.lane >> 1) & 1) << 2) | (((c.lane >> 2) & 1) << 1) | ((c.lane >> 3) & 1);
#define FFN_LOAD_RAW(BLK, DST) do { _Pragma("unroll") for (int q = 0; q < 4; ++q) { const GAS bf16* hb_ = (const GAS bf16*)c.out + (size_t)((BLK) * 4 + q) * 2048; \
            _Pragma("unroll") for (int j = 0; j < 4; ++j) DST[q][j] = *(const GAS u32x2*)(hb_ + 4 * c.lane + 256 * j); } } while (0)
    u32x2 wn[4][4];
    if (gw < nrows / 4 && gw * 4 < MLAT) FFN_LOAD_RAW(gw, wn);
    for (int blk = gw; blk < nrows / 4; blk += NGW) {
        const int m0 = blk * 4; const bool isctx = m0 >= MLAT; const int b = isctx ? ((m0 - MLAT) >> 8) : (m0 >> 14), mb = isctx ? 2 : b;
        const GAS float* mo = modv + (size_t)(l * 3 + mb) * 6144;
        f32x4 gsc[4], sh[4];
#pragma unroll
        for (int j = 0; j < 4; ++j) { const int col = 4 * c.lane + 256 * j; gsc[j] = *(const GAS f32x4*)(gn + col) * (*(const GAS f32x4*)(mo + 4 * 1024 + col) + 1.0f); sh[j] = *(const GAS f32x4*)(mo + 3 * 1024 + col); }
#pragma unroll 1
        for (int r4 = 0; r4 < 4; r4 += 4) { asm volatile("" ::: "memory");
            f32x4 v[4][4]; float rstd[4];
#pragma unroll
            for (int q = 0; q < 4; ++q) { const int m = m0 + r4 + q;
                if (isctx) { const GAS float* src = hctx + (size_t)(m - MLAT) * D;
#pragma unroll
                    for (int j = 0; j < 4; ++j) v[q][j] = *(const GAS f32x4*)(src + 4 * c.lane + 256 * j); }
                else {
#pragma unroll
                    for (int j = 0; j < 4; ++j) { const u32x2 w = wn[q][j]; v[q][j] = (f32x4){bf2f(w.x & 0xffffu), bf2f(w.x >> 16), bf2f(w.y & 0xffffu), bf2f(w.y >> 16)}; } } }
            if (blk + NGW < nrows / 4 && (blk + NGW) * 4 < MLAT) FFN_LOAD_RAW(blk + NGW, wn);
#pragma unroll
            for (int q = 0; q < 4; ++q) { float ss = 0.f;
#pragma unroll
                for (int j = 0; j < 4; ++j) ss += (v[q][j].x * v[q][j].x + v[q][j].y * v[q][j].y) + (v[q][j].z * v[q][j].z + v[q][j].w * v[q][j].w);
                rstd[q] = ss; }
#pragma unroll
            for (int o = 1; o < 64; o <<= 1) {
#pragma unroll
                for (int q = 0; q < 4; ++q) rstd[q] += __shfl_xor(rstd[q], o); }
#pragma unroll
            for (int q = 0; q < 4; ++q) rstd[q] = 1.0f / sqrtf(rstd[q] * (1.0f / D) + EPS);
            float lg[4][16];
#pragma unroll
            for (int q = 0; q < 4; ++q)
#pragma unroll
                for (int e = 0; e < 16; ++e) lg[q][e] = 0.f;
#pragma unroll
            for (int j = 0; j < 4; ++j) {
#pragma unroll
                for (int q = 0; q < 4; ++q) { v[q][j] = v[q][j] * rstd[q] * gsc[j] + sh[j];
                    u32x2 w; w.x = pk2(v[q][j].x, v[q][j].y); w.y = pk2(v[q][j].z, v[q][j].w); *(GAS u32x2*)(F + (size_t)(m0 + r4 + q) * D + 4 * c.lane + 256 * j) = w; }
#pragma unroll
                for (int i = 0; i < 4; ++i) { const LAS f32x4* rp = (const LAS f32x4*)(c.lds + c.lane * RW_PITCH + (j * 4 + i) * 64);
#pragma unroll
                    for (int k4 = 0; k4 < 4; ++k4) { const f32x4 w4 = rp[k4];
#pragma unroll
                        for (int q = 0; q < 4; ++q) { const float ai = v[q][j][i]; lg[q][4 * k4] += ai * w4.x; lg[q][4 * k4 + 1] += ai * w4.y; lg[q][4 * k4 + 2] += ai * w4.z; lg[q][4 * k4 + 3] += ai * w4.w; } } } }
            float lgt[4];
#pragma unroll
            for (int q = 0; q < 4; ++q) {
                float r8[8];
#pragma unroll
                for (int i = 0; i < 8; ++i) { const bool up = c.lane & 1; const float keep = up ? lg[q][i + 8] : lg[q][i], send = up ? lg[q][i] : lg[q][i + 8]; r8[i] = keep + __shfl_xor(send, 1); }
                float r4v[4];
#pragma unroll
                for (int i = 0; i < 4; ++i) { const bool up = c.lane & 2; const float keep = up ? r8[i + 4] : r8[i], send = up ? r8[i] : r8[i + 4]; r4v[i] = keep + __shfl_xor(send, 2); }
                float r2[2];
#pragma unroll
                for (int i = 0; i < 2; ++i) { const bool up = c.lane & 4; const float keep = up ? r4v[i + 2] : r4v[i], send = up ? r4v[i] : r4v[i + 2]; r2[i] = keep + __shfl_xor(send, 4); }
                { const bool up = c.lane & 8; const float keep = up ? r2[1] : r2[0], send = up ? r2[0] : r2[1]; lgt[q] = keep + __shfl_xor(send, 8); }
            }
#pragma unroll
            for (int o = 16; o < 64; o <<= 1) {
#pragma unroll
                for (int q = 0; q < 4; ++q) lgt[q] += __shfl_xor(lgt[q], o); }
            float mx[4], ex[4], den[4];
#pragma unroll
            for (int q = 0; q < 4; ++q) mx[q] = lgt[q];
#pragma unroll
            for (int o = 1; o < 16; o <<= 1) {
#pragma unroll
                for (int q = 0; q < 4; ++q) mx[q] = fmaxf(mx[q], __shfl_xor(mx[q], o)); }
#pragma unroll
            for (int q = 0; q < 4; ++q) { ex[q] = expf(lgt[q] - mx[q]); den[q] = ex[q]; }
#pragma unroll
            for (int o = 1; o < 16; o <<= 1) {
#pragma unroll
                for (int q = 0; q < 4; ++q) den[q] += __shfl_xor(den[q], o); }
            if (c.lane < 16) {
#pragma unroll
                for (int q = 0; q < 4; ++q) { const int m = m0 + r4 + q; const int t = isctx ? ((m - MLAT) & 255) : (m & 16383); const float pr = ex[q] / den[q];
                    if (isctx) probsC[(b * 16 + myexp) * 256 + t] = pr; else probsL[(b * 16 + myexp) * 16384 + t] = pr; } }
        }
    }
}

#undef FFN_LOAD_RAW
__device__ __forceinline__ int block_excl_scan(const Ctx& c, int v, volatile LAS int* tmp, int& total) {
    int inc = v;
#pragma unroll
    for (int o = 1; o < 64; o <<= 1) { const int y = __shfl_up(inc, o); if (c.lane >= o) inc += y; }
    __syncthreads();
    if (c.lane == 63) tmp[c.wave] = inc;
    __syncthreads();
    int base = 0, tot = 0;
#pragma unroll
    for (int w = 0; w < 8; ++w) { const int x = tmp[w]; if (w < c.wave) base += x; tot += x; }
    total = tot;
    return base + inc - v;
}
__device__ __forceinline__ void select_unit(const Ctx& c_, int unit) { Ctx c = c_; asm volatile("" : "+s"(c.ws), "+s"(c.inp), "+s"(c.out), "+v"(c.tid)); c.lane = c.tid & 63;
    const bool isctx = unit >= 32; const int be = isctx ? unit - 32 : unit, b = be >> 4, e = be & 15;
    const int N = isctx ? 256 : 16384, cap = isctx ? CAPC : CAPL;
    const GAS float* probs = (const GAS float*)(c.ws + WS_PROBS) + (isctx ? 2 * 16 * 16384 + be * 256 : be * 16384);
    int* smap = (int*)(c.ws + WS_SMAP) + (isctx ? 2 * 16 * 16384 + be * 256 : be * 16384);
    int* idx = (int*)(c.ws + WS_IDX); float* gate = (float*)(c.ws + WS_GATE);
    const int rowbase = isctx ? (XLAT + e * 256 + b * 32) : be * CAPL;
    const int tokbase = isctx ? (MLAT + b * LC) : b * SEQ;
    LAS unsigned* keys = (LAS unsigned*)(c.lds + RING_OFF);
    volatile LAS unsigned* hist = (volatile LAS unsigned*)(c.lds + RING_OFF + 65536);
    volatile LAS int* tmp = (volatile LAS int*)(c.lds + RING_OFF + 65536 + 16384);
    __syncthreads();
    unsigned kreg[32];
    const int R = isctx ? 1 : N / 512; const bool act = !isctx || c.tid < 256;
    if (!isctx) {
#pragma unroll
        for (int r = 0; r < 32; ++r) kreg[r] = __float_as_uint(probs[c.tid + 512 * r]);
#pragma unroll
        for (int r = 0; r < 32; ++r) keys[c.tid + 512 * r] = kreg[r]; }
    else {
#pragma unroll
        for (int r = 0; r < 32; ++r) kreg[r] = 0u;
        if (c.tid < 256) { kreg[0] = __float_as_uint(probs[c.tid]); keys[c.tid] = kreg[0]; } }
    unsigned prefix = 0; int remaining = cap;
#pragma unroll 1
    for (int pass = 0; pass < 3; ++pass) {
        const int shift = pass == 0 ? 19 : pass == 1 ? 9 : 0, width = pass == 0 ? 12 : pass == 1 ? 10 : 9, B = 1 << width, nb = B >> 6;
        for (int i = c.tid; i < B; i += 512) hist[i] = 0u;
        __syncthreads();
        if (act) {
#pragma unroll
            for (int r = 0; r < 32; ++r) { const unsigned k = kreg[r];
                if (r < R && (pass == 0 || (k >> (shift + width)) == (prefix >> (shift + width)))) __hip_atomic_fetch_add((LAS unsigned*)&hist[(k >> shift) & (unsigned)(B - 1)], 1u, __ATOMIC_RELAXED, __HIP_MEMORY_SCOPE_WORKGROUP); } }
        __syncthreads();
        if (c.wave == 0) {
            const int d0 = B - 1 - c.lane * nb; int cl = 0;
            for (int q = 0; q < nb; ++q) cl += (int)hist[d0 - ((q + c.lane) & (nb - 1))];
            int inc = cl;
#pragma unroll
            for (int o = 1; o < 64; o <<= 1) { const int y = __shfl_up(inc, o); if (c.lane >= o) inc += y; }
            const int before = inc - cl;
            const unsigned long long own = __ballot(before < remaining && remaining <= inc);
            const int ol = __builtin_ctzll(own);
            const int obefore = __shfl(before, ol), od0 = B - 1 - ol * nb;
            const int hb = c.lane < nb ? (int)hist[od0 - c.lane] : 0; int hinc = hb;
#pragma unroll
            for (int o = 1; o < 64; o <<= 1) { const int y = __shfl_up(hinc, o); if (c.lane >= o) hinc += y; }
            const int hbefore = obefore + hinc - hb;
            if (c.lane < nb && hbefore < remaining && remaining <= hbefore + hb) { tmp[16] = od0 - c.lane; tmp[17] = remaining - hbefore; }
        }
        __syncthreads();
        prefix |= ((unsigned)tmp[16]) << shift; remaining = tmp[17];
        __syncthreads();
    }
    int cnt2 = 0;
    if (act) {
#pragma unroll
        for (int r = 0; r < 32; ++r) { const unsigned k = kreg[r]; if (r < R) cnt2 += (k >= prefix ? 1 : 0) + (k == prefix ? 65536 : 0); } }
    int tot2; int base2 = block_excl_scan(c, cnt2, tmp, tot2);
    const int toteq = tot2 >> 16;
    int cutoff = N;
    int slot = base2 & 0xffff;
    if (toteq != remaining) {
        if (c.wave == 0) { int cum = 0;
            for (int base = 0; base < N; base += 64) { const unsigned long long m = __ballot(keys[base + c.lane] == prefix); const int pc = __popcll(m);
                if (cum + pc >= remaining) { unsigned long long mm = m; for (int q = cum + 1; q < remaining; ++q) mm &= mm - 1; if (c.lane == 0) tmp[18] = base + __builtin_ctzll(mm); break; }
                cum += pc; } }
        __syncthreads();
        cutoff = tmp[18];
        __syncthreads();
        int nsel = 0;
        if (act) {
#pragma unroll
            for (int r = 0; r < 32; ++r) { const int i = c.tid + 512 * r; const unsigned k = kreg[r]; if (r < R) nsel += (k > prefix || (k == prefix && i <= cutoff)) ? 1 : 0; } }
        int tot; slot = block_excl_scan(c, nsel, tmp, tot);
    }
    if (act) {
#pragma unroll
        for (int r = 0; r < 32; ++r) { if (r < R) { const int i = c.tid + 512 * r; const unsigned k = kreg[r]; const bool sel = (k > prefix || (k == prefix && i <= cutoff)) && slot < cap;
            if (sel) { smap[i] = slot; idx[rowbase + slot] = tokbase + i; gate[rowbase + slot] = __uint_as_float(k); ++slot; } else smap[i] = -1; } } }
}


__device__ __forceinline__ void sg_stage_a(const Ctx& c, const GAS bf16* const (&srow)[16]) {
    __syncthreads();
    v4u v[16];
#pragma unroll
    for (int i = 0; i < 16; ++i) { const int p = c.tid + 512 * i; v[i] = *(const GAS v4u*)(srow[i] + (p & 127) * 8); }
#pragma unroll
    for (int i = 0; i < 16; ++i) { const int p = c.tid + 512 * i, row = p >> 7, ch = p & 127; *(LAS v4u*)(c.lds + RING_OFF + row * 2048 + ((ch ^ (row & 15)) << 4)) = v[i]; }
    LDS_WAIT(); __syncthreads();
}
template <int NB> __device__ __forceinline__ void sg_mainloop(const Ctx& c, const GAS bf16* const (&brow)[NB], int fr, int fq, f32x4 (&acc)[NB][4]) {
#pragma unroll
    for (int nb = 0; nb < NB; ++nb)
#pragma unroll
        for (int mt = 0; mt < 4; ++mt) acc[nb][mt] = (f32x4){0.f, 0.f, 0.f, 0.f};
    bf16x8 b0[NB][8], b1[NB][8];
#pragma unroll
    for (int nb = 0; nb < NB; ++nb)
#pragma unroll
        for (int k = 0; k < 8; ++k) b0[nb][k] = *(const GAS bf16x8*)(brow[nb] + 32 * k + 8 * fq);
#pragma unroll
    for (int kb = 0; kb < 4; ++kb) {
        if (kb < 3) {
#pragma unroll
            for (int nb = 0; nb < NB; ++nb)
#pragma unroll
                for (int k = 0; k < 8; ++k) { const bf16x8 t = *(const GAS bf16x8*)(brow[nb] + 32 * (8 * (kb + 1) + k) + 8 * fq); if (kb & 1) b0[nb][k] = t; else b1[nb][k] = t; }
        }
#pragma unroll
        for (int k = 0; k < 8; ++k) { const int ch = 4 * (8 * kb + k) + fq;
            bf16x8 a[4];
#pragma unroll
            for (int mt = 0; mt < 4; ++mt) { const int row = 16 * mt + fr; a[mt] = *(const LAS bf16x8*)(c.lds + RING_OFF + row * 2048 + ((ch ^ (row & 15)) << 4)); }
#pragma unroll
            for (int nb = 0; nb < NB; ++nb) { const bf16x8 bb = (kb & 1) ? b1[nb][k] : b0[nb][k];
#pragma unroll
                for (int mt = 0; mt < 4; ++mt) acc[nb][mt] = mfma16(bb, a[mt], acc[nb][mt]); } }
    }
}
__device__ __forceinline__ void ctx_inproj_item(const Ctx& c_, int l, int item, int nb_lo, int nb_cnt) { Ctx c = c_; asm volatile("" : "+s"(c.ws), "+s"(c.inp), "+s"(c.out), "+v"(c.tid)); c.lane = c.tid & 63; asm volatile("" : "+s"(l));
    const int fr = c.lane & 15, fq = c.lane >> 4; const int mblk = item / nb_cnt, nbk = nb_lo + item % nb_cnt;
    const GAS bf16* A1 = (const GAS bf16*)(c.ws + WS_R1); const GAS bf16* W = (const GAS bf16*)(c.ws + WS_WIN) + (size_t)l * INW * 1024;
    GAS bf16* P = (GAS bf16*)(c.ws + WS_R2); GAS bf16* Amat = (GAS bf16*)(c.ws + WS_R1 + OFF_AMAT); GAS bf16* U2 = (GAS bf16*)(c.ws + WS_R3);
    const int row0 = MLAT + 64 * mblk, col0 = 128 * nbk + 16 * c.wave;
    const GAS bf16* srow[16]; const GAS bf16* brow[1];
#pragma unroll
    for (int i = 0; i < 16; ++i) srow[i] = A1 + (size_t)(row0 + ((c.tid + 512 * i) >> 7)) * 1024;
    brow[0] = W + (size_t)(col0 + fr) * 1024;
    sg_stage_a(c, srow);
    f32x4 acc[1][4]; sg_mainloop<1>(c, brow, fr, fq, acc);
#pragma unroll
    for (int mt = 0; mt < 4; ++mt) { const int row = row0 + 16 * mt + fr, col = col0 + 4 * fq; u32x2 w; w.x = pk2(acc[0][mt][0], acc[0][mt][1]); w.y = pk2(acc[0][mt][2], acc[0][mt][3]);
        if (col >= 768 && col < 1024) { const int cl = col - 768; const size_t r = (size_t)(cl >> 4) * 2304 + (row >> 4); const int k = (row & 15) * 16 + (cl & 15); *(GAS u32x2*)(Amat + r * 512 + k) = w; *(GAS u32x2*)(U2 + r * 256 + k) = w; }
        else *(GAS u32x2*)(P + (size_t)row * INW + col) = w; }
}
__device__ __forceinline__ void ctx_outproj_item(const Ctx& c_, int l, int item) { Ctx c = c_; asm volatile("" : "+s"(c.ws), "+s"(c.inp), "+s"(c.out), "+v"(c.tid)); c.lane = c.tid & 63; asm volatile("" : "+s"(l));
    const int fr = c.lane & 15, fq = c.lane >> 4; const int mblk = item >> 3, nbk = item & 7;
    const GAS bf16* mixn = (const GAS bf16*)(c.ws + WS_R3); const GAS bf16* W = (const GAS bf16*)(c.ws + WS_WOUT) + (size_t)l * 1024 * 1024;
    const GAS float* gate = (const GAS float*)(c.ws + WS_MODV) + (size_t)(l * 3 + 2) * 6144 + 2 * 1024; GAS float* hctx = (GAS float*)(c.ws + WS_HCTX);
    const int r0 = 64 * mblk, col0 = 128 * nbk + 16 * c.wave;
    const GAS bf16* srow[16]; const GAS bf16* brow[1];
#pragma unroll
    for (int i = 0; i < 16; ++i) srow[i] = mixn + (size_t)(MLAT + r0 + ((c.tid + 512 * i) >> 7)) * 1024;
    brow[0] = W + (size_t)(col0 + fr) * 1024;
    sg_stage_a(c, srow);
    f32x4 acc[1][4]; sg_mainloop<1>(c, brow, fr, fq, acc);
    const f32x4 gv = *(const GAS f32x4*)(gate + col0 + 4 * fq);
#pragma unroll
    for (int mt = 0; mt < 4; ++mt) { const size_t off = (size_t)(r0 + 16 * mt + fr) * 1024 + col0 + 4 * fq;
        const f32x4 h = *(const GAS f32x4*)(c.inp[I_CTX] + off); *(GAS f32x4*)(hctx + off) = h + gv * acc[0][mt]; }
}
__device__ __forceinline__ void ctx_moe1_item(const Ctx& c_, int item) { Ctx c = c_; asm volatile("" : "+s"(c.ws), "+s"(c.inp), "+s"(c.out), "+v"(c.tid)); c.lane = c.tid & 63;
    const int fr = c.lane & 15, fq = c.lane >> 4; const int e = item >> 3, fb = item & 7;
    const GAS bf16* F = (const GAS bf16*)(c.ws + WS_R3 + 66 * MiB); const GAS int* idx = (const GAS int*)(c.ws + WS_IDX);
    const GAS bf16* W = (const GAS bf16*)(c.ws + WS_WGU) + (size_t)e * 2048 * 1024; GAS bf16* hid = (GAS bf16*)(c.ws + WS_R2);
    const int xr0 = XLAT + 256 * e;
    const GAS bf16* srow[16]; const GAS bf16* brow[2];
#pragma unroll
    for (int i = 0; i < 16; ++i) srow[i] = F + (size_t)idx[xr0 + ((c.tid + 512 * i) >> 7)] * 1024;
    brow[0] = W + (size_t)(256 * fb + 16 * c.wave + fr) * 1024; brow[1] = brow[0] + (size_t)128 * 1024;
    sg_stage_a(c, srow);
    f32x4 acc[2][4]; sg_mainloop<2>(c, brow, fr, fq, acc);
#pragma unroll
    for (int mt = 0; mt < 4; ++mt) { float hv[4];
#pragma unroll
        for (int i = 0; i < 4; ++i) { const float g = acc[0][mt][i]; hv[i] = g * __builtin_amdgcn_rcpf(1.0f + __builtin_amdgcn_exp2f(-g * LOG2E)) * acc[1][mt][i]; }
        u32x2 w; w.x = pk2(hv[0], hv[1]); w.y = pk2(hv[2], hv[3]);
        *(GAS u32x2*)(hid + (size_t)(xr0 + 16 * mt + fr) * 1024 + 128 * fb + 16 * c.wave + 4 * fq) = w; }
}
__device__ __forceinline__ void ctx_moe2_item(const Ctx& c_, int item) { Ctx c = c_; asm volatile("" : "+s"(c.ws), "+s"(c.inp), "+s"(c.out), "+v"(c.tid)); c.lane = c.tid & 63;
    const int fr = c.lane & 15, fq = c.lane >> 4; const int e = item >> 3, nbk = item & 7;
    const GAS bf16* hid = (const GAS bf16*)(c.ws + WS_R2); const GAS bf16* W = (const GAS bf16*)(c.ws + WS_WD) + (size_t)e * 1024 * 1024;
    GAS bf16* Y = (GAS bf16*)(c.ws + WS_R3); const GAS float* gate = (const GAS float*)(c.ws + WS_GATE);
    const int xr0 = XLAT + 256 * e, col0 = 128 * nbk + 16 * c.wave;
    const GAS bf16* srow[16]; const GAS bf16* brow[1];
#pragma unroll
    for (int i = 0; i < 16; ++i) srow[i] = hid + (size_t)(xr0 + ((c.tid + 512 * i) >> 7)) * 1024;
    brow[0] = W + (size_t)(col0 + fr) * 1024;
    sg_stage_a(c, srow);
    f32x4 acc[1][4]; sg_mainloop<1>(c, brow, fr, fq, acc);
#pragma unroll
    for (int mt = 0; mt < 4; ++mt) { const int row = xr0 + 16 * mt + fr; const float gt = gate[row];
        u32x2 w; w.x = pk2(acc[0][mt][0] * gt, acc[0][mt][1] * gt); w.y = pk2(acc[0][mt][2] * gt, acc[0][mt][3] * gt);
        *(GAS u32x2*)(Y + (size_t)row * 1024 + col0 + 4 * fq) = w; }
}

__device__ __forceinline__ void norm_unit(const Ctx& c_, int l, int unit) { Ctx c = c_; asm volatile("" : "+s"(c.ws), "+s"(c.inp), "+s"(c.out), "+v"(c.tid)); c.lane = c.tid & 63; asm volatile("" : "+s"(l));
    const int lane = c.lane; const bool sg = lane >= 32;
    const GAS bf16* mix = (const GAS bf16*)(c.ws + WS_R1); GAS bf16* mixn = (GAS bf16*)(c.ws + WS_R3); const GAS float* ong = c.inp[I_ONG] + l * D;
    const f32x4 ga0 = *(const GAS f32x4*)(ong + 8 * lane), gb0 = *(const GAS f32x4*)(ong + 8 * lane + 4), ga1 = *(const GAS f32x4*)(ong + 512 + 8 * lane), gb1 = *(const GAS f32x4*)(ong + 512 + 8 * lane + 4);
    const int row0 = unit * 64 + c.wave * 8;
    float x[8][2][8]; float sa[8], sh[8];
#pragma unroll
    for (int q = 0; q < 8; ++q)
#pragma unroll
        for (int j = 0; j < 2; ++j) { v4u w = (v4u){0u, 0u, 0u, 0u}; if (j == 0 || sg) w = *(const GAS v4u*)(mix + (size_t)(row0 + q) * 1024 + 8 * lane + 512 * j);
            x[q][j][0] = __uint_as_float(w.x << 16); x[q][j][1] = __uint_as_float(w.x & 0xffff0000u); x[q][j][2] = __uint_as_float(w.y << 16); x[q][j][3] = __uint_as_float(w.y & 0xffff0000u);
            x[q][j][4] = __uint_as_float(w.z << 16); x[q][j][5] = __uint_as_float(w.z & 0xffff0000u); x[q][j][6] = __uint_as_float(w.w << 16); x[q][j][7] = __uint_as_float(w.w & 0xffff0000u); }
#pragma unroll
    for (int q = 0; q < 8; ++q) { float s0 = 0.f, s1 = 0.f;
#pragma unroll
        for (int i = 0; i < 8; ++i) { s0 += x[q][0][i] * x[q][0][i]; s1 += x[q][1][i] * x[q][1][i]; }
        sa[q] = s0; sh[q] = s1; }
#pragma unroll
    for (int o = 1; o < 64; o <<= 1) {
#pragma unroll
        for (int q = 0; q < 8; ++q) { sa[q] += __shfl_xor(sa[q], o); sh[q] += __shfl_xor(sh[q], o); } }
#pragma unroll
    for (int q = 0; q < 8; ++q) {
        const float r_att = 1.0f / sqrtf(sa[q] * (1.0f / 512.0f) + EPS), r_b = 1.0f / sqrtf(sh[q] * (1.0f / 256.0f) + EPS);
#pragma unroll
        for (int j = 0; j < 2; ++j) { if (j == 0 || sg) { const float r = j == 0 ? r_att : r_b; const f32x4 ga = j == 0 ? ga0 : ga1, gb = j == 0 ? gb0 : gb1;
            v4u w; w.x = pk2(x[q][j][0] * r * ga[0], x[q][j][1] * r * ga[1]); w.y = pk2(x[q][j][2] * r * ga[2], x[q][j][3] * r * ga[3]);
            w.z = pk2(x[q][j][4] * r * gb[0], x[q][j][5] * r * gb[1]); w.w = pk2(x[q][j][6] * r * gb[2], x[q][j][7] * r * gb[3]);
            *(GAS v4u*)(mixn + (size_t)(row0 + q) * 1024 + 8 * lane + 512 * j) = w; } } }
}

#ifndef MK_N_LAUNCHES
#define MK_N_LAUNCHES 1
#endif
constexpr int N_PHASES = 24;
constexpr int N_LAUNCHES = MK_N_LAUNCHES;
static_assert(N_LAUNCHES == 1 || N_LAUNCHES == N_PHASES, "MK_N_LAUNCHES is 1 or 24");

typedef const __attribute__((address_space(4))) unsigned char* kargp_t;
__device__ __forceinline__ Ctx make_ctx(LAS unsigned char* lds) {
    Ctx c; kargp_t kp = (kargp_t)__builtin_amdgcn_kernarg_segment_ptr(); asm volatile("" : "+s"(kp));
    c.inp = (kfptr*)kp;
    c.out = *(GAS float* const __attribute__((address_space(4)))*)(kp + 248); c.ws = *(GAS unsigned char* const __attribute__((address_space(4)))*)(kp + 256);
    c.ctl = (gu32*)(c.ws + WS_CTL);
    c.lds = lds; c.MISC = (volatile LAS unsigned*)(lds + MISC_OFF);
    int t = threadIdx.x; asm volatile("" : "+v"(t)); c.tid = t; c.lane = t & 63; c.wave = __builtin_amdgcn_readfirstlane(t >> 6);
    int G = gridDim.x, bx = blockIdx.x; asm volatile("" : "+s"(G), "+s"(bx)); c.G = G; c.vcu = (G % 8 == 0) ? (bx % 8) * (G / 8) + bx / 8 : bx;
    return c;
}
static_assert(offsetof(Args, out) == 248 && offsetof(Args, ws) == 256 && offsetof(Args, ph_lo) == 264, "Args layout");
__device__ __forceinline__ void grid_bar(const Ctx& c) {
    XcdBarrier bar; bar.bar = (unsigned*)(c.ctl + CW_BAR); bar.x = xb_xcc_id(); bar.st = c.MISC + 8;
    xcd_barrier(bar);
}

__global__ void __launch_bounds__(NWAVES * 64, 2) mega_fwd(Args args) {
    extern __shared__ __attribute__((aligned(16))) unsigned char lds[];
    {
        Ctx c = make_ctx((LAS unsigned char*)lds);
        for (int u = c.tid; u < (LDS_BYTES - LDSCTL_OFF) / 4; u += NWAVES * 64) ((LAS unsigned*)(c.lds + LDSCTL_OFF))[u] = 0u;
        __syncthreads();
        if (N_LAUNCHES == 1) (void)xcd_barrier_post((unsigned*)(c.ctl + CW_BAR), c.MISC + 8);
    }
    const int lo = args.ph_lo, hi = args.ph_hi;
#ifndef KIND_MASK
#define KIND_MASK 0x1fff
#endif
#define KIND_OF(k) ((k) < 2 ? (k) : 2 + ((k) - 2) % 11)
#define IN(k) (((KIND_MASK >> KIND_OF(k)) & 1) && lo <= (k) && (k) < hi)
#ifndef TPROBE
#define TPROBE -1
#endif
#ifndef TPROBE_UNIT
#define TPROBE_UNIT 0
#endif
#define STAMP(i) do { if ((TPROBE >= 0) && blockIdx.x == 0 && c.tid == 0) __hip_atomic_store(c.ctl + CW_TS + (i), (unsigned)__builtin_amdgcn_s_memrealtime(), RLX_AGENT); } while (0)
#define SEAM(k) do { if (IN((k) + 1)) grid_bar(c); STAMP((k) + 1); } while (0)
#ifndef REPEAT_MASK
#define REPEAT_MASK 0
#endif
#ifndef D_REP_MASK
#define D_REP_MASK 7
#endif
#define NREP(k) ((((REPEAT_MASK) >> KIND_OF(k)) & 1) ? 2 : 1)
#define REPEAT(k) for (int rep = 0; rep < NREP(k); ++rep)
#define LAUNDER() Ctx c = make_ctx((LAS unsigned char*)lds)
#define A1 ((bf16*)(c.ws + WS_R1))
#define Pb ((bf16*)(c.ws + WS_R2))
#define mixn ((bf16*)(c.ws + WS_R3))
#define xin ((bf16*)(c.ws + WS_R1))
#define hid ((bf16*)(c.ws + WS_R2))
#define Yb ((bf16*)(c.ws + WS_R3))
#define hctx ((float*)(c.ws + WS_HCTX))
#define AMAT ((bf16*)(c.ws + WS_R1 + OFF_AMAT))
#define U2M ((bf16*)(c.ws + WS_R3))
#define GS ((bf16*)(c.ws + WS_R1 + OFF_GS))
#define MIX ((bf16*)(c.ws + WS_R1))

    { Ctx c = make_ctx((LAS unsigned char*)lds); STAMP(0); }
    if (IN(0)) { REPEAT(0) { LAUNDER(); if (rep) grid_bar(c); p0a(c); } LAUNDER(); SEAM(0); }
    if (IN(1)) { REPEAT(1) { LAUNDER(); if (rep) grid_bar(c); p0b_tables(c); row_prep(c, 0, 0); } LAUNDER(); SEAM(1); }
#pragma unroll 1
    for (int l = 0; l < 2; ++l) {
        const int pb = 2 + 11 * l;
#define PH_BEGIN(k) if (IN(pb + (k))) { for (int rep = 0; rep < NREP(pb + (k)); ++rep) { LAUNDER(); if (rep) grid_bar(c);
#define PH_END(k) } LAUNDER(); SEAM(pb + (k)); }
        PH_BEGIN(0)
            pg8::Gemm g{A1, (const bf16*)(c.ws + WS_WIN) + (size_t)l * INW * 1024, MLAT, INW, 1024, 1024, nullptr}; pg8::StaticOrder S; S.init(MLAT, INW, c.G, (int)blockIdx.x);
            pg8::EpiInProj E{Pb, AMAT, U2M};
            pg8::gemm_phase<pg8::EpiInProj, pg8::StaticOrder, true, true>(c.lds + RING_OFF, g, S, E);
            { const int nb_lo = l == 0 ? 0 : 4, nb_cnt = l == 0 ? 12 : 4;
              for (int it = (int)blockIdx.x; it < 8 * nb_cnt; it += c.G) ctx_inproj_item(c, l, it, nb_lo, nb_cnt); }
        PH_END(0)
        PH_BEGIN(1)
            if (l == 0 && rep == 0) tg_assemble(c);
            { pg8::Gemm g{U2M, (const bf16*)(c.ws + WS_EB) + (size_t)l * 16 * 256 * 256, 144 * 256, 256, 256, 256, nullptr}; pg8::StaticOrder S; S.init(144 * 256, 256, c.G, (int)blockIdx.x, 2);
              pg8::EpiF32x256 E{(float*)(c.ws + WS_R2 + OFF_E)};
              pg8::gemm_phase<pg8::EpiF32x256, pg8::StaticOrder, false, true>(c.lds + RING_OFF, g, S, E); }
            if (rep == 0) qk_prep_rows(c, l);
        PH_END(1)
        PH_BEGIN(2)
            const int natt = l == 0 ? 520 : 512, nsgu = l == 0 ? 260 : 256;
            int nredo = 0;
            for (int u = q_next(c, pb + 2 + 32 * rep), un = 0; u < 64 + natt + nsgu; u = un) { const bool ahead = u < 64 + 256; unsigned tk = 0u; if (ahead) tk = q_issue(c, pb + 2 + 32 * rep);
                const int ukind = u < 64 ? 3 : u < 64 + natt ? 1 : 2;
                unsigned long long t0_ = 0; if (TPROBE_UNIT == ukind) t0_ = __builtin_amdgcn_s_memrealtime();
                if (u < 64) { if (rep == 0 || (D_REP_MASK & 1)) s5_scan_unit(c, l, u); }
                else if (u < 64 + natt) { if (rep == 0 || (D_REP_MASK & 2)) { if (attn_unit_t<true>(c, l, u - 64)) { if (c.tid == 0) c.MISC[64 + nredo] = (unsigned)(u - 64); ++nredo; } } }
                else { if (rep == 0 || (D_REP_MASK & 4)) sgu_unit(c, l, u - 64 - natt); }
                if (TPROBE_UNIT == ukind && l == 0) { WG_SYNC(); if (blockIdx.x == 0 && c.tid == 0) { const unsigned dt_ = (unsigned)(__builtin_amdgcn_s_memrealtime() - t0_);
                    __hip_atomic_fetch_add(c.ctl + CW_TS + 40, dt_, RLX_AGENT); __hip_atomic_fetch_add(c.ctl + CW_TS + 41, 1u, RLX_AGENT); } }
                un = ahead ? q_publish(c, tk) : q_next(c, pb + 2 + 32 * rep); }
            for (int i = 0; i < nredo; ++i) { LDS_WAIT(); __syncthreads(); const int uu = (int)c.MISC[64 + i]; (void)attn_unit_t<false>(c, l, __builtin_amdgcn_readfirstlane(uu)); }
        PH_END(2)
        PH_BEGIN(3)
            pg8::Gemm g{AMAT, (const bf16*)(c.ws + WS_TG) + (size_t)l * 16 * 256 * 512, 144 * 256, 256, 512, 512, nullptr}; pg8::StaticOrder S; S.init(144 * 256, 256, c.G, (int)blockIdx.x, 2);
            pg8::EpiS5Out E{GS, NSC};
            pg8::gemm_phase<pg8::EpiS5Out, pg8::StaticOrder, true, true>(c.lds + RING_OFF, g, S, E);
            if (rep == 0) for (;;) { const int u = q_next(c, pb + 3); if (u >= (l == 0 ? MT : MLAT) / 64) break; norm_unit(c, l, u); }
        PH_END(3)
        PH_BEGIN(4)
            const int M = l == 0 ? MT : MLAT;
            pg8::Gemm g{GS, (const bf16*)(c.ws + WS_WGLU) + (size_t)l * 256 * 256, M, 256, 256, 256, nullptr}; pg8::StaticOrder S; S.init(M, 256, c.G, (int)blockIdx.x);
            pg8::EpiGluNorm E{GS, MIX, mixn, (const float*)(c.inp[I_GLUB] + l * 256), (const float*)(c.inp[I_ONG] + l * D), EPS};
            pg8::gemm_phase<pg8::EpiGluNorm, pg8::StaticOrder, false, true>(c.lds + RING_OFF, g, S, E);
        PH_END(4)
        if (IN(pb + 5)) { for (int rep = 0; rep < (l == 0 ? NREP(pb + 5) : 1); ++rep) { LAUNDER(); if (rep) grid_bar(c);
            const int M = MLAT;
            pg8::Gemm g{mixn, (const bf16*)(c.ws + WS_WOUT) + (size_t)l * 1024 * 1024, M, 1024, 1024, 1024, nullptr}; pg8::StaticOrder S; S.init(M, 1024, c.G, (int)blockIdx.x);
            pg8::EpiResidBf E{l == 0 ? (const float*)c.inp[I_X] : nullptr, (bf16*)c.out, (const float*)(c.ws + WS_MODV) + (size_t)l * 3 * 6144, 2 * 1024};
            pg8::gemm_phase<pg8::EpiResidBf, pg8::StaticOrder, true, true>(c.lds + RING_OFF, g, S, E);
            if (l == 0) for (int it = (int)blockIdx.x; it < 64; it += c.G) ctx_outproj_item(c, l, it);
        PH_END(5)
        PH_BEGIN(6) ffn_prep(c, l, l == 0 ? MT : MLAT); PH_END(6)
        PH_BEGIN(7) const int nu = l == 0 ? 64 : 32; for (int u = (int)blockIdx.x; u < nu; u += c.G) select_unit(c, u);
            if (l == 0 && rep == 0 && c.G > 128) convert_experts(c, 1, 2, 3, 64);
        PH_END(7)
        PH_BEGIN(8)
            const int M = XLAT;
            pg8::Gemm g{(const bf16*)(c.ws + WS_R3 + 66 * MiB), (const bf16*)(c.ws + WS_WGU), M, 2048, 1024, 1024, (const int*)(c.ws + WS_IDX)};   pg8::StaticOrder S; S.init(M, 2048, c.G, (int)blockIdx.x, 1);
            pg8::EpiSwiGLU E{hid};
            pg8::gemm_phase<pg8::EpiSwiGLU, pg8::StaticOrder, true, true, true>(c.lds + RING_OFF, g, S, E);
            if (l == 0) for (int it = (int)blockIdx.x; it < 128; it += c.G) ctx_moe1_item(c, it);
        PH_END(8)
        PH_BEGIN(9)
            const int M = XLAT;
            pg8::Gemm g{hid, (const bf16*)(c.ws + (l == 0 ? WS_WD : WS_WD1)), M, 1024, 1024, 1024, nullptr}; pg8::StaticOrder S; S.init(M, 1024, c.G, (int)blockIdx.x, 1);
            pg8::EpiGateY E{Yb, (const float*)(c.ws + WS_GATE)};
            pg8::gemm_phase<pg8::EpiGateY, pg8::StaticOrder, true, true>(c.lds + RING_OFF, g, S, E);
            if (l == 0) for (int it = (int)blockIdx.x; it < 128; it += c.G) ctx_moe2_item(c, it);
        PH_END(9)
        if (IN(pb + 10)) { LAUNDER();
            if (l == 0) { row_prep(c, 1, 1); if (c.G > 128) convert_experts(c, 1, 0, 2, 0); else convert_experts(c, 1, 0, 3, 0); SEAM(pb + 10); }
            else row_prep(c, 2, 1);
        }
    }
#undef PH_BEGIN
#undef PH_END
#undef AMAT
#undef U2M
#undef GS
#undef MIX
#undef IN
#undef SEAM
#undef A1
#undef Pb
#undef mixn
#undef xin
#undef hid
#undef Yb
#undef hctx
}

extern "C" void kernel_launch(void* const* d_in, const int* in_sizes, int n_in, void* d_out, int out_size, void* d_ws, size_t ws_size, hipStream_t stream) {
    static int grid = 0;
    if (grid == 0) {
        if (n_in != 31 || in_sizes[0] != MLAT * D || out_size != MLAT * D || ws_size < WS_END) {
            fprintf(stderr, "kernel_launch: unexpected shapes (n_in %d, in0 %d, out %d, ws %zu < %zu); nothing launched\n", n_in, n_in > 0 ? in_sizes[0] : -1, out_size, ws_size, (size_t)WS_END); grid = -1; return; }
        int dev = 0, cus = 0, per_cu = 0;
        if (hipGetDevice(&dev) != hipSuccess || hipDeviceGetAttribute(&cus, hipDeviceAttributeMultiprocessorCount, dev) != hipSuccess) { grid = -1; return; }
        if (hipFuncSetAttribute((const void*)mega_fwd, hipFuncAttributeMaxDynamicSharedMemorySize, LDS_BYTES) != hipSuccess) { fprintf(stderr, "kernel_launch: hipFuncSetAttribute failed\n"); grid = -1; return; }
        if (hipOccupancyMaxActiveBlocksPerMultiprocessor(&per_cu, (const void*)mega_fwd, NWAVES * 64, LDS_BYTES) != hipSuccess || per_cu < 1)
            fprintf(stderr, "kernel_launch: note: occupancy query reports %d workgroups per CU\n", per_cu);
        (void)hipGetLastError();
        grid = cus;
    }
    if (grid < 0) return;
    if (hipMemsetAsync((char*)d_ws + WS_CTL, 0, CTL_ZERO_BYTES, stream) != hipSuccess) { fprintf(stderr, "kernel_launch: hipMemsetAsync failed\n"); return; }
    Args a{};
    for (int i = 0; i < 31; ++i) a.in[i] = (const float*)d_in[i];
    a.out = (float*)d_out; a.ws = (unsigned char*)d_ws;
    for (int li = 0; li < N_LAUNCHES; ++li) {
        a.ph_lo = (N_LAUNCHES == 1) ? 0 : li; a.ph_hi = (N_LAUNCHES == 1) ? N_PHASES : li + 1;
        hipLaunchKernelGGL(mega_fwd, dim3(grid), dim3(NWAVES * 64), LDS_BYTES, stream, a);
        const hipError_t le = hipPeekAtLastError();
        if (le != hipSuccess) { fprintf(stderr, "kernel_launch: launch %d failed: %s\n", li, hipGetErrorName(le)); break; }
    }
}
```
